# Optimizing an MI355X kernel written in HIP

```python
import jax, jax.numpy as jnp
from jax import lax
import numpy as np

D_MODEL = 1024
BATCH = 8
SEQ = 4096
DEPTH = 2

N_A_LAYERS = DEPTH // 2
N_B_LAYERS = DEPTH - N_A_LAYERS

HEAD_DIM = 128
A_HEADS = 6
A_WIDTH = A_HEADS * HEAD_DIM
CHUNK = 64

B_HEADS = 6
B_WIDTH = B_HEADS * HEAD_DIM
DILATED_GROUPS = ((128, 1), (512, 4), (2048, 16))
N_GROUPS = len(DILATED_GROUPS)
ROPE_THETA = 10000.0

MEM_TOKENS = 256
MEM_HEADS = 4
MEM_HEAD_DIM = 64
MEM_WIDTH = MEM_HEADS * MEM_HEAD_DIM

MIX_WIDTH = A_WIDTH + MEM_WIDTH
A_COLS = 4 * A_WIDTH + MEM_WIDTH
B_COLS = N_GROUPS * B_WIDTH + MEM_WIDTH
FFN_HIDDEN = ((-(-8 * D_MODEL // 3)) + 255) // 256 * 256
EPS = 1e-6

kernel_name = "yoco_hgrn2_dilated_attn_memory_hybrid"


def rms_norm(x, g):
    xf = x.astype(jnp.float32)
    y = xf * lax.rsqrt(jnp.mean(xf * xf, axis=-1, keepdims=True) + EPS)
    return (y * g.astype(jnp.float32)).astype(x.dtype)


def rope(x, pos):
    dh = x.shape[-1]
    half = dh // 2
    inv = ROPE_THETA ** (-jnp.arange(half, dtype=jnp.float32) / half)
    ang = pos.astype(jnp.float32)[:, None] * inv[None, :]
    cos = jnp.cos(ang)[None, :, None, :]
    sin = jnp.sin(ang)[None, :, None, :]
    xf = x.astype(jnp.float32)
    x1, x2 = xf[..., :half], xf[..., half:]
    out = jnp.concatenate([x1 * cos - x2 * sin, x2 * cos + x1 * sin], axis=-1)
    return out.astype(x.dtype)


def hgrn2_chunkwise(q, f_logit, i, lb):
    Bn, S, H, dk = q.shape
    nC = S // CHUNK
    f = lb + (1.0 - lb) * jax.nn.sigmoid(f_logit.astype(jnp.float32))
    k = 1.0 - f
    logf = jnp.log(f)
    qf = jax.nn.silu(q.astype(jnp.float32))
    vf = i.astype(jnp.float32)

    def chunks(t):
        return t.reshape(Bn, nC, CHUNK, H, t.shape[-1]).transpose(1, 0, 3, 2, 4)

    qc, kc, vc, gc = chunks(qf), chunks(k), chunks(vf), chunks(logf)
    b = jnp.cumsum(gc, axis=3)
    b_end = b[:, :, :, -1:, :]
    q_in = qc * jnp.exp(b)
    k_in = kc * jnp.exp(-b)
    k_out = kc * jnp.exp(b_end - b)
    causal = jnp.tril(jnp.ones((CHUNK, CHUNK), dtype=bool))
    att = jnp.where(causal, jnp.einsum('nbhqd,nbhkd->nbhqk', q_in, k_in), 0.0)
    o_intra = jnp.einsum('nbhqk,nbhke->nbhqe', att, vc)
    decay = jnp.exp(b_end[:, :, :, 0, :])

    def step(state, xs):
        q_n, k_n, v_n, dec = xs
        o_n = jnp.einsum('bhqd,bhde->bhqe', q_n, state)
        state = dec[..., None] * state + jnp.einsum('bhkd,bhke->bhde', k_n, v_n)
        return state, o_n

    s0 = jnp.zeros((Bn, H, dk, vf.shape[-1]), jnp.float32)
    _, o_inter = lax.scan(step, s0, (q_in, k_out, vc, decay))
    o = o_intra + o_inter
    return o.transpose(1, 0, 3, 2, 4).reshape(Bn, S, H, vf.shape[-1])


def dilated_branch(q, k, v, window, dilation):
    Bn, S, H, dh = q.shape
    span = window // dilation
    blk = span
    L = S // dilation
    nb = -(-L // blk)
    Lp = nb * blk

    def by_residue(t):
        t = t.reshape(Bn, L, dilation, H, dh).transpose(0, 2, 3, 1, 4)
        return jnp.pad(t, ((0, 0), (0, 0), (0, 0), (0, Lp - L), (0, 0)))

    def band(t):
        tp = jnp.pad(t, ((0, 0), (0, 0), (0, 0), (blk, 0), (0, 0)))
        prev = tp[:, :, :, :Lp].reshape(Bn, dilation, H, nb, blk, dh)
        cur = tp[:, :, :, blk:].reshape(Bn, dilation, H, nb, blk, dh)
        return jnp.concatenate([prev, cur], axis=4)

    qb = by_residue(q).reshape(Bn, dilation, H, nb, blk, dh)
    kb = band(by_residue(k))
    vb = band(by_residue(v))
    s = jnp.einsum('brhnqd,brhnkd->brhnqk', qb, kb,
                   preferred_element_type=jnp.float32) * (dh ** -0.5)
    qpos = jnp.arange(nb)[:, None, None] * blk + jnp.arange(blk)[None, :, None]
    kpos = (jnp.arange(nb)[:, None, None] - 1) * blk + jnp.arange(2 * blk)[None, None, :]
    dist = qpos - kpos
    mask = (dist >= 0) & (dist <= span) & (kpos >= 0)
    s = jnp.where(mask, s, -jnp.inf)
    lse = jax.nn.logsumexp(s, axis=-1)
    p = jnp.exp(s - lse[..., None])
    o = jnp.einsum('brhnqk,brhnkd->brhnqd', p.astype(v.dtype), vb)
    o = o.reshape(Bn, dilation, H, Lp, dh)[:, :, :, :L].transpose(0, 3, 1, 2, 4).reshape(Bn, S, H, dh)
    lse = lse.reshape(Bn, dilation, H, Lp)[..., :L].transpose(0, 3, 1, 2).reshape(Bn, S, H)
    return o, lse


def memory_attention(q, mk, mv):
    s = jnp.einsum('bshd,bmhd->bhsm', q, mk,
                   preferred_element_type=jnp.float32) * (q.shape[-1] ** -0.5)
    p = jax.nn.softmax(s, axis=-1)
    return jnp.einsum('bhsm,bmhd->bshd', p.astype(mv.dtype), mv)


def setup_inputs(seed: int = 0) -> dict:
    key = jax.random.key(seed)
    ks = jax.random.split(key, 24)

    def w(k, shape, fan_in):
        return jax.random.normal(k, shape, jnp.float32) * (fan_in ** -0.5)

    def gain(k, shape):
        return 1.0 + 0.02 * jax.random.normal(k, shape, jnp.float32)

    return {
        "x": jax.random.normal(ks[0], (BATCH, SEQ, D_MODEL), jnp.float32),
        "mem": jax.random.normal(ks[1], (BATCH, MEM_TOKENS, D_MODEL), jnp.float32),
        "norm_mix": gain(ks[2], (DEPTH, D_MODEL)),
        "norm_ffn": gain(ks[3], (DEPTH, D_MODEL)),
        "a_w_in": w(ks[4], (N_A_LAYERS, D_MODEL, A_COLS), D_MODEL),
        "a_lb_logits": 0.1 * jax.random.normal(ks[5], (N_A_LAYERS + 1, A_WIDTH), jnp.float32),
        "a_onorm": gain(ks[6], (N_A_LAYERS, A_WIDTH)),
        "b_w_in": w(ks[7], (N_B_LAYERS, D_MODEL, B_COLS), D_MODEL),
        "b_qnorm": gain(ks[8], (N_B_LAYERS, N_GROUPS, HEAD_DIM)),
        "kv_norm": gain(ks[9], (D_MODEL,)),
        "w_kv": w(ks[10], (D_MODEL, 2 * B_WIDTH), D_MODEL),
        "b_knorm": gain(ks[11], (HEAD_DIM,)),
        "mem_norm": gain(ks[12], (DEPTH, D_MODEL)),
        "w_mem_kv": w(ks[13], (DEPTH, D_MODEL, 2 * MEM_WIDTH), D_MODEL),
        "mem_qnorm": gain(ks[14], (DEPTH, MEM_HEAD_DIM)),
        "mem_knorm": gain(ks[15], (DEPTH, MEM_HEAD_DIM)),
        "w_out": w(ks[16], (DEPTH, MIX_WIDTH, D_MODEL), MIX_WIDTH),
        "w_gate_up": w(ks[17], (DEPTH, D_MODEL, 2 * FFN_HIDDEN), D_MODEL),
        "w_down": w(ks[18], (DEPTH, FFN_HIDDEN, D_MODEL), FFN_HIDDEN),
    }


def reference(x, mem, norm_mix, norm_ffn, a_w_in, a_lb_logits, a_onorm, b_w_in, b_qnorm,
              kv_norm, w_kv, b_knorm, mem_norm, w_mem_kv, mem_qnorm, mem_knorm,
              w_out, w_gate_up, w_down):
    Bn, S, _ = x.shape
    pos = jnp.arange(S)
    lb_all = jnp.cumsum(jax.nn.softmax(a_lb_logits.astype(jnp.float32), axis=0), axis=0)
    h = x
    k_sh = None
    v_sh = None
    for l in range(DEPTH):
        xn = rms_norm(h, norm_mix[l])
        mn = rms_norm(mem, mem_norm[l])
        mk, mv = jnp.split(mn @ w_mem_kv[l], 2, axis=-1)
        mk = rms_norm(mk.reshape(Bn, MEM_TOKENS, MEM_HEADS, MEM_HEAD_DIM), mem_knorm[l])
        mv = mv.reshape(Bn, MEM_TOKENS, MEM_HEADS, MEM_HEAD_DIM)
        if l < N_A_LAYERS:
            proj = xn @ a_w_in[l]
            q, f, i, g, mq = jnp.split(proj, [A_WIDTH, 2 * A_WIDTH, 3 * A_WIDTH, 4 * A_WIDTH], axis=-1)
            shp = (Bn, S, A_HEADS, HEAD_DIM)
            o = hgrn2_chunkwise(q.reshape(shp), f.reshape(shp), i.reshape(shp),
                                lb_all[l].reshape(A_HEADS, HEAD_DIM))
            o = rms_norm(o, a_onorm[l].reshape(A_HEADS, HEAD_DIM)) * jax.nn.silu(g.reshape(shp).astype(jnp.float32))
            mix_main = o.reshape(Bn, S, A_WIDTH).astype(h.dtype)
        else:
            j = l - N_A_LAYERS
            proj = xn @ b_w_in[j]
            qs = proj[..., :N_GROUPS * B_WIDTH].reshape(Bn, S, N_GROUPS, B_HEADS, HEAD_DIM)
            mq = proj[..., N_GROUPS * B_WIDTH:]
            outs = []
            lses = []
            for gi, (win, dil) in enumerate(DILATED_GROUPS):
                qg = rope(rms_norm(qs[:, :, gi], b_qnorm[j, gi]), pos)
                o_g, lse_g = dilated_branch(qg, k_sh, v_sh, win, dil)
                outs.append(o_g)
                lses.append(lse_g)
            alpha = jax.nn.softmax(jnp.stack(lses, axis=0), axis=0)
            o = jnp.sum(alpha[..., None] * jnp.stack(outs, axis=0).astype(jnp.float32), axis=0)
            mix_main = o.reshape(Bn, S, B_WIDTH).astype(h.dtype)
        mq = rms_norm(mq.reshape(Bn, S, MEM_HEADS, MEM_HEAD_DIM), mem_qnorm[l])
        mo = memory_attention(mq, mk, mv).reshape(Bn, S, MEM_WIDTH)
        h = h + jnp.concatenate([mix_main, mo.astype(h.dtype)], axis=-1) @ w_out[l]
        gt, up = jnp.split(rms_norm(h, norm_ffn[l]) @ w_gate_up[l], 2, axis=-1)
        h = h + (jax.nn.silu(gt) * up) @ w_down[l]
        if l == N_A_LAYERS - 1:
            k_sh, v_sh = jnp.split(rms_norm(h, kv_norm) @ w_kv, 2, axis=-1)
            k_sh = rope(rms_norm(k_sh.reshape(Bn, S, B_HEADS, HEAD_DIM), b_knorm), pos)
            v_sh = v_sh.reshape(Bn, S, B_HEADS, HEAD_DIM)
    return h
```

```cpp
#include <hip/hip_runtime.h>
#include <stdint.h>

typedef unsigned short bf16_t;
typedef short bf16x8 __attribute__((ext_vector_type(8)));
typedef float f32x4 __attribute__((ext_vector_type(4)));
typedef unsigned u32x4 __attribute__((ext_vector_type(4)));
typedef unsigned u32x2 __attribute__((ext_vector_type(2)));

constexpr int DM = 1024, BATCH = 8, SEQ = 4096, T = BATCH * SEQ;
constexpr int HD = 128, NH = 6, AW = 768;
constexpr int MEMT = 256, MH = 4, MHD = 64, MW = 256, MROWS = BATCH * MEMT;
constexpr int A_COLS = 4 * AW + MW;
constexpr int B_COLS = 3 * AW + MW;
constexpr int KVB_COLS = 2 * AW + B_COLS;
constexpr int FFN = 2816;
constexpr float EPS = 1e-6f;
constexpr float LOG2E = 1.4426950408889634f;

constexpr size_t MiB = 1u << 20;
constexpr size_t WS_WA    = 0;
constexpr size_t WS_WKVB  = WS_WA + 7 * MiB;
constexpr size_t WS_WO    = WS_WKVB + 8 * MiB;
constexpr size_t WS_WGU   = WS_WO + 4 * MiB;
constexpr size_t WS_WD    = WS_WGU + 22 * MiB;
constexpr size_t WS_WMKV  = WS_WD + 11 * MiB;
constexpr size_t WS_SMALL = WS_WMKV + 2 * MiB;
constexpr size_t SM_LB = 0, SM_COS = 4096, SM_SIN = SM_COS + 4096 * 64 * 4, SM_SS0 = SM_SIN + 4096 * 64 * 4,
                 SM_SS1 = SM_SS0 + T * 4, SM_SS2 = SM_SS1 + T * 4, SM_SS3 = SM_SS2 + T * 4, SM_SSM = SM_SS3 + T * 4, SM_END = SM_SSM + MROWS * 4;
static_assert(SM_END <= 4 * MiB, "small");
constexpr size_t WS_XB    = WS_SMALL + 4 * MiB;
constexpr size_t WS_MEMB  = WS_XB + 64 * MiB;
constexpr size_t WS_MK    = WS_MEMB + 4 * MiB;
constexpr size_t WS_MV    = WS_MK + 2 * MiB;
constexpr size_t WS_R1    = WS_MV + 2 * MiB;
constexpr size_t WS_QS    = WS_R1;
constexpr size_t WS_VV    = WS_QS + 48 * MiB;
constexpr size_t WS_SG    = WS_VV + 48 * MiB;
constexpr size_t WS_MQ0   = WS_SG + 48 * MiB;
constexpr size_t WS_LF    = WS_MQ0 + 16 * MiB;
constexpr size_t WS_MIX   = WS_R1 + 256 * MiB;
constexpr size_t WS_TMP   = WS_MIX + 64 * MiB;
constexpr size_t WS_ACT   = WS_R1;
constexpr size_t WS_TMP2  = WS_ACT + 176 * MiB;
constexpr size_t WS_KR    = WS_R1;
constexpr size_t WS_VS    = WS_KR + 48 * MiB;
constexpr size_t WS_QG    = WS_VS + 48 * MiB;
constexpr size_t WS_MQ1   = WS_QG + 144 * MiB;
constexpr size_t WS_END   = 512 * MiB;

__device__ __forceinline__ float bf2f(bf16_t v) { return __uint_as_float((unsigned)v << 16); }
__device__ __forceinline__ bf16_t f2bf(float f) { unsigned u = __float_as_uint(f); return (bf16_t)((u + 0x7fffu + ((u >> 16) & 1u)) >> 16); }
__device__ __forceinline__ float silu_f(float v) { return v / (1.f + __expf(-v)); }
__device__ __forceinline__ float wave_sum(float v) {
#pragma unroll
    for (int o = 1; o < 64; o <<= 1) v += __shfl_xor(v, o);
    return v;
}
__device__ __forceinline__ float wave_max(float v) {
#pragma unroll
    for (int o = 1; o < 64; o <<= 1) v = fmaxf(v, __shfl_xor(v, o));
    return v;
}

namespace nv {
__global__ void wt_kernel(const float* __restrict__ W, const float* __restrict__ gain, bf16_t* __restrict__ out, int K, int N, int row_off) {
    __shared__ float tile[32][33];
    const int n0 = blockIdx.x * 32, k0 = blockIdx.y * 32;
    const int tx = threadIdx.x & 31, ty = threadIdx.x >> 5;
    for (int i = ty; i < 32; i += 8) tile[i][tx] = W[(size_t)(k0 + i) * N + n0 + tx] * (gain ? gain[k0 + i] : 1.f);
    __syncthreads();
    for (int i = ty; i < 32; i += 8) out[(size_t)(row_off + n0 + i) * K + k0 + tx] = f2bf(tile[tx][i]);
}
__global__ void rows_kernel(const float* __restrict__ x, bf16_t* __restrict__ xb, float* __restrict__ ss, int rows) {
    const int row = blockIdx.x * 4 + (threadIdx.x >> 6), lane = threadIdx.x & 63;
    if (row >= rows) return;
    const f32x4* xr = (const f32x4*)(x + (size_t)row * DM) + lane;
    float s = 0.f;
#pragma unroll
    for (int j = 0; j < 4; ++j) { f32x4 v = xr[64 * j]; s += v.x * v.x + v.y * v.y + v.z * v.z + v.w * v.w;
        u32x2 o; o.x = f2bf(v.x) | ((unsigned)f2bf(v.y) << 16); o.y = f2bf(v.z) | ((unsigned)f2bf(v.w) << 16);
        *((u32x2*)(xb + (size_t)row * DM) + lane + 64 * j) = o; }
    s = wave_sum(s);
    if (lane == 0) ss[row] = s;
}
__global__ void misc_kernel(const float* __restrict__ lb_logits, float* __restrict__ sm) {
    const int i = blockIdx.x * blockDim.x + threadIdx.x;
    if (i < AW) { const float a0 = lb_logits[i], a1 = lb_logits[AW + i]; const float m = fmaxf(a0, a1); const float e0 = expf(a0 - m), e1 = expf(a1 - m); sm[SM_LB / 4 + i] = e0 / (e0 + e1); }
    if (i < 4096 * 64) { const int pos = i >> 6, fi = i & 63; const float inv = powf(10000.f, -(float)fi / 64.f); const float ang = (float)pos * inv;
        sm[SM_COS / 4 + i] = cosf(ang); sm[SM_SIN / 4 + i] = sinf(ang); }
    if (i < T) { sm[SM_SS1 / 4 + i] = 0.f; sm[SM_SS2 / 4 + i] = 0.f; sm[SM_SS3 / 4 + i] = 0.f; }
}
__global__ __launch_bounds__(256) void gemm_kernel(const bf16_t* __restrict__ A, const bf16_t* __restrict__ Bt, float* __restrict__ C, int K, int ldc) {
    const int wave = threadIdx.x >> 6, lane = threadIdx.x & 63, r = lane & 15, g = lane >> 4;
    const int m0 = blockIdx.y * 128 + (wave >> 1) * 64, n0 = blockIdx.x * 128 + (wave & 1) * 64;
    f32x4 acc[4][4];
#pragma unroll
    for (int i = 0; i < 4; ++i)
#pragma unroll
        for (int j = 0; j < 4; ++j) acc[i][j] = (f32x4){0.f, 0.f, 0.f, 0.f};
    for (int k0 = 0; k0 < K; k0 += 32) {
        bf16x8 a[4], b[4];
#pragma unroll
        for (int i = 0; i < 4; ++i) a[i] = *(const bf16x8*)(A + (size_t)(m0 + 16 * i + r) * K + k0 + 8 * g);
#pragma unroll
        for (int j = 0; j < 4; ++j) b[j] = *(const bf16x8*)(Bt + (size_t)(n0 + 16 * j + r) * K + k0 + 8 * g);
#pragma unroll
        for (int i = 0; i < 4; ++i)
#pragma unroll
            for (int j = 0; j < 4; ++j) acc[i][j] = __builtin_amdgcn_mfma_f32_16x16x32_bf16(a[i], b[j], acc[i][j], 0, 0, 0);
    }
#pragma unroll
    for (int i = 0; i < 4; ++i)
#pragma unroll
        for (int j = 0; j < 4; ++j)
#pragma unroll
            for (int e = 0; e < 4; ++e) C[(size_t)(m0 + 16 * i + 4 * g + e) * ldc + n0 + 16 * j + r] = acc[i][j][e];
}
__device__ __forceinline__ float rs_of(const float* ss, int row) { return rsqrtf(ss[row] * (1.f / DM) + EPS); }

__global__ __launch_bounds__(256) void epi_inproj0(const float* __restrict__ C, int row0, const float* __restrict__ ss, const float* __restrict__ lb, const float* __restrict__ mqn,
                                                   bf16_t* QS, float* LF, bf16_t* VV, bf16_t* SG, bf16_t* MQ) {
    const int lr = blockIdx.x, row = row0 + lr, tid = threadIdx.x;
    const float rs = rs_of(ss, row);
    const float* c = C + (size_t)lr * A_COLS;
    for (int d = tid; d < AW; d += 256) {
        QS[(size_t)row * AW + d] = f2bf(silu_f(c[d] * rs));
        const float z = c[AW + d] * rs, l = lb[d]; const float f = l + (1.f - l) / (1.f + __expf(-z));
        LF[(size_t)row * AW + d] = __logf(f);
        VV[(size_t)row * AW + d] = f2bf(c[2 * AW + d] * rs);
        SG[(size_t)row * AW + d] = f2bf(silu_f(c[3 * AW + d] * rs));
    }
    const int w = tid >> 6, lane = tid & 63;
    const float v = c[4 * AW + w * 64 + lane] * rs;
    const float s2 = wave_sum(v * v);
    const float r2 = rsqrtf(s2 * (1.f / 64.f) + EPS);
    MQ[(size_t)row * MW + w * 64 + lane] = f2bf(v * r2 * mqn[lane] * (0.125f * LOG2E));
}
__global__ __launch_bounds__(256) void epi_memkv(const float* __restrict__ C, const float* __restrict__ ss, const float* __restrict__ mkn, bf16_t* MK, bf16_t* MV) {
    const int row = blockIdx.x, tid = threadIdx.x, w = tid >> 6, lane = tid & 63;
    const float rs = rs_of(ss, row);
    const float* c = C + (size_t)row * 1024;
    for (int l = 0; l < 2; ++l) {
        const float v = c[l * 512 + w * 64 + lane] * rs;
        const float s2 = wave_sum(v * v);
        const float r2 = rsqrtf(s2 * (1.f / 64.f) + EPS);
        MK[((size_t)l * MROWS + row) * MW + w * 64 + lane] = f2bf(v * r2 * mkn[l * 64 + lane]);
        MV[((size_t)l * MROWS + row) * MW + tid] = f2bf(c[l * 512 + 256 + tid] * rs);
    }
}
__global__ __launch_bounds__(256) void epi_resid(const float* __restrict__ C, int row0, const float* base, float* H, bf16_t* HB, float* ssn) {
    __shared__ float red[4];
    const int lr = blockIdx.x, row = row0 + lr, tid = threadIdx.x;
    float s = 0.f;
    for (int d = tid; d < DM; d += 256) { const float v = base[(size_t)row * DM + d] + C[(size_t)lr * DM + d]; H[(size_t)row * DM + d] = v; if (HB) HB[(size_t)row * DM + d] = f2bf(v); s += v * v; }
    s = wave_sum(s);
    if ((tid & 63) == 0) red[tid >> 6] = s;
    __syncthreads();
    if (tid == 0 && ssn) ssn[row] = red[0] + red[1] + red[2] + red[3];
}
__global__ __launch_bounds__(256) void epi_gateup(const float* __restrict__ C, int row0, const float* __restrict__ ss, bf16_t* ACT) {
    const int lr = blockIdx.x, row = row0 + lr, tid = threadIdx.x;
    const float rs = rs_of(ss, row);
    const float* c = C + (size_t)lr * (2 * FFN);
    for (int j = tid; j < FFN; j += 256) ACT[(size_t)row * FFN + j] = f2bf(silu_f(c[j] * rs) * (c[FFN + j] * rs));
}
__global__ __launch_bounds__(256) void epi_kvb(const float* __restrict__ C, int row0, const float* __restrict__ ss, const float* __restrict__ knorm, const float* __restrict__ qnorm  ,
                                               const float* __restrict__ mqn, const float* __restrict__ cs, const float* __restrict__ sn,
                                               bf16_t* KR, bf16_t* VS, bf16_t* QG, bf16_t* MQ) {
    const int lr = blockIdx.x, row = row0 + lr, tid = threadIdx.x, w = tid >> 6, lane = tid & 63;
    const int pos = row & (SEQ - 1);
    const float rs = rs_of(ss, row);
    const float* c = C + (size_t)lr * KVB_COLS;
    const float co = cs[pos * 64 + lane], si = sn[pos * 64 + lane];
    for (int hv = w; hv < 30; hv += 4) {
        const float x1 = c[hv * 128 + lane] * rs, x2 = c[hv * 128 + 64 + lane] * rs;
        if (hv >= 6 && hv < 12) { VS[(size_t)row * AW + (hv - 6) * 128 + lane] = f2bf(x1); VS[(size_t)row * AW + (hv - 6) * 128 + 64 + lane] = f2bf(x2); continue; }
        const float s2 = wave_sum(x1 * x1 + x2 * x2);
        const float r2 = rsqrtf(s2 * (1.f / 128.f) + EPS);
        const float* gn = hv < 6 ? knorm : qnorm + ((hv - 12) / 6) * 128;
        const float sc = hv < 6 ? 1.f : (0.08838834764831845f * LOG2E);
        const float y1 = x1 * r2 * gn[lane] * sc, y2 = x2 * r2 * gn[64 + lane] * sc;
        const float o1 = y1 * co - y2 * si, o2 = y2 * co + y1 * si;
        bf16_t* dst = hv < 6 ? KR + (size_t)row * AW + hv * 128 : QG + ((size_t)((hv - 12) / 6) * T + row) * AW + ((hv - 12) % 6) * 128;
        dst[lane] = f2bf(o1); dst[64 + lane] = f2bf(o2);
    }
    const float v = c[30 * 128 + w * 64 + lane] * rs;
    const float s2 = wave_sum(v * v);
    const float r2 = rsqrtf(s2 * (1.f / 64.f) + EPS);
    MQ[(size_t)row * MW + w * 64 + lane] = f2bf(v * r2 * mqn[lane] * (0.125f * LOG2E));
}
__global__ __launch_bounds__(256) void hgrn_kernel(const bf16_t* __restrict__ QS, const float* __restrict__ LF, const bf16_t* __restrict__ VV, const bf16_t* __restrict__ SG,
                                                   const float* __restrict__ onorm, bf16_t* MIX) {
    __shared__ float qs[128], kk[128], ff[128], vv[128], part[256], red[2];
    const int b = blockIdx.x / NH, h = blockIdx.x % NH, tid = threadIdx.x, dv = tid & 127, half = tid >> 7;
    float S[64];
#pragma unroll
    for (int i = 0; i < 64; ++i) S[i] = 0.f;
    for (int t = 0; t < SEQ; ++t) {
        const size_t off = (size_t)(b * SEQ + t) * AW + h * 128;
        if (tid < 128) { const float f = __expf(LF[off + tid]); ff[tid] = f; kk[tid] = 1.f - f; qs[tid] = bf2f(QS[off + tid]); vv[tid] = bf2f(VV[off + tid]); }
        __syncthreads();
        const float v = vv[dv]; float o = 0.f;
#pragma unroll
        for (int i = 0; i < 64; ++i) { const int dk = half * 64 + i; S[i] = ff[dk] * S[i] + kk[dk] * v; o += S[i] * qs[dk]; }
        part[tid] = o;
        __syncthreads();
        if (tid < 128) { o = part[tid] + part[tid + 128]; const float s2 = wave_sum(o * o); if ((tid & 63) == 0) red[tid >> 6] = s2; part[tid] = o; }
        __syncthreads();
        if (tid < 128) { const float r2 = rsqrtf((red[0] + red[1]) * (1.f / 128.f) + EPS);
            MIX[(size_t)(b * SEQ + t) * DM + h * 128 + tid] = f2bf(part[tid] * r2 * onorm[h * 128 + tid] * bf2f(SG[off + tid])); }
    }
}
__global__ __launch_bounds__(256) void memattn_kernel(const bf16_t* __restrict__ MQ, const bf16_t* __restrict__ MK, const bf16_t* __restrict__ MV, bf16_t* MIX) {
    __shared__ float qsh[4][64];
    const int w = threadIdx.x >> 6, lane = threadIdx.x & 63;
    const int item = blockIdx.x * 4 + w, row = item >> 2, hd = item & 3, b = row / SEQ;
    qsh[w][lane] = bf2f(MQ[(size_t)row * MW + hd * 64 + lane]);
    __syncthreads();
    float s[4], m = -1e30f;
#pragma unroll
    for (int j = 0; j < 4; ++j) { const bf16_t* kr = MK + ((size_t)(b * MEMT + lane + 64 * j)) * MW + hd * 64; float a = 0.f;
        for (int c8 = 0; c8 < 8; ++c8) { const bf16x8 kv = *(const bf16x8*)(kr + 8 * c8);
#pragma unroll
            for (int e = 0; e < 8; ++e) a += qsh[w][c8 * 8 + e] * bf2f((bf16_t)kv[e]); }
        s[j] = a; m = fmaxf(m, a); }
    m = wave_max(m);
    float l = 0.f;
#pragma unroll
    for (int j = 0; j < 4; ++j) { s[j] = exp2f(s[j] - m); l += s[j]; }
    l = wave_sum(l);
    float o = 0.f;
#pragma unroll
    for (int j = 0; j < 4; ++j)
        for (int kq = 0; kq < 64; ++kq) { const float p = __shfl(s[j], kq); o += p * bf2f(MV[((size_t)(b * MEMT + kq + 64 * j)) * MW + hd * 64 + lane]); }
    MIX[(size_t)row * DM + AW + hd * 64 + lane] = f2bf(o / l);
}
__global__ __launch_bounds__(256) void dilattn_kernel(const bf16_t* __restrict__ QG, const bf16_t* __restrict__ KR, const bf16_t* __restrict__ VS, bf16_t* MIX) {
    __shared__ float qsh[4][3][128];
    const int w = threadIdx.x >> 6, lane = threadIdx.x & 63;
    const int item = blockIdx.x * 4 + w, row = item / NH, h = item % NH, b = row / SEQ, t = row % SEQ;
#pragma unroll
    for (int g = 0; g < 3; ++g) { qsh[w][g][lane] = bf2f(QG[((size_t)g * T + row) * AW + h * 128 + lane]); qsh[w][g][64 + lane] = bf2f(QG[((size_t)g * T + row) * AW + h * 128 + 64 + lane]); }
    __syncthreads();
    float s[3][3]; float m = -1e30f;
#pragma unroll
    for (int g = 0; g < 3; ++g) { const int dil = g == 0 ? 1 : (g == 1 ? 4 : 16);
#pragma unroll
        for (int jj = 0; jj < 3; ++jj) { const int j = lane + 64 * jj; const int pk = t - j * dil; float a = -1e30f;
            if (j <= 128 && pk >= 0) { const bf16_t* kr = KR + ((size_t)(b * SEQ + pk)) * AW + h * 128; a = 0.f; for (int c8 = 0; c8 < 16; ++c8) { const bf16x8 kv = *(const bf16x8*)(kr + 8 * c8);
#pragma unroll
                for (int e = 0; e < 8; ++e) a += qsh[w][g][c8 * 8 + e] * bf2f((bf16_t)kv[e]); } }
            s[g][jj] = a; m = fmaxf(m, a); } }
    m = wave_max(m);
    float l = 0.f;
#pragma unroll
    for (int g = 0; g < 3; ++g)
#pragma unroll
        for (int jj = 0; jj < 3; ++jj) { const float p = s[g][jj] > -1e29f ? exp2f(s[g][jj] - m) : 0.f; s[g][jj] = p; l += p; }
    l = wave_sum(l);
    float o0 = 0.f, o1 = 0.f;
#pragma unroll
    for (int g = 0; g < 3; ++g) { const int dil = g == 0 ? 1 : (g == 1 ? 4 : 16);
#pragma unroll
        for (int jj = 0; jj < 3; ++jj) {
            const int nk = jj < 2 ? 64 : 1;
            for (int kq = 0; kq < nk; ++kq) { const int j = kq + 64 * jj; const int pk = t - j * dil; if (pk < 0) break;
                const float p = __shfl(s[g][jj], kq);
                const bf16_t* vr = VS + ((size_t)(b * SEQ + pk)) * AW + h * 128;
                o0 += p * bf2f(vr[lane]); o1 += p * bf2f(vr[64 + lane]); } } }
    MIX[(size_t)row * DM + h * 128 + lane] = f2bf(o0 / l); MIX[(size_t)row * DM + h * 128 + 64 + lane] = f2bf(o1 / l);
}
}

extern "C" void kernel_launch(void* const* d_in, const int* in_sizes, int n_in, void* d_out, int out_size, void* d_ws, size_t ws_size, hipStream_t stream) {
    if (ws_size < WS_END || n_in != 19 || out_size != T * DM) return;
    const float* x = (const float*)d_in[0]; const float* mem = (const float*)d_in[1];
    const float* norm_mix = (const float*)d_in[2]; const float* norm_ffn = (const float*)d_in[3];
    const float* a_w_in = (const float*)d_in[4]; const float* a_lb = (const float*)d_in[5]; const float* a_onorm = (const float*)d_in[6];
    const float* b_w_in = (const float*)d_in[7]; const float* b_qnorm = (const float*)d_in[8]; const float* kv_norm = (const float*)d_in[9];
    const float* w_kv = (const float*)d_in[10]; const float* b_knorm = (const float*)d_in[11]; const float* mem_norm = (const float*)d_in[12];
    const float* w_mem_kv = (const float*)d_in[13]; const float* mem_qnorm = (const float*)d_in[14]; const float* mem_knorm = (const float*)d_in[15];
    const float* w_out = (const float*)d_in[16]; const float* w_gate_up = (const float*)d_in[17]; const float* w_down = (const float*)d_in[18];
    char* ws = (char*)d_ws;
    bf16_t* WA = (bf16_t*)(ws + WS_WA); bf16_t* WKVB = (bf16_t*)(ws + WS_WKVB); bf16_t* WO = (bf16_t*)(ws + WS_WO); bf16_t* WGU = (bf16_t*)(ws + WS_WGU);
    bf16_t* WD = (bf16_t*)(ws + WS_WD); bf16_t* WMKV = (bf16_t*)(ws + WS_WMKV);
    float* sm = (float*)(ws + WS_SMALL);
    float* LB = sm + SM_LB / 4; float* COS = sm + SM_COS / 4; float* SIN = sm + SM_SIN / 4;
    float* SS0 = sm + SM_SS0 / 4; float* SS1 = sm + SM_SS1 / 4; float* SS2 = sm + SM_SS2 / 4; float* SS3 = sm + SM_SS3 / 4; float* SSM = sm + SM_SSM / 4;
    bf16_t* XB = (bf16_t*)(ws + WS_XB); bf16_t* MEMB = (bf16_t*)(ws + WS_MEMB); bf16_t* MK = (bf16_t*)(ws + WS_MK); bf16_t* MV = (bf16_t*)(ws + WS_MV);
    bf16_t* QS = (bf16_t*)(ws + WS_QS); bf16_t* VV = (bf16_t*)(ws + WS_VV); bf16_t* SG = (bf16_t*)(ws + WS_SG); bf16_t* MQ0 = (bf16_t*)(ws + WS_MQ0);
    float* LF = (float*)(ws + WS_LF);
    bf16_t* KR = (bf16_t*)(ws + WS_KR); bf16_t* VS = (bf16_t*)(ws + WS_VS); bf16_t* QG = (bf16_t*)(ws + WS_QG); bf16_t* MQ1 = (bf16_t*)(ws + WS_MQ1);
    bf16_t* MIX = (bf16_t*)(ws + WS_MIX); bf16_t* ACT = (bf16_t*)(ws + WS_ACT);
    float* TMP = (float*)(ws + WS_TMP); float* TMP2 = (float*)(ws + WS_TMP2);
    float* H = (float*)d_out;

    auto wt = [&](const float* W, const float* g, bf16_t* o, int K, int N, int ro) { hipLaunchKernelGGL(nv::wt_kernel, dim3(N / 32, K / 32), dim3(256), 0, stream, W, g, o, K, N, ro); };
    wt(a_w_in, norm_mix, WA, DM, A_COLS, 0);
    wt(w_kv, kv_norm, WKVB, DM, 2 * AW, 0);
    wt(b_w_in, norm_mix + DM, WKVB, DM, B_COLS, 2 * AW);
    for (int l = 0; l < 2; ++l) {
        wt(w_out + (size_t)l * DM * DM, nullptr, WO + (size_t)l * DM * DM, DM, DM, 0);
        wt(w_gate_up + (size_t)l * DM * 2 * FFN, norm_ffn + l * DM, WGU + (size_t)l * 2 * FFN * DM, DM, 2 * FFN, 0);
        wt(w_down + (size_t)l * FFN * DM, nullptr, WD + (size_t)l * DM * FFN, FFN, DM, 0);
        wt(w_mem_kv + (size_t)l * DM * 512, mem_norm + l * DM, WMKV, DM, 512, l * 512);
    }
    hipLaunchKernelGGL(nv::misc_kernel, dim3(4096 * 64 / 256), dim3(256), 0, stream, a_lb, sm);
    hipLaunchKernelGGL(nv::rows_kernel, dim3(T / 4), dim3(256), 0, stream, x, XB, SS0, T);
    hipLaunchKernelGGL(nv::rows_kernel, dim3(MROWS / 4), dim3(256), 0, stream, mem, MEMB, SSM, MROWS);
    hipLaunchKernelGGL(nv::gemm_kernel, dim3(1024 / 128, MROWS / 128), dim3(256), 0, stream, MEMB, WMKV, TMP, DM, 1024);
    hipLaunchKernelGGL(nv::epi_memkv, dim3(MROWS), dim3(256), 0, stream, TMP, SSM, mem_knorm, MK, MV);
    for (int r0 = 0; r0 < T; r0 += 4096) {
        hipLaunchKernelGGL(nv::gemm_kernel, dim3(A_COLS / 128, 4096 / 128), dim3(256), 0, stream, XB + (size_t)r0 * DM, WA, TMP, DM, A_COLS);
        hipLaunchKernelGGL(nv::epi_inproj0, dim3(4096), dim3(256), 0, stream, TMP, r0, SS0, LB, mem_qnorm, QS, LF, VV, SG, MQ0);
    }
    hipLaunchKernelGGL(nv::hgrn_kernel, dim3(BATCH * NH), dim3(256), 0, stream, QS, LF, VV, SG, a_onorm, MIX);
    hipLaunchKernelGGL(nv::memattn_kernel, dim3(T), dim3(256), 0, stream, MQ0, MK, MV, MIX);
    for (int l = 0; l < 2; ++l) {
        float* ssa = l == 0 ? SS1 : SS3;
        for (int r0 = 0; r0 < T; r0 += 8192) {
            hipLaunchKernelGGL(nv::gemm_kernel, dim3(DM / 128, 8192 / 128), dim3(256), 0, stream, MIX + (size_t)r0 * DM, WO + (size_t)l * DM * DM, TMP, DM, DM);
            hipLaunchKernelGGL(nv::epi_resid, dim3(8192), dim3(256), 0, stream, TMP, r0, l == 0 ? x : (const float*)H, H, XB, ssa);
        }
        for (int r0 = 0; r0 < T; r0 += 4096) {
            hipLaunchKernelGGL(nv::gemm_kernel, dim3(2 * FFN / 128, 4096 / 128), dim3(256), 0, stream, XB + (size_t)r0 * DM, WGU + (size_t)l * 2 * FFN * DM, TMP2, DM, 2 * FFN);
            hipLaunchKernelGGL(nv::epi_gateup, dim3(4096), dim3(256), 0, stream, TMP2, r0, ssa, ACT);
        }
        for (int r0 = 0; r0 < T; r0 += 8192) {
            hipLaunchKernelGGL(nv::gemm_kernel, dim3(DM / 128, 8192 / 128), dim3(256), 0, stream, ACT + (size_t)r0 * FFN, WD + (size_t)l * DM * FFN, TMP2, FFN, DM);
            hipLaunchKernelGGL(nv::epi_resid, dim3(8192), dim3(256), 0, stream, TMP2, r0, (const float*)H, H, l == 0 ? XB : (bf16_t*)nullptr, l == 0 ? SS2 : (float*)nullptr);
        }
        if (l == 0) {
            for (int r0 = 0; r0 < T; r0 += 2048) {
                hipLaunchKernelGGL(nv::gemm_kernel, dim3(KVB_COLS / 128, 2048 / 128), dim3(256), 0, stream, XB + (size_t)r0 * DM, WKVB, TMP, DM, KVB_COLS);
                hipLaunchKernelGGL(nv::epi_kvb, dim3(2048), dim3(256), 0, stream, TMP, r0, SS2, b_knorm, b_qnorm, mem_qnorm + 64, COS, SIN, KR, VS, QG, MQ1);
            }
            hipLaunchKernelGGL(nv::dilattn_kernel, dim3(T * NH / 4), dim3(256), 0, stream, QG, KR, VS, MIX);
            hipLaunchKernelGGL(nv::memattn_kernel, dim3(T), dim3(256), 0, stream, MQ1, MK + (size_t)MROWS * MW, MV + (size_t)MROWS * MW, MIX);
        }
    }
}
```

```cpp
#include <hip/hip_runtime.h>
#include <stdint.h>

typedef unsigned short bf16_t;
typedef short bf16x8 __attribute__((ext_vector_type(8)));
typedef float f32x4 __attribute__((ext_vector_type(4)));
typedef unsigned u32x4 __attribute__((ext_vector_type(4)));
typedef unsigned u32x2 __attribute__((ext_vector_type(2)));

constexpr int DM = 1024, BATCH = 8, SEQ = 4096, T = BATCH * SEQ;
constexpr int HD = 128, NH = 6, AW = 768;
constexpr int MEMT = 256, MH = 4, MHD = 64, MW = 256, MROWS = BATCH * MEMT;
constexpr int A_COLS = 4 * AW + MW;
constexpr int B_COLS = 3 * AW + MW;
constexpr int KVB_COLS = 2 * AW + B_COLS;
constexpr int FFN = 2816;
constexpr float EPS = 1e-6f;
constexpr float LOG2E = 1.4426950408889634f;

constexpr size_t MiB = 1u << 20;
constexpr size_t WS_WA    = 0;
constexpr size_t WS_WKVB  = WS_WA + 7 * MiB;
constexpr size_t WS_WO    = WS_WKVB + 8 * MiB;
constexpr size_t WS_WGU   = WS_WO + 4 * MiB;
constexpr size_t WS_WD    = WS_WGU + 22 * MiB;
constexpr size_t WS_WMKV  = WS_WD + 11 * MiB;
constexpr size_t WS_SMALL = WS_WMKV + 2 * MiB;
constexpr size_t SM_LB = 0, SM_COS = 4096, SM_SIN = SM_COS + 4096 * 64 * 4, SM_SS0 = SM_SIN + 4096 * 64 * 4,
                 SM_SS1 = SM_SS0 + T * 4, SM_SS2 = SM_SS1 + T * 4, SM_SS3 = SM_SS2 + T * 4, SM_SSM = SM_SS3 + T * 4, SM_END = SM_SSM + MROWS * 4;
static_assert(SM_END <= 4 * MiB, "small");
constexpr size_t WS_XB    = WS_SMALL + 4 * MiB;
constexpr size_t WS_MEMB  = WS_XB + 64 * MiB;
constexpr size_t WS_MK    = WS_MEMB + 4 * MiB;
constexpr size_t WS_MV    = WS_MK + 2 * MiB;
constexpr size_t WS_R1    = WS_MV + 2 * MiB;
constexpr size_t WS_QS    = WS_R1;
constexpr size_t WS_VV    = WS_QS + 48 * MiB;
constexpr size_t WS_SG    = WS_VV + 48 * MiB;
constexpr size_t WS_MQ0   = WS_SG + 48 * MiB;
constexpr size_t WS_LF    = WS_MQ0 + 16 * MiB;
constexpr size_t WS_MIX   = WS_R1 + 256 * MiB;
constexpr size_t WS_TMP   = WS_MIX + 64 * MiB;
constexpr size_t WS_ACT   = WS_R1;
constexpr size_t WS_TMP2  = WS_ACT + 176 * MiB;
constexpr size_t WS_KR    = WS_R1;
constexpr size_t WS_VS    = WS_KR + 48 * MiB;
constexpr size_t WS_QG    = WS_VS + 48 * MiB;
constexpr size_t WS_MQ1   = WS_QG + 144 * MiB;
constexpr size_t WS_LSE   = WS_TMP;
constexpr size_t WS_END   = 512 * MiB;

__device__ __forceinline__ float bf2f(bf16_t v) { return __uint_as_float((unsigned)v << 16); }
__device__ __forceinline__ bf16_t f2bf(float f) { unsigned u = __float_as_uint(f); return (bf16_t)((u + 0x7fffu + ((u >> 16) & 1u)) >> 16); }
__device__ __forceinline__ float silu_f(float v) { return v / (1.f + __expf(-v)); }
__device__ __forceinline__ float wave_sum(float v) {
#pragma unroll
    for (int o = 1; o < 64; o <<= 1) v += __shfl_xor(v, o);
    return v;
}
__device__ __forceinline__ float wave_max(float v) {
#pragma unroll
    for (int o = 1; o < 64; o <<= 1) v = fmaxf(v, __shfl_xor(v, o));
    return v;
}

namespace nv {
__global__ void wt_kernel(const float* __restrict__ W, const float* __restrict__ gain, bf16_t* __restrict__ out, int K, int N, int row_off) {
    __shared__ float tile[32][33];
    const int n0 = blockIdx.x * 32, k0 = blockIdx.y * 32;
    const int tx = threadIdx.x & 31, ty = threadIdx.x >> 5;
    for (int i = ty; i < 32; i += 8) tile[i][tx] = W[(size_t)(k0 + i) * N + n0 + tx] * (gain ? gain[k0 + i] : 1.f);
    __syncthreads();
    for (int i = ty; i < 32; i += 8) out[(size_t)(row_off + n0 + i) * K + k0 + tx] = f2bf(tile[tx][i]);
}
__global__ void rows_kernel(const float* __restrict__ x, bf16_t* __restrict__ xb, float* __restrict__ ss, int rows) {
    const int row = blockIdx.x * 4 + (threadIdx.x >> 6), lane = threadIdx.x & 63;
    if (row >= rows) return;
    const f32x4* xr = (const f32x4*)(x + (size_t)row * DM) + lane;
    float s = 0.f;
#pragma unroll
    for (int j = 0; j < 4; ++j) { f32x4 v = xr[64 * j]; s += v.x * v.x + v.y * v.y + v.z * v.z + v.w * v.w;
        u32x2 o; o.x = f2bf(v.x) | ((unsigned)f2bf(v.y) << 16); o.y = f2bf(v.z) | ((unsigned)f2bf(v.w) << 16);
        *((u32x2*)(xb + (size_t)row * DM) + lane + 64 * j) = o; }
    s = wave_sum(s);
    if (lane == 0) ss[row] = s;
}
__global__ void misc_kernel(const float* __restrict__ lb_logits, float* __restrict__ sm) {
    const int i = blockIdx.x * blockDim.x + threadIdx.x;
    if (i < AW) { const float a0 = lb_logits[i], a1 = lb_logits[AW + i]; const float m = fmaxf(a0, a1); const float e0 = expf(a0 - m), e1 = expf(a1 - m); sm[SM_LB / 4 + i] = e0 / (e0 + e1); }
    if (i < 4096 * 64) { const int pos = i >> 6, fi = i & 63; const float inv = powf(10000.f, -(float)fi / 64.f); const float ang = (float)pos * inv;
        sm[SM_COS / 4 + i] = cosf(ang); sm[SM_SIN / 4 + i] = sinf(ang); }
    if (i < T) { sm[SM_SS1 / 4 + i] = 0.f; sm[SM_SS2 / 4 + i] = 0.f; sm[SM_SS3 / 4 + i] = 0.f; }
}
__global__ __launch_bounds__(256) void gemm_kernel(const bf16_t* __restrict__ A, const bf16_t* __restrict__ Bt, float* __restrict__ C, int K, int ldc) {
    const int wave = threadIdx.x >> 6, lane = threadIdx.x & 63, r = lane & 15, g = lane >> 4;
    const int m0 = blockIdx.y * 128 + (wave >> 1) * 64, n0 = blockIdx.x * 128 + (wave & 1) * 64;
    f32x4 acc[4][4];
#pragma unroll
    for (int i = 0; i < 4; ++i)
#pragma unroll
        for (int j = 0; j < 4; ++j) acc[i][j] = (f32x4){0.f, 0.f, 0.f, 0.f};
    for (int k0 = 0; k0 < K; k0 += 32) {
        bf16x8 a[4], b[4];
#pragma unroll
        for (int i = 0; i < 4; ++i) a[i] = *(const bf16x8*)(A + (size_t)(m0 + 16 * i + r) * K + k0 + 8 * g);
#pragma unroll
        for (int j = 0; j < 4; ++j) b[j] = *(const bf16x8*)(Bt + (size_t)(n0 + 16 * j + r) * K + k0 + 8 * g);
#pragma unroll
        for (int i = 0; i < 4; ++i)
#pragma unroll
            for (int j = 0; j < 4; ++j) acc[i][j] = __builtin_amdgcn_mfma_f32_16x16x32_bf16(a[i], b[j], acc[i][j], 0, 0, 0);
    }
#pragma unroll
    for (int i = 0; i < 4; ++i)
#pragma unroll
        for (int j = 0; j < 4; ++j)
#pragma unroll
            for (int e = 0; e < 4; ++e) C[(size_t)(m0 + 16 * i + 4 * g + e) * ldc + n0 + 16 * j + r] = acc[i][j][e];
}
__device__ __forceinline__ float rs_of(const float* ss, int row) { return rsqrtf(ss[row] * (1.f / DM) + EPS); }

__global__ __launch_bounds__(256) void epi_inproj0(const float* __restrict__ C, int row0, const float* __restrict__ ss, const float* __restrict__ lb, const float* __restrict__ mqn,
                                                   bf16_t* QS, float* LF, bf16_t* VV, bf16_t* SG, bf16_t* MQ) {
    const int lr = blockIdx.x, row = row0 + lr, tid = threadIdx.x;
    const float rs = rs_of(ss, row);
    const float* c = C + (size_t)lr * A_COLS;
    for (int d = tid; d < AW; d += 256) {
        QS[(size_t)row * AW + d] = f2bf(silu_f(c[d] * rs));
        const float z = c[AW + d] * rs, l = lb[d]; const float f = l + (1.f - l) / (1.f + __expf(-z));
        LF[(size_t)row * AW + d] = __logf(f);
        VV[(size_t)row * AW + d] = f2bf(c[2 * AW + d] * rs);
        SG[(size_t)row * AW + d] = f2bf(silu_f(c[3 * AW + d] * rs));
    }
    const int w = tid >> 6, lane = tid & 63;
    const float v = c[4 * AW + w * 64 + lane] * rs;
    const float s2 = wave_sum(v * v);
    const float r2 = rsqrtf(s2 * (1.f / 64.f) + EPS);
    MQ[(size_t)row * MW + w * 64 + lane] = f2bf(v * r2 * mqn[lane] * (0.125f * LOG2E));
}
__global__ __launch_bounds__(256) void epi_memkv(const float* __restrict__ C, const float* __restrict__ ss, const float* __restrict__ mkn, bf16_t* MK, bf16_t* MV) {
    const int row = blockIdx.x, tid = threadIdx.x, w = tid >> 6, lane = tid & 63;
    const float rs = rs_of(ss, row);
    const float* c = C + (size_t)row * 1024;
    for (int l = 0; l < 2; ++l) {
        const float v = c[l * 512 + w * 64 + lane] * rs;
        const float s2 = wave_sum(v * v);
        const float r2 = rsqrtf(s2 * (1.f / 64.f) + EPS);
        MK[((size_t)l * MROWS + row) * MW + w * 64 + lane] = f2bf(v * r2 * mkn[l * 64 + lane]);
        MV[((size_t)l * MROWS + row) * MW + tid] = f2bf(c[l * 512 + 256 + tid] * rs);
    }
}
__global__ __launch_bounds__(256) void epi_resid(const float* __restrict__ C, int row0, const float* base, float* H, bf16_t* HB, float* ssn) {
    __shared__ float red[4];
    const int lr = blockIdx.x, row = row0 + lr, tid = threadIdx.x;
    float s = 0.f;
    for (int d = tid; d < DM; d += 256) { const float v = base[(size_t)row * DM + d] + C[(size_t)lr * DM + d]; H[(size_t)row * DM + d] = v; if (HB) HB[(size_t)row * DM + d] = f2bf(v); s += v * v; }
    s = wave_sum(s);
    if ((tid & 63) == 0) red[tid >> 6] = s;
    __syncthreads();
    if (tid == 0 && ssn) ssn[row] = red[0] + red[1] + red[2] + red[3];
}
__global__ __launch_bounds__(256) void epi_gateup(const float* __restrict__ C, int row0, const float* __restrict__ ss, bf16_t* ACT) {
    const int lr = blockIdx.x, row = row0 + lr, tid = threadIdx.x;
    const float rs = rs_of(ss, row);
    const float* c = C + (size_t)lr * (2 * FFN);
    for (int j = tid; j < FFN; j += 256) ACT[(size_t)row * FFN + j] = f2bf(silu_f(c[j] * rs) * (c[FFN + j] * rs));
}
__global__ __launch_bounds__(256) void epi_kvb(const float* __restrict__ C, int row0, const float* __restrict__ ss, const float* __restrict__ knorm, const float* __restrict__ qnorm  ,
                                               const float* __restrict__ mqn, const float* __restrict__ cs, const float* __restrict__ sn,
                                               bf16_t* KR, bf16_t* VS, bf16_t* QG, bf16_t* MQ) {
    const int lr = blockIdx.x, row = row0 + lr, tid = threadIdx.x, w = tid >> 6, lane = tid & 63;
    const int pos = row & (SEQ - 1);
    const float rs = rs_of(ss, row);
    const float* c = C + (size_t)lr * KVB_COLS;
    const float co = cs[pos * 64 + lane], si = sn[pos * 64 + lane];
    for (int hv = w; hv < 30; hv += 4) {
        const float x1 = c[hv * 128 + lane] * rs, x2 = c[hv * 128 + 64 + lane] * rs;
        if (hv >= 6 && hv < 12) { VS[(size_t)row * AW + (hv - 6) * 128 + lane] = f2bf(x1); VS[(size_t)row * AW + (hv - 6) * 128 + 64 + lane] = f2bf(x2); continue; }
        const float s2 = wave_sum(x1 * x1 + x2 * x2);
        const float r2 = rsqrtf(s2 * (1.f / 128.f) + EPS);
        const float* gn = hv < 6 ? knorm : qnorm + ((hv - 12) / 6) * 128;
        const float sc = hv < 6 ? 1.f : (0.08838834764831845f * LOG2E);
        const float y1 = x1 * r2 * gn[lane] * sc, y2 = x2 * r2 * gn[64 + lane] * sc;
        const float o1 = y1 * co - y2 * si, o2 = y2 * co + y1 * si;
        bf16_t* dst = hv < 6 ? KR + (size_t)row * AW + hv * 128 : QG + ((size_t)((hv - 12) / 6) * T + row) * AW + ((hv - 12) % 6) * 128;
        dst[lane] = f2bf(o1); dst[64 + lane] = f2bf(o2);
    }
    const float v = c[30 * 128 + w * 64 + lane] * rs;
    const float s2 = wave_sum(v * v);
    const float r2 = rsqrtf(s2 * (1.f / 64.f) + EPS);
    MQ[(size_t)row * MW + w * 64 + lane] = f2bf(v * r2 * mqn[lane] * (0.125f * LOG2E));
}
__global__ __launch_bounds__(256) void hgrn_kernel(const bf16_t* __restrict__ QS, const float* __restrict__ LF, const bf16_t* __restrict__ VV, const bf16_t* __restrict__ SG,
                                                   const float* __restrict__ onorm, bf16_t* MIX) {
    __shared__ float qs[128], kk[128], ff[128], vv[128], part[256], red[2];
    const int b = blockIdx.x / NH, h = blockIdx.x % NH, tid = threadIdx.x, dv = tid & 127, half = tid >> 7;
    float S[64];
#pragma unroll
    for (int i = 0; i < 64; ++i) S[i] = 0.f;
    for (int t = 0; t < SEQ; ++t) {
        const size_t off = (size_t)(b * SEQ + t) * AW + h * 128;
        if (tid < 128) { const float f = __expf(LF[off + tid]); ff[tid] = f; kk[tid] = 1.f - f; qs[tid] = bf2f(QS[off + tid]); vv[tid] = bf2f(VV[off + tid]); }
        __syncthreads();
        const float v = vv[dv]; float o = 0.f;
#pragma unroll
        for (int i = 0; i < 64; ++i) { const int dk = half * 64 + i; S[i] = ff[dk] * S[i] + kk[dk] * v; o += S[i] * qs[dk]; }
        part[tid] = o;
        __syncthreads();
        if (tid < 128) { o = part[tid] + part[tid + 128]; const float s2 = wave_sum(o * o); if ((tid & 63) == 0) red[tid >> 6] = s2; part[tid] = o; }
        __syncthreads();
        if (tid < 128) { const float r2 = rsqrtf((red[0] + red[1]) * (1.f / 128.f) + EPS);
            MIX[(size_t)(b * SEQ + t) * DM + h * 128 + tid] = f2bf(part[tid] * r2 * onorm[h * 128 + tid] * bf2f(SG[off + tid])); }
    }
}
__global__ __launch_bounds__(256) void memattn_kernel(const bf16_t* __restrict__ MQ, const bf16_t* __restrict__ MK, const bf16_t* __restrict__ MV, bf16_t* MIX) {
    __shared__ float qsh[4][64];
    const int w = threadIdx.x >> 6, lane = threadIdx.x & 63;
    const int item = blockIdx.x * 4 + w, row = item >> 2, hd = item & 3, b = row / SEQ;
    qsh[w][lane] = bf2f(MQ[(size_t)row * MW + hd * 64 + lane]);
    __syncthreads();
    float s[4], m = -1e30f;
#pragma unroll
    for (int j = 0; j < 4; ++j) { const bf16_t* kr = MK + ((size_t)(b * MEMT + lane + 64 * j)) * MW + hd * 64; float a = 0.f;
        for (int c8 = 0; c8 < 8; ++c8) { const bf16x8 kv = *(const bf16x8*)(kr + 8 * c8);
#pragma unroll
            for (int e = 0; e < 8; ++e) a += qsh[w][c8 * 8 + e] * bf2f((bf16_t)kv[e]); }
        s[j] = a; m = fmaxf(m, a); }
    m = wave_max(m);
    float l = 0.f;
#pragma unroll
    for (int j = 0; j < 4; ++j) { s[j] = exp2f(s[j] - m); l += s[j]; }
    l = wave_sum(l);
    float o = 0.f;
#pragma unroll
    for (int j = 0; j < 4; ++j)
        for (int kq = 0; kq < 64; ++kq) { const float p = __shfl(s[j], kq); o += p * bf2f(MV[((size_t)(b * MEMT + kq + 64 * j)) * MW + hd * 64 + lane]); }
    MIX[(size_t)row * DM + AW + hd * 64 + lane] = f2bf(o / l);
}
__global__ __launch_bounds__(256) void dilattn_kernel(const bf16_t* __restrict__ QG, const bf16_t* __restrict__ KR, const bf16_t* __restrict__ VS, bf16_t* MIX) {
    __shared__ float qsh[4][3][128];
    const int w = threadIdx.x >> 6, lane = threadIdx.x & 63;
    const int item = blockIdx.x * 4 + w, row = item / NH, h = item % NH, b = row / SEQ, t = row % SEQ;
#pragma unroll
    for (int g = 0; g < 3; ++g) { qsh[w][g][lane] = bf2f(QG[((size_t)g * T + row) * AW + h * 128 + lane]); qsh[w][g][64 + lane] = bf2f(QG[((size_t)g * T + row) * AW + h * 128 + 64 + lane]); }
    __syncthreads();
    float s[3][3]; float m = -1e30f;
#pragma unroll
    for (int g = 0; g < 3; ++g) { const int dil = g == 0 ? 1 : (g == 1 ? 4 : 16);
#pragma unroll
        for (int jj = 0; jj < 3; ++jj) { const int j = lane + 64 * jj; const int pk = t - j * dil; float a = -1e30f;
            if (j <= 128 && pk >= 0) { const bf16_t* kr = KR + ((size_t)(b * SEQ + pk)) * AW + h * 128; a = 0.f; for (int c8 = 0; c8 < 16; ++c8) { const bf16x8 kv = *(const bf16x8*)(kr + 8 * c8);
#pragma unroll
                for (int e = 0; e < 8; ++e) a += qsh[w][g][c8 * 8 + e] * bf2f((bf16_t)kv[e]); } }
            s[g][jj] = a; m = fmaxf(m, a); } }
    m = wave_max(m);
    float l = 0.f;
#pragma unroll
    for (int g = 0; g < 3; ++g)
#pragma unroll
        for (int jj = 0; jj < 3; ++jj) { const float p = s[g][jj] > -1e29f ? exp2f(s[g][jj] - m) : 0.f; s[g][jj] = p; l += p; }
    l = wave_sum(l);
    float o0 = 0.f, o1 = 0.f;
#pragma unroll
    for (int g = 0; g < 3; ++g) { const int dil = g == 0 ? 1 : (g == 1 ? 4 : 16);
#pragma unroll
        for (int jj = 0; jj < 3; ++jj) {
            const int nk = jj < 2 ? 64 : 1;
            for (int kq = 0; kq < nk; ++kq) { const int j = kq + 64 * jj; const int pk = t - j * dil; if (pk < 0) break;
                const float p = __shfl(s[g][jj], kq);
                const bf16_t* vr = VS + ((size_t)(b * SEQ + pk)) * AW + h * 128;
                o0 += p * bf2f(vr[lane]); o1 += p * bf2f(vr[64 + lane]); } } }
    MIX[(size_t)row * DM + h * 128 + lane] = f2bf(o0 / l); MIX[(size_t)row * DM + h * 128 + 64 + lane] = f2bf(o1 / l);
}
}

#include <hip/hip_cooperative_groups.h>
namespace cg = cooperative_groups;
#define LAS __attribute__((address_space(3)))
#define GAS __attribute__((address_space(1)))

constexpr int NTHREADS = 512, NWAVES = 8;
constexpr int RING_BYTES = 131072;
constexpr int XSCR_OFF = RING_BYTES;
constexpr int LDS_BYTES = 147456;

__host__ __device__ __forceinline__ int rho_of(int r) { return 16 * ((r >> 2) & 1) + 4 * (r >> 3) + (r & 3); }
__host__ __device__ __forceinline__ int slot_std(int c) { return (c & ~31) + rho_of(c & 31); }
__host__ __device__ __forceinline__ int slot_rope(int d) { return 32 * ((d & 63) >> 4) + 16 * (d >> 6) + (d & 15); }
__host__ __device__ __forceinline__ int slot_mq(int c) { return 128 * ((c >> 5) & 1) + 32 * (c >> 6) + rho_of(c & 31); }
enum { MAP_WA = 0, MAP_KV = 1, MAP_BIN = 2, MAP_STD = 3, MAP_GU = 4, MAP_MKV0 = 5, MAP_MKV1 = 6 };
__device__ __forceinline__ int dst_row(int map, int n) {
    switch (map) {
    case MAP_WA:  return n < 3072 ? (n & ~127) + slot_std(n & 127) : 3072 + slot_mq(n - 3072);
    case MAP_KV:  return n < 768 ? (n & ~127) + slot_rope(n & 127) : (n & ~127) + slot_std(n & 127);
    case MAP_BIN: return n < 2304 ? 1536 + (n & ~127) + slot_rope(n & 127) : 3840 + slot_mq(n - 2304);
    case MAP_STD: return (n & ~127) + slot_std(n & 127);
    case MAP_GU:  return n < FFN ? 256 * (n >> 7) + slot_std(n & 127) : 256 * ((n - FFN) >> 7) + 128 + slot_std((n - FFN) & 127);
    case MAP_MKV0: return n < 256 ? slot_mq(n) : 256 + ((n - 256) & ~127) + slot_std((n - 256) & 127);
    default:       return 512 + (n < 256 ? slot_mq(n) : 256 + ((n - 256) & ~127) + slot_std((n - 256) & 127));
    }
}

typedef float f32x2_t __attribute__((ext_vector_type(2))); typedef __bf16 bf16x2_t __attribute__((ext_vector_type(2)));
__device__ __forceinline__ unsigned cvt_pk_bf16(float lo, float hi) { f32x2_t v = {lo, hi}; bf16x2_t b = __builtin_convertvector(v, bf16x2_t); return __builtin_bit_cast(unsigned, b); }
__device__ __forceinline__ float fast_sigmoid(float v) { return __builtin_amdgcn_rcpf(1.f + __builtin_amdgcn_exp2f(-LOG2E * v)); }
__device__ __forceinline__ float fast_silu(float v) { return v * fast_sigmoid(v); }

namespace pg8 {
constexpr int BM = 256, BK = 64, HALF = 128, HTB = HALF * BK * 2, STAGE_BYTES = 8 * HTB, NXCD = 8, WGM = 8;
__host__ __device__ __forceinline__ int lds_byte(int r, int c) { const int st = (r >> 4) * 2 + (c >> 5), rr = r & 15, cc = c & 31, ob = rr * 64 + cc * 2; return st * 1024 + (ob ^ (((ob >> 9) & 1) << 5)); }
__host__ __device__ __forceinline__ void stage_rc(int b, int& R, int& C) { const int st = b / 1024, sb = b % 1024, swz = sb ^ (((sb >> 9) & 1) << 5); R = (st >> 1) * 16 + swz / 64; C = (st & 1) * 32 + (swz % 64) / 2; }
struct Unit { int pm, pn; };
struct StaticOrder {
    int nM, nN, nwg, G, c;
    __device__ void init(int M, int N, int G_, int c_) { nM = M / BM; nN = N / BM; nwg = nM * nN; G = G_; c = c_; }
    __device__ bool next(int i, Unit& u) const {
        const long L = (long)i * G + c; if (L >= nwg) return false;
        int wgid = (int)L; { const int q = nwg / NXCD, r = nwg % NXCD, xcd = wgid % NXCD, off = wgid / NXCD; wgid = (xcd < r ? xcd * (q + 1) : r * (q + 1) + (xcd - r) * q) + off; }
        const int nig = WGM * nN, gid = wgid / nig, fm = gid * WGM, gsz = (nM - fm) < WGM ? (nM - fm) : WGM;
        u.pm = fm + ((wgid % nig) % gsz); u.pn = (wgid % nig) / gsz; return true;
    }
};
typedef f32x4 Acc[2][2][4][2];

template <class Epi>
__device__ __forceinline__ void gemm_phase(LAS unsigned char* lds, const bf16_t* A, const bf16_t* Bt, int M, int N, int K, const StaticOrder& S, const Epi& E) {
    int tid = threadIdx.x; asm volatile("" : "+v"(tid));
    const int wid = __builtin_amdgcn_readfirstlane(tid >> 6), lane = tid & 63, wr = wid >> 2, wc = wid & 3, fr = lane & 15, fq = lane >> 4;
    const int nt = K / BK;
    unsigned voff[2];
#pragma unroll
    for (int i = 0; i < 2; ++i) { int R, C; stage_rc(tid * 16 + i * 8192, R, C); voff[i] = (unsigned)(R * K + C) * 2u; }
    const size_t kstep = (size_t)(BK * 2);
    const size_t hstep = (size_t)HALF * K * 2;
    const size_t tstep = 2 * hstep;
    const unsigned ldsw = (unsigned)wid * 1024u;
    const int aoff = lds_byte(wr * 64 + fr, fq * 8), boff = lds_byte(wc * 32 + fr, fq * 8);
#define PG8_SA(b, h) (((b) * 2 + (h)) * HTB)
#define PG8_SB(b, h) ((4 + (b) * 2 + (h)) * HTB)
#define PG8_STAGE(bufoff, gbase) do { _Pragma("unroll") for (int _i = 0; _i < 2; ++_i) \
        __builtin_amdgcn_global_load_lds((const unsigned*)((const char*)(gbase) + voff[_i]), (LAS unsigned*)(lds + (bufoff) + ldsw + _i * 8192), 16, 0, 0); } while (0)
#define PG8_LDA(dst, b, h) do { _Pragma("unroll") for (int m = 0; m < 4; ++m) _Pragma("unroll") for (int k = 0; k < 2; ++k) dst[m][k] = *(const LAS bf16x8*)(lds + PG8_SA(b, h) + aoff + m * 2048 + k * 1024); } while (0)
#define PG8_LDB(dst, b, h) do { _Pragma("unroll") for (int n = 0; n < 2; ++n) _Pragma("unroll") for (int k = 0; k < 2; ++k) dst[n][k] = *(const LAS bf16x8*)(lds + PG8_SB(b, h) + boff + n * 2048 + k * 1024); } while (0)
#define PG8_MMA(ai, bj, At, Bt_) do { __builtin_amdgcn_s_setprio(1); _Pragma("unroll") for (int m = 0; m < 4; ++m) _Pragma("unroll") for (int n = 0; n < 2; ++n) _Pragma("unroll") for (int k = 0; k < 2; ++k) \
        acc[ai][bj][m][n] = __builtin_amdgcn_mfma_f32_16x16x32_bf16(Bt_[n][k], At[m][k], acc[ai][bj][m][n], 0, 0, 0); __builtin_amdgcn_s_setprio(0); } while (0)
#define PG8_WAIT_V(n) asm volatile("s_waitcnt vmcnt(" #n ")" ::: "memory")
#define PG8_WAIT_L(n) asm volatile("s_waitcnt lgkmcnt(" #n ")" ::: "memory")
#define PG8_BAR __builtin_amdgcn_s_barrier()
#define PG8_SCHED __builtin_amdgcn_sched_barrier(0)
    Unit cur, nxt; int ui = 0;
    if (!S.next(0, cur)) return;
    Acc acc;
#pragma unroll
    for (int a = 0; a < 2; ++a)
#pragma unroll
        for (int b = 0; b < 2; ++b)
#pragma unroll
            for (int m = 0; m < 4; ++m)
#pragma unroll
                for (int n = 0; n < 2; ++n) acc[a][b][m][n] = (f32x4){0.f, 0.f, 0.f, 0.f};
    bf16x8 At[4][2], B0[2][2], B1[2][2];
    const char* cA = (const char*)A + (size_t)cur.pm * tstep; const char* cB = (const char*)Bt + (size_t)cur.pn * tstep;
    PG8_STAGE(PG8_SB(0, 0), cB); PG8_STAGE(PG8_SB(0, 1), cB + hstep); PG8_STAGE(PG8_SA(0, 0), cA); PG8_STAGE(PG8_SA(0, 1), cA + hstep);
    if (wr == 1) PG8_BAR;
    PG8_WAIT_V(2); PG8_BAR;
    PG8_STAGE(PG8_SB(1, 0), cB + kstep); PG8_STAGE(PG8_SA(1, 0), cA + kstep); PG8_STAGE(PG8_SB(1, 1), cB + hstep + kstep);
    PG8_WAIT_V(6); PG8_BAR;
    for (;;) {
        const bool has_next = S.next(ui + 1, nxt);
        const char* nA = has_next ? (const char*)A + (size_t)nxt.pm * tstep : cA; const char* nB = has_next ? (const char*)Bt + (size_t)nxt.pn * tstep : cB;
        for (int t = 0; t < nt; t += 2) {
            const bool last = (t == nt - 2);
            const char* a1 = cA + (size_t)(t + 1) * kstep;
            const char* a2 = last ? nA : cA + (size_t)(t + 2) * kstep; const char* b2 = last ? nB : cB + (size_t)(t + 2) * kstep;
            const char* a3 = a2 + kstep; const char* b3 = b2 + kstep;
            PG8_LDB(B0, 0, 0); PG8_LDB(B1, 0, 1); PG8_SCHED; PG8_LDA(At, 0, 0); PG8_STAGE(PG8_SA(1, 1), a1 + hstep);
            PG8_WAIT_V(8); PG8_WAIT_L(0); PG8_BAR; PG8_MMA(0, 0, At, B0); PG8_MMA(0, 1, At, B1); PG8_BAR; PG8_SCHED;
            PG8_LDA(At, 0, 1); PG8_STAGE(PG8_SB(0, 0), b2); PG8_STAGE(PG8_SB(0, 1), b2 + hstep); PG8_STAGE(PG8_SA(0, 0), a2);
            PG8_WAIT_V(8); PG8_WAIT_L(0); PG8_BAR; PG8_MMA(1, 0, At, B0); PG8_MMA(1, 1, At, B1); PG8_BAR; PG8_SCHED;
            PG8_LDB(B0, 1, 0); PG8_LDB(B1, 1, 1); PG8_SCHED; PG8_LDA(At, 1, 0); PG8_STAGE(PG8_SA(0, 1), a2 + hstep);
            PG8_WAIT_V(8); PG8_WAIT_L(0); PG8_BAR; PG8_MMA(0, 0, At, B0); PG8_MMA(0, 1, At, B1); PG8_BAR; PG8_SCHED;
            PG8_LDA(At, 1, 1); PG8_STAGE(PG8_SB(1, 0), b3); PG8_STAGE(PG8_SB(1, 1), b3 + hstep); PG8_STAGE(PG8_SA(1, 0), a3);
            PG8_WAIT_V(8); PG8_WAIT_L(0); PG8_BAR; PG8_MMA(1, 0, At, B0); PG8_MMA(1, 1, At, B1); PG8_BAR; PG8_SCHED;
        }
        if (wr == 0) PG8_BAR;
        E(acc, cur, wr, wc, fr, fq, lds);
        if (!has_next) break;
#pragma unroll
        for (int a = 0; a < 2; ++a)
#pragma unroll
            for (int b = 0; b < 2; ++b)
#pragma unroll
                for (int m = 0; m < 4; ++m)
#pragma unroll
                    for (int n = 0; n < 2; ++n) acc[a][b][m][n] = (f32x4){0.f, 0.f, 0.f, 0.f};
        cur = nxt; cA = nA; cB = nB; ++ui;
        if (wr == 1) PG8_BAR;
    }
    PG8_WAIT_V(0);
    PG8_BAR;
#undef PG8_SA
#undef PG8_SB
#undef PG8_STAGE
#undef PG8_LDA
#undef PG8_LDB
#undef PG8_MMA
#undef PG8_WAIT_V
#undef PG8_WAIT_L
#undef PG8_BAR
#undef PG8_SCHED
}

__device__ __forceinline__ float rs_of(const float* ss, int row) { return __builtin_amdgcn_rsqf(ss[row] * (1.f / DM) + EPS); }
__device__ __forceinline__ u32x4 pack8(const f32x4& a, const f32x4& b) { u32x4 w; w.x = cvt_pk_bf16(a[0], a[1]); w.y = cvt_pk_bf16(a[2], a[3]); w.z = cvt_pk_bf16(b[0], b[1]); w.w = cvt_pk_bf16(b[2], b[3]); return w; }

__device__ __forceinline__ void head64_store(f32x4 a0, f32x4 a1, f32x4 b0, f32x4 b1, float rs, const float* gain, float scale, bf16_t* dst  , int fq) {
    a0 *= rs; a1 *= rs; b0 *= rs; b1 *= rs;
    float s = 0.f;
#pragma unroll
    for (int e = 0; e < 4; ++e) s += a0[e] * a0[e] + a1[e] * a1[e] + b0[e] * b0[e] + b1[e] * b1[e];
    s += __shfl_xor(s, 16); s += __shfl_xor(s, 32);
    const float r2 = __builtin_amdgcn_rsqf(s * (1.f / 64.f) + EPS) * scale;
    const f32x4 g0 = *(const f32x4*)(gain + 8 * fq), g1 = *(const f32x4*)(gain + 8 * fq + 4), g2 = *(const f32x4*)(gain + 32 + 8 * fq), g3 = *(const f32x4*)(gain + 32 + 8 * fq + 4);
    *(u32x4*)(dst + 8 * fq) = pack8(a0 * g0 * r2, a1 * g1 * r2);
    *(u32x4*)(dst + 32 + 8 * fq) = pack8(b0 * g2 * r2, b1 * g3 * r2);
}

struct EpiInproj0 {
    const float* ss; const float* lb; const float* mqn; bf16_t* QS; float* LF; bf16_t* VV; bf16_t* SG; bf16_t* MQ;
    __device__ __forceinline__ void operator()(const Acc& acc, const Unit& u, int wr, int wc, int fr, int fq, LAS unsigned char*) const {
        const int row0 = u.pm * BM + wr * 64 + fr, pn = u.pn;
        if (pn == 12) {
#pragma unroll
            for (int ai = 0; ai < 2; ++ai)
#pragma unroll
                for (int m = 0; m < 4; ++m) { const int row = row0 + ai * HALF + m * 16;
                    head64_store(acc[ai][0][m][0], acc[ai][0][m][1], acc[ai][1][m][0], acc[ai][1][m][1], rs_of(ss, row), mqn, 0.125f * LOG2E, MQ + (size_t)row * MW + 64 * wc, fq); }
            return;
        }
        const int kind = pn / 3, colb = (pn % 3) * 256 + wc * 32 + 8 * fq;
        f32x4 lbv[2][2];
        if (kind == 1) {
#pragma unroll
            for (int bj = 0; bj < 2; ++bj) { lbv[bj][0] = *(const f32x4*)(lb + colb + bj * HALF); lbv[bj][1] = *(const f32x4*)(lb + colb + bj * HALF + 4); }
        }
#pragma unroll
        for (int ai = 0; ai < 2; ++ai)
#pragma unroll
            for (int m = 0; m < 4; ++m) { const int row = row0 + ai * HALF + m * 16; const float rs = rs_of(ss, row);
#pragma unroll
                for (int bj = 0; bj < 2; ++bj) { f32x4 v0 = acc[ai][bj][m][0] * rs, v1 = acc[ai][bj][m][1] * rs; const size_t o = (size_t)row * AW + colb + bj * HALF;
                    if (kind == 1) {
#pragma unroll
                        for (int e = 0; e < 4; ++e) { const float l0 = lbv[bj][0][e], l1 = lbv[bj][1][e];
                            v0[e] = __builtin_amdgcn_logf(l0 + (1.f - l0) * fast_sigmoid(v0[e])) * 0.6931471805599453f; v1[e] = __builtin_amdgcn_logf(l1 + (1.f - l1) * fast_sigmoid(v1[e])) * 0.6931471805599453f; }
                        *(f32x4*)(LF + o) = v0; *(f32x4*)(LF + o + 4) = v1;
                    } else {
                        if (kind != 2) {
#pragma unroll
                            for (int e = 0; e < 4; ++e) { v0[e] = fast_silu(v0[e]); v1[e] = fast_silu(v1[e]); } }
                        bf16_t* dst = QS + (size_t)(kind == 0 ? 0 : kind - 1) * ((size_t)T * AW);
                        *(u32x4*)(dst + o) = pack8(v0, v1);
                    } } }
    }
};
struct EpiMemKV {
    const float* ss; const float* mkn; bf16_t* MK; bf16_t* MV;
    __device__ __forceinline__ void operator()(const Acc& acc, const Unit& u, int wr, int wc, int fr, int fq, LAS unsigned char*) const {
        const int row0 = u.pm * BM + wr * 64 + fr, l = u.pn >> 1;
#pragma unroll
        for (int ai = 0; ai < 2; ++ai)
#pragma unroll
            for (int m = 0; m < 4; ++m) { const int row = row0 + ai * HALF + m * 16; const float rs = rs_of(ss, row);
                if ((u.pn & 1) == 0) head64_store(acc[ai][0][m][0], acc[ai][0][m][1], acc[ai][1][m][0], acc[ai][1][m][1], rs, mkn + l * 64, 1.f, MK + ((size_t)l * MROWS + row) * MW + 64 * wc, fq);
                else {
#pragma unroll
                    for (int bj = 0; bj < 2; ++bj) *(u32x4*)(MV + ((size_t)l * MROWS + row) * MW + bj * HALF + wc * 32 + 8 * fq) = pack8(acc[ai][bj][m][0] * rs, acc[ai][bj][m][1] * rs); } }
    }
};
struct EpiResid {
    const float* base; float* H; bf16_t* HB; float* ssn;
    __device__ __forceinline__ void operator()(const Acc& acc, const Unit& u, int wr, int wc, int fr, int fq, LAS unsigned char*) const {
        const int row0 = u.pm * BM + wr * 64 + fr, col0 = u.pn * BM + wc * 32 + 8 * fq;
#pragma unroll
        for (int ai = 0; ai < 2; ++ai)
#pragma unroll
            for (int m = 0; m < 4; ++m) { const int row = row0 + ai * HALF + m * 16; float s = 0.f;
#pragma unroll
                for (int bj = 0; bj < 2; ++bj) { const size_t o = (size_t)row * DM + col0 + bj * HALF;
                    const f32x4 v0 = *(const f32x4*)(base + o) + acc[ai][bj][m][0], v1 = *(const f32x4*)(base + o + 4) + acc[ai][bj][m][1];
                    *(f32x4*)(H + o) = v0; *(f32x4*)(H + o + 4) = v1;
                    if (HB) { *(u32x4*)(HB + o) = pack8(v0, v1);
#pragma unroll
                        for (int e = 0; e < 4; ++e) s += v0[e] * v0[e] + v1[e] * v1[e]; } }
                if (HB) { s += __shfl_xor(s, 16); s += __shfl_xor(s, 32); if (fq == 0) atomicAdd(ssn + row, s); }
                if (m & 1) asm volatile("" ::: "memory"); }
    }
};
struct EpiGateUp {
    const float* ss; bf16_t* ACT;
    __device__ __forceinline__ void operator()(const Acc& acc, const Unit& u, int wr, int wc, int fr, int fq, LAS unsigned char*) const {
        const int row0 = u.pm * BM + wr * 64 + fr, col0 = u.pn * HALF + wc * 32 + 8 * fq;
#pragma unroll
        for (int ai = 0; ai < 2; ++ai)
#pragma unroll
            for (int m = 0; m < 4; ++m) { const int row = row0 + ai * HALF + m * 16; const float rs = rs_of(ss, row);
                f32x4 o0, o1;
#pragma unroll
                for (int e = 0; e < 4; ++e) { o0[e] = fast_silu(acc[ai][0][m][0][e] * rs) * (acc[ai][1][m][0][e] * rs); o1[e] = fast_silu(acc[ai][0][m][1][e] * rs) * (acc[ai][1][m][1][e] * rs); }
                *(u32x4*)(ACT + (size_t)row * FFN + col0) = pack8(o0, o1); }
    }
};
struct EpiKVB {
    const float* ss; const float* knorm; const float* qnorm; const float* mqn; const float* cs; const float* sn; bf16_t* KR; bf16_t* VS; bf16_t* QG; bf16_t* MQ;
    __device__ __forceinline__ void operator()(const Acc& acc, const Unit& u, int wr, int wc, int fr, int fq, LAS unsigned char* lds) const {
        const int row0 = u.pm * BM + wr * 64 + fr, pn = u.pn;
        if (pn == 15) {
#pragma unroll
            for (int ai = 0; ai < 2; ++ai)
#pragma unroll
                for (int m = 0; m < 4; ++m) { const int row = row0 + ai * HALF + m * 16;
                    head64_store(acc[ai][0][m][0], acc[ai][0][m][1], acc[ai][1][m][0], acc[ai][1][m][1], rs_of(ss, row), mqn, 0.125f * LOG2E, MQ + (size_t)row * MW + 64 * wc, fq); }
            return;
        }
        if (pn >= 3 && pn < 6) {
#pragma unroll
            for (int ai = 0; ai < 2; ++ai)
#pragma unroll
                for (int m = 0; m < 4; ++m) { const int row = row0 + ai * HALF + m * 16; const float rs = rs_of(ss, row);
#pragma unroll
                    for (int bj = 0; bj < 2; ++bj) *(u32x4*)(VS + (size_t)row * AW + (pn - 3) * 256 + bj * HALF + wc * 32 + 8 * fq) = pack8(acc[ai][bj][m][0] * rs, acc[ai][bj][m][1] * rs); }
            return;
        }
        LAS float* P = (LAS float*)(lds + XSCR_OFF);
#pragma unroll
        for (int ai = 0; ai < 2; ++ai)
#pragma unroll
            for (int m = 0; m < 4; ++m) { const int rl = ai * HALF + wr * 64 + m * 16 + fr; const float rs = rs_of(ss, u.pm * BM + rl);
#pragma unroll
                for (int bj = 0; bj < 2; ++bj) { const f32x4 a = acc[ai][bj][m][0] * rs, b = acc[ai][bj][m][1] * rs; float s = 0.f;
#pragma unroll
                    for (int e = 0; e < 4; ++e) s += a[e] * a[e] + b[e] * b[e];
                    s += __shfl_xor(s, 16); s += __shfl_xor(s, 32);
                    if (fq == 0) P[(rl * 2 + bj) * 4 + wc] = s; } }
        asm volatile("s_waitcnt lgkmcnt(0)" ::: "memory"); __builtin_amdgcn_s_barrier(); asm volatile("" ::: "memory");
        const bool isk = pn < 3; const int grp = isk ? 0 : (pn - 6) / 3, hp = isk ? pn : (pn - 6) % 3;
        const float* gn = isk ? knorm : qnorm + grp * 128; const float sc = isk ? 1.f : (0.08838834764831845f * LOG2E);
        bf16_t* dstb = KR + (size_t)(isk ? 0 : 2 + grp) * ((size_t)T * AW);
        const int d = 16 * wc + 4 * fq;
        const f32x4 g1 = *(const f32x4*)(gn + d), g2 = *(const f32x4*)(gn + 64 + d);
#pragma unroll
        for (int ai = 0; ai < 2; ++ai)
#pragma unroll
            for (int m = 0; m < 4; ++m) { const int rl = ai * HALF + wr * 64 + m * 16 + fr, row = u.pm * BM + rl, pos = row & (SEQ - 1); const float rs = rs_of(ss, row);
                const f32x4 co = *(const f32x4*)(cs + pos * 64 + d), si = *(const f32x4*)(sn + pos * 64 + d);
#pragma unroll
                for (int bj = 0; bj < 2; ++bj) { const f32x4 pp = *(const LAS f32x4*)(P + (rl * 2 + bj) * 4);
                    const float r2 = __builtin_amdgcn_rsqf(((pp[0] + pp[1]) + (pp[2] + pp[3])) * (1.f / 128.f) + EPS) * rs * sc;
                    const f32x4 y1 = acc[ai][bj][m][0] * g1 * r2, y2 = acc[ai][bj][m][1] * g2 * r2;
                    const f32x4 o1 = y1 * co - y2 * si, o2 = y2 * co + y1 * si;
                    bf16_t* dst = dstb + (size_t)row * AW + (2 * hp + bj) * 128 + d;
                    u32x2 w1, w2; w1.x = cvt_pk_bf16(o1[0], o1[1]); w1.y = cvt_pk_bf16(o1[2], o1[3]); w2.x = cvt_pk_bf16(o2[0], o2[1]); w2.y = cvt_pk_bf16(o2[2], o2[3]);
                    *(u32x2*)dst = w1; *(u32x2*)(dst + 64) = w2; }
                asm volatile("" ::: "memory"); }
    }
};
}


typedef short s16x4 __attribute__((ext_vector_type(4)));
__device__ __forceinline__ unsigned off_b(unsigned row, unsigned ch) { return 256u * row + 16u * (ch ^ (((row & 3) << 2) | ((row >> 2) & 3))); }
__device__ __forceinline__ unsigned rowrd16(unsigned lane, unsigned rb, unsigned s) { return off_b((lane & 15) + 16 * rb, 4 * s + (lane >> 4)); }
__device__ __forceinline__ unsigned trrd(unsigned lane, unsigned rowbase, unsigned c) { const unsigned q = (lane & 15) >> 2, p = lane & 3; return off_b(rowbase + q, 2 * c + (p >> 1)) + 8 * (p & 1); }
__device__ __forceinline__ unsigned off_h(unsigned row, unsigned ch) { return 128u * row + 16u * (ch ^ ((row >> 1) & 7)); }
__device__ __forceinline__ s16x4 tr_read(LAS unsigned char* p) { return __builtin_bit_cast(s16x4, __builtin_amdgcn_ds_read_tr16_b64_v4i16((LAS s16x4*)p)); }
__device__ __forceinline__ bf16x8 cat8(s16x4 lo, s16x4 hi) { return (bf16x8){lo[0], lo[1], lo[2], lo[3], hi[0], hi[1], hi[2], hi[3]}; }
#define MFMA16(a, b, c) __builtin_amdgcn_mfma_f32_16x16x32_bf16(a, b, c, 0, 0, 0)
#define LDS_BARRIER() do { asm volatile("s_waitcnt vmcnt(0) lgkmcnt(0)" ::: "memory"); __builtin_amdgcn_s_barrier(); asm volatile("" ::: "memory"); } while (0)

template <int NT, int NDT>
__device__ __forceinline__ float attn_softmax_pv(LAS unsigned char* Vimg, f32x4 (&st)[NT], int t0, int lane, f32x4 (&o)[NDT], float& mx_out) {
    const int g = lane >> 4;
    float mx = -1e30f;
#pragma unroll
    for (int i = 0; i < NT; ++i)
#pragma unroll
        for (int e = 0; e < 4; ++e) mx = fmaxf(mx, st[i][e]);
    mx = fmaxf(mx, __shfl_xor(mx, 16)); mx = fmaxf(mx, __shfl_xor(mx, 32));
    float l = 0.f;
#pragma unroll
    for (int i = 0; i < NT; ++i)
#pragma unroll
        for (int e = 0; e < 4; ++e) { const float p = __builtin_amdgcn_exp2f(st[i][e] - mx); st[i][e] = p; l += p; }
    l += __shfl_xor(l, 16); l += __shfl_xor(l, 32);
#pragma unroll
    for (int dt = 0; dt < NDT; ++dt) o[dt] = (f32x4){0.f, 0.f, 0.f, 0.f};
#pragma unroll
    for (int pr = 0; pr < (NT + 1) / 2; ++pr) {
        const bool has1 = (2 * pr + 1 < NT);
        const int T0 = t0 + 2 * pr; int T1 = T0 + 1; if (T1 > 15) T1 = 15;
        u32x4 pw; pw.x = cvt_pk_bf16(st[2 * pr][0], st[2 * pr][1]); pw.y = cvt_pk_bf16(st[2 * pr][2], st[2 * pr][3]);
        if (has1) { pw.z = cvt_pk_bf16(st[has1 ? 2 * pr + 1 : 0][0], st[has1 ? 2 * pr + 1 : 0][1]); pw.w = cvt_pk_bf16(st[has1 ? 2 * pr + 1 : 0][2], st[has1 ? 2 * pr + 1 : 0][3]); } else { pw.z = 0u; pw.w = 0u; }
        const bf16x8 pb = __builtin_bit_cast(bf16x8, pw);
#pragma unroll
        for (int dt = 0; dt < NDT; ++dt) {
            const s16x4 lo = tr_read(Vimg + trrd(lane, 16 * T0 + 4 * g, dt)), hi = tr_read(Vimg + trrd(lane, 16 * T1 + 4 * g, dt));
            o[dt] = MFMA16(cat8(lo, hi), pb, o[dt]);
        }
    }
    mx_out = mx;
    return l;
}

__device__ __forceinline__ void dil_unit(LAS unsigned char* lds, int u, const bf16_t* KR, const bf16_t* VS, bf16_t* QG, float* LSE, int tid) {
    LAS unsigned char* Kimg = lds; LAS unsigned char* Vimg = lds + 65536;
    const int lane = tid & 63, w = __builtin_amdgcn_readfirstlane(tid >> 6), g = lane >> 4, lq = lane & 15;
    const int bh = u / 96, b = bh / NH, h = bh % NH, v = u % 96, grp = v >> 5, vv = v & 31;
    const int dil = grp == 0 ? 1 : (grp == 1 ? 4 : 16), nbk = 32 >> (2 * grp), r = vv / nbk, qb = vv % nbk, m0 = 128 * qb;
#pragma unroll
    for (int i = 0; i < 8; ++i) { const int idx = i * 512 + tid, row = idx >> 4, ch = idx & 15; int m = m0 - 128 + row; if (m < 0) m = 0;
        const size_t go = ((size_t)(b * SEQ + m * dil + r)) * AW + h * 128 + ch * 8;
        const u32x4 kv = *(const u32x4*)(KR + go), vx = *(const u32x4*)(VS + go);
        *(LAS u32x4*)(Kimg + off_b(row, ch)) = kv; *(LAS u32x4*)(Vimg + off_b(row, ch)) = vx; }
    const size_t qrow = (size_t)(b * SEQ + (m0 + 16 * w + lq) * dil + r);
    bf16_t* qp = QG + ((size_t)grp * T + qrow) * AW + h * 128;
    bf16x8 qf[4];
#pragma unroll
    for (int s = 0; s < 4; ++s) qf[s] = *(const bf16x8*)(qp + 32 * s + 8 * g);
    LDS_BARRIER();
    f32x4 st[9];
#pragma unroll
    for (int i = 0; i < 9; ++i) { const int tile = w + i; f32x4 acc = (f32x4){0.f, 0.f, 0.f, 0.f};
#pragma unroll
        for (int s = 0; s < 4; ++s) acc = MFMA16(*(const LAS bf16x8*)(Kimg + rowrd16(lane, tile, s)), qf[s], acc);
#pragma unroll
        for (int e = 0; e < 4; ++e) { const int kk = 16 * tile + 4 * g + e, dist = 128 + 16 * w + lq - kk; const bool ok = dist >= 0 && dist <= 128 && (m0 - 128 + kk) >= 0; st[i][e] = ok ? acc[e] : -1e30f; } }
    f32x4 o[8]; float mx;
    const float l = attn_softmax_pv<9, 8>(Vimg, st, w, lane, o, mx);
    const float inv = __builtin_amdgcn_rcpf(l);
#pragma unroll
    for (int dt = 0; dt < 8; ++dt) { u32x2 ow; ow.x = cvt_pk_bf16(o[dt][0] * inv, o[dt][1] * inv); ow.y = cvt_pk_bf16(o[dt][2] * inv, o[dt][3] * inv); *(u32x2*)(qp + 16 * dt + 4 * g) = ow; }
    if (g == 0) LSE[((size_t)grp * T + qrow) * NH + h] = mx + __builtin_amdgcn_logf(l);
    LDS_BARRIER();
}
__device__ __forceinline__ void mem_unit(LAS unsigned char* lds, int u, const bf16_t* MQ, const bf16_t* MKl, const bf16_t* MVl, bf16_t* MIX, int tid) {
    LAS unsigned char* Kimg = lds; LAS unsigned char* Vimg = lds + 65536;
    const int lane = tid & 63, w = __builtin_amdgcn_readfirstlane(tid >> 6), g = lane >> 4, lq = lane & 15;
    const int b = u >> 7, hd = (u >> 5) & 3, qblk = u & 31;
#pragma unroll
    for (int i = 0; i < 4; ++i) { const int idx = i * 512 + tid, row = idx >> 3, ch = idx & 7;
        const size_t go = ((size_t)(b * MEMT + row)) * MW + hd * 64 + ch * 8;
        const u32x4 kv = *(const u32x4*)(MKl + go), vx = *(const u32x4*)(MVl + go);
        *(LAS u32x4*)(Kimg + off_b(row, ch)) = kv; *(LAS u32x4*)(Vimg + off_b(row, ch)) = vx; }
    const size_t qrow = (size_t)(b * SEQ + 128 * qblk + 16 * w + lq);
    const bf16_t* qp = MQ + qrow * MW + hd * 64;
    bf16x8 qf[2];
#pragma unroll
    for (int s = 0; s < 2; ++s) qf[s] = *(const bf16x8*)(qp + 32 * s + 8 * g);
    LDS_BARRIER();
    f32x4 st[16];
#pragma unroll
    for (int i = 0; i < 16; ++i) { f32x4 acc = (f32x4){0.f, 0.f, 0.f, 0.f};
#pragma unroll
        for (int s = 0; s < 2; ++s) acc = MFMA16(*(const LAS bf16x8*)(Kimg + rowrd16(lane, i, s)), qf[s], acc);
        st[i] = acc; }
    f32x4 o[4]; float mx;
    const float l = attn_softmax_pv<16, 4>(Vimg, st, 0, lane, o, mx);
    const float inv = __builtin_amdgcn_rcpf(l);
#pragma unroll
    for (int dt = 0; dt < 4; ++dt) { u32x2 ow; ow.x = cvt_pk_bf16(o[dt][0] * inv, o[dt][1] * inv); ow.y = cvt_pk_bf16(o[dt][2] * inv, o[dt][3] * inv); *(u32x2*)(MIX + qrow * DM + AW + hd * 64 + 16 * dt + 4 * g) = ow; }
    LDS_BARRIER();
}

constexpr int HG_UNITS = BATCH * NH * (SEQ / 64);
__device__ __forceinline__ void hg_cumsum(LAS float* tot, const float* LF, size_t rowbase, int h, int tid, float (&lf)[16], float (&bc)[16], float& bend) {
    const int d = tid & 127, rg = tid >> 7;
    float c = 0.f;
#pragma unroll
    for (int i = 0; i < 16; ++i) { lf[i] = LF[(rowbase + 16 * rg + i) * AW + h * 128 + d]; }
#pragma unroll
    for (int i = 0; i < 16; ++i) { c += lf[i]; bc[i] = c; }
    tot[rg * 128 + d] = c;
    LDS_BARRIER();
    const float t0 = tot[d], t1 = tot[128 + d], t2 = tot[256 + d], t3 = tot[384 + d];
    const float pre = rg == 0 ? 0.f : (rg == 1 ? t0 : (rg == 2 ? t0 + t1 : t0 + t1 + t2));
    bend = (t0 + t1) + (t2 + t3);
#pragma unroll
    for (int i = 0; i < 16; ++i) bc[i] += pre;
}
__device__ __forceinline__ float ex(float v) { return __builtin_amdgcn_exp2f(v * LOG2E); }
__device__ __forceinline__ void hgA_unit(LAS unsigned char* lds, int u, const float* LF, const bf16_t* VV, bf16_t* DS, float* DEC, int tid) {
    LAS unsigned char* KT = lds;
    LAS unsigned char* Vimg = lds + 16384;
    LAS float* tot = (LAS float*)(lds + 32768);
    const int lane = tid & 63, w = __builtin_amdgcn_readfirstlane(tid >> 6), g = lane >> 4;
    const int bh = u >> 6, c = u & 63, b = bh / NH, h = bh % NH; const size_t rowbase = (size_t)b * SEQ + 64 * c;
    float lf[16], bc[16], bend;
    hg_cumsum(tot, LF, rowbase, h, tid, lf, bc, bend);
    const int d = tid & 127, rg = tid >> 7;
    { u32x4 w0, w1; float ko[16];
#pragma unroll
      for (int i = 0; i < 16; ++i) ko[i] = (1.f - ex(lf[i])) * ex(bend - bc[i]);
      w0.x = cvt_pk_bf16(ko[0], ko[1]); w0.y = cvt_pk_bf16(ko[2], ko[3]); w0.z = cvt_pk_bf16(ko[4], ko[5]); w0.w = cvt_pk_bf16(ko[6], ko[7]);
      w1.x = cvt_pk_bf16(ko[8], ko[9]); w1.y = cvt_pk_bf16(ko[10], ko[11]); w1.z = cvt_pk_bf16(ko[12], ko[13]); w1.w = cvt_pk_bf16(ko[14], ko[15]);
      *(LAS u32x4*)(KT + off_h(d, 2 * rg)) = w0; *(LAS u32x4*)(KT + off_h(d, 2 * rg + 1)) = w1;
      if (rg == 0) DEC[(size_t)u * 128 + d] = ex(bend); }
#pragma unroll
    for (int i = 0; i < 2; ++i) { const int idx = i * 512 + tid, row = idx >> 4, ch = idx & 15;
        *(LAS u32x4*)(Vimg + off_b(row, ch)) = *(const u32x4*)(VV + (rowbase + row) * AW + h * 128 + ch * 8); }
    LDS_BARRIER();
    bf16x8 af[2];
#pragma unroll
    for (int ks = 0; ks < 2; ++ks) af[ks] = *(const LAS bf16x8*)(KT + off_h(16 * w + (lane & 15), 4 * ks + g));
    bf16_t* dsu = DS + (size_t)u * 16384;
#pragma unroll
    for (int j = 0; j < 8; ++j) { f32x4 acc = (f32x4){0.f, 0.f, 0.f, 0.f};
#pragma unroll
        for (int ks = 0; ks < 2; ++ks) { const s16x4 lo = tr_read(Vimg + trrd(lane, 32 * ks + 8 * g, j)), hi = tr_read(Vimg + trrd(lane, 32 * ks + 8 * g + 4, j));
            acc = MFMA16(af[ks], cat8(lo, hi), acc); }
        u32x2 ow; ow.x = cvt_pk_bf16(acc[0], acc[1]); ow.y = cvt_pk_bf16(acc[2], acc[3]);
        *(u32x2*)(dsu + (size_t)(16 * j + (lane & 15)) * 128 + 16 * w + 4 * g) = ow; }
    LDS_BARRIER();
}
__device__ __forceinline__ void hgB_item(int it, bf16_t* DS, const float* DEC) {
    const int bh = it >> 11, e8 = it & 2047;
    const int dk0 = 8 * (e8 & 15);
    float S[8];
#pragma unroll
    for (int i = 0; i < 8; ++i) S[i] = 0.f;
#pragma unroll 4
    for (int c = 0; c < 64; ++c) { const size_t un = (size_t)(bh * 64 + c);
        u32x4* p = (u32x4*)(DS + un * 16384 + (size_t)e8 * 8);
        const u32x4 dsv = *p; const f32x4 d0 = *(const f32x4*)(DEC + un * 128 + dk0), d1 = *(const f32x4*)(DEC + un * 128 + dk0 + 4);
        u32x4 o; o.x = cvt_pk_bf16(S[0], S[1]); o.y = cvt_pk_bf16(S[2], S[3]); o.z = cvt_pk_bf16(S[4], S[5]); o.w = cvt_pk_bf16(S[6], S[7]);
        *p = o;
        const unsigned wv[4] = {dsv.x, dsv.y, dsv.z, dsv.w};
#pragma unroll
        for (int i = 0; i < 4; ++i) { const float dl = (i < 2 ? d0 : d1)[(2 * i) & 3], dh = (i < 2 ? d0 : d1)[(2 * i + 1) & 3];
            S[2 * i] = dl * S[2 * i] + __uint_as_float(wv[i] << 16); S[2 * i + 1] = dh * S[2 * i + 1] + __uint_as_float(wv[i] & 0xffff0000u); } }
}
__device__ __forceinline__ void hgC_unit(LAS unsigned char* lds, int u, const float* LF, const bf16_t* QS, const bf16_t* VV, const bf16_t* SG, const bf16_t* SP, const float* onorm, bf16_t* MIX, int tid) {
    LAS unsigned char* QI = lds;
    LAS unsigned char* KI = lds + 16384;
    LAS unsigned char* Vimg = lds + 32768;
    LAS unsigned char* STi = lds + 49152;
    LAS unsigned char* AT = lds + 81920;
    LAS float* tot = (LAS float*)(lds + 90112);
    LAS float* red = (LAS float*)(lds + 92160);
    const int lane = tid & 63, w = __builtin_amdgcn_readfirstlane(tid >> 6), g = lane >> 4, lq = lane & 15;
    const int bh = u >> 6, c = u & 63, b = bh / NH, h = bh % NH; const size_t rowbase = (size_t)b * SEQ + 64 * c;
    float lf[16], bc[16], bend;
    hg_cumsum(tot, LF, rowbase, h, tid, lf, bc, bend);
    const int d = tid & 127, rg = tid >> 7;
#pragma unroll
    for (int i = 0; i < 16; ++i) { const int t = 16 * rg + i; const float q = bf2f(QS[(rowbase + t) * AW + h * 128 + d]);
        const float eb = ex(bc[i]);
        const unsigned a = off_b(t, d >> 3) + (d & 7) * 2;
        *(LAS bf16_t*)(QI + a) = (bf16_t)(cvt_pk_bf16(q * eb, 0.f) & 0xffffu);
        *(LAS bf16_t*)(KI + a) = (bf16_t)(cvt_pk_bf16((1.f - ex(lf[i])) * __builtin_amdgcn_rcpf(eb), 0.f) & 0xffffu); }
#pragma unroll
    for (int i = 0; i < 2; ++i) { const int idx = i * 512 + tid, row = idx >> 4, ch = idx & 15;
        *(LAS u32x4*)(Vimg + off_b(row, ch)) = *(const u32x4*)(VV + (rowbase + row) * AW + h * 128 + ch * 8); }
#pragma unroll
    for (int i = 0; i < 4; ++i) { const int idx = i * 512 + tid, row = idx >> 4, ch = idx & 15;
        *(LAS u32x4*)(STi + off_b(row, ch)) = *(const u32x4*)(SP + (size_t)u * 16384 + row * 128 + ch * 8); }
    LDS_BARRIER();
    { const int ti = w & 3;
#pragma unroll
      for (int k2 = 0; k2 < 2; ++k2) { const int si = 2 * (w >> 2) + k2; f32x4 acc = (f32x4){0.f, 0.f, 0.f, 0.f};
        if (si <= ti) {
#pragma unroll
            for (int s = 0; s < 4; ++s) acc = MFMA16(*(const LAS bf16x8*)(KI + rowrd16(lane, si, s)), *(const LAS bf16x8*)(QI + rowrd16(lane, ti, s)), acc);
        }
        const int t = 16 * ti + lq, s0 = 16 * si + 4 * g;
        u32x2 ow; ow.x = cvt_pk_bf16(s0 <= t ? acc[0] : 0.f, s0 + 1 <= t ? acc[1] : 0.f); ow.y = cvt_pk_bf16(s0 + 2 <= t ? acc[2] : 0.f, s0 + 3 <= t ? acc[3] : 0.f);
        *(LAS u32x2*)(AT + off_h(t, s0 >> 3) + (s0 & 7) * 2) = ow; } }
    LDS_BARRIER();
    const int ti = w & 3, jh = w >> 2;
    bf16x8 aq[4], aa[2];
#pragma unroll
    for (int s = 0; s < 4; ++s) aq[s] = *(const LAS bf16x8*)(QI + rowrd16(lane, ti, s));
#pragma unroll
    for (int s = 0; s < 2; ++s) aa[s] = *(const LAS bf16x8*)(AT + off_h(16 * ti + lq, 4 * s + g));
    f32x4 o[4]; float ssq[4] = {0.f, 0.f, 0.f, 0.f};
#pragma unroll
    for (int jj = 0; jj < 4; ++jj) { const int j = 4 * jh + jj; f32x4 acc = (f32x4){0.f, 0.f, 0.f, 0.f};
#pragma unroll
        for (int s = 0; s < 4; ++s) acc = MFMA16(aq[s], *(const LAS bf16x8*)(STi + rowrd16(lane, j, s)), acc);
#pragma unroll
        for (int ks = 0; ks < 2; ++ks) { const s16x4 lo = tr_read(Vimg + trrd(lane, 32 * ks + 8 * g, j)), hi = tr_read(Vimg + trrd(lane, 32 * ks + 8 * g + 4, j));
            acc = MFMA16(aa[ks], cat8(lo, hi), acc); }
        o[jj] = acc;
#pragma unroll
        for (int e = 0; e < 4; ++e) ssq[e] += acc[e] * acc[e]; }
#pragma unroll
    for (int e = 0; e < 4; ++e) { float s = ssq[e]; s += __shfl_xor(s, 1); s += __shfl_xor(s, 2); s += __shfl_xor(s, 4); s += __shfl_xor(s, 8); ssq[e] = s; }
    if (lq == 0) {
#pragma unroll
        for (int e = 0; e < 4; ++e) red[(16 * ti + 4 * g + e) * 2 + jh] = ssq[e]; }
    LDS_BARRIER();
#pragma unroll
    for (int e = 0; e < 4; ++e) { const int t = 16 * ti + 4 * g + e; const float r2 = __builtin_amdgcn_rsqf((red[t * 2] + red[t * 2 + 1]) * (1.f / 128.f) + EPS);
#pragma unroll
        for (int jj = 0; jj < 4; ++jj) { const int dv = 16 * (4 * jh + jj) + lq; const size_t ro = rowbase + t;
            const float gt = bf2f(SG[ro * AW + h * 128 + dv]);
            MIX[ro * DM + h * 128 + dv] = (bf16_t)(cvt_pk_bf16(o[jj][e] * r2 * onorm[h * 128 + dv] * gt, 0.f) & 0xffffu); } }
    LDS_BARRIER();
}

struct Args {
    const float* in[19]; float* out; unsigned char* ws; int ph_lo, ph_hi;
};
enum { PH_PRO = 0, PH_GEMM1 = 1, PH_WO0 = 5, PH_GU0 = 6, PH_DN0 = 7, PH_KVB = 8, PH_WO1 = 11, PH_GU1 = 12, PH_DN1 = 13, PH_END = 14 };

__device__ __forceinline__ void p0_transpose_item(const float* W, const float* gain, int K, int N, bf16_t* WT, int map, LAS float* scr, int item, int lane) {
    const int nblk = N / 32, kb = item / nblk, nb = item % nblk, k0 = 64 * kb, n0 = 32 * nb;
#pragma unroll 8
    for (int i = 0; i < 32; ++i) { const int kk = 2 * i + (lane >> 5); scr[kk * 33 + (lane & 31)] = W[(size_t)(k0 + kk) * N + n0 + (lane & 31)] * (gain ? gain[k0 + kk] : 1.f); }
    asm volatile("s_waitcnt lgkmcnt(0)" ::: "memory");
    const int c = lane & 7;
#pragma unroll
    for (int j = 0; j < 4; ++j) { const int n = (lane >> 3) + 8 * j; const LAS float* s = scr + (8 * c) * 33 + n;
        u32x4 o; o.x = cvt_pk_bf16(s[0 * 33], s[1 * 33]); o.y = cvt_pk_bf16(s[2 * 33], s[3 * 33]); o.z = cvt_pk_bf16(s[4 * 33], s[5 * 33]); o.w = cvt_pk_bf16(s[6 * 33], s[7 * 33]);
        *(u32x4*)(WT + (size_t)dst_row(map, n0 + n) * K + k0 + 8 * c) = o; }
    asm volatile("s_waitcnt lgkmcnt(0)" ::: "memory");
}
__device__ __forceinline__ void p0_row(const float* xrow, bf16_t* orow, float* ss, int lane) {
    const f32x4* xr = (const f32x4*)xrow + lane; f32x4 v[4]; float s = 0.f;
#pragma unroll
    for (int j = 0; j < 4; ++j) { v[j] = xr[64 * j]; s += (v[j].x * v[j].x + v[j].y * v[j].y) + (v[j].z * v[j].z + v[j].w * v[j].w); }
    s = wave_sum(s);
#pragma unroll
    for (int j = 0; j < 4; ++j) { u32x2 o; o.x = cvt_pk_bf16(v[j].x, v[j].y); o.y = cvt_pk_bf16(v[j].z, v[j].w); *((u32x2*)orow + lane + 64 * j) = o; }
    if (lane == 0) *ss = s;
}

__global__ void __launch_bounds__(NTHREADS, 2) mk_fwd(Args args) {
    extern __shared__ __attribute__((aligned(16))) unsigned char lds_raw[];
    LAS unsigned char* lds = (LAS unsigned char*)lds_raw;
    const int G = gridDim.x, bx = blockIdx.x;
    const int vcu = (G % 8 == 0) ? (bx % 8) * (G / 8) + bx / 8 : bx;
    const float* x = (const float*)(const GAS float*)args.in[0]; const float* mem = (const float*)(const GAS float*)args.in[1]; const float* norm_mix = (const float*)(const GAS float*)args.in[2]; const float* norm_ffn = (const float*)(const GAS float*)args.in[3];
    const float* a_w_in = (const float*)(const GAS float*)args.in[4]; const float* a_lb = (const float*)(const GAS float*)args.in[5]; const float* a_onorm = (const float*)(const GAS float*)args.in[6]; const float* b_w_in = (const float*)(const GAS float*)args.in[7]; const float* b_qnorm = (const float*)(const GAS float*)args.in[8];
    const float* kv_norm = (const float*)(const GAS float*)args.in[9]; const float* w_kv = (const float*)(const GAS float*)args.in[10]; const float* b_knorm = (const float*)(const GAS float*)args.in[11]; const float* mem_norm = (const float*)(const GAS float*)args.in[12]; const float* w_mem_kv = (const float*)(const GAS float*)args.in[13];
    const float* mem_qnorm = (const float*)(const GAS float*)args.in[14]; const float* mem_knorm = (const float*)(const GAS float*)args.in[15]; const float* w_out = (const float*)(const GAS float*)args.in[16]; const float* w_gate_up = (const float*)(const GAS float*)args.in[17]; const float* w_down = (const float*)(const GAS float*)args.in[18];
#define WSP(type, name, off) type* name = (type*)(GAS type*)(wsp + (off))
#define PHASE_PTRS GAS unsigned char* wsp = (GAS unsigned char*)args.ws; asm volatile("" : "+s"(wsp)); float* sm = (float*)(GAS float*)(wsp + WS_SMALL); (void)sm
    float* H = (float*)(GAS float*)args.out;
    const int lo = args.ph_lo, hi = args.ph_hi;
    cg::grid_group grid = cg::this_grid();
#define IN(k) (lo <= (k) && (k) < hi)
#define SEAM(k) do { if (IN(k) && IN((k) + 1)) grid.sync(); } while (0)

    if (IN(PH_PRO)) {
        PHASE_PTRS;
        WSP(bf16_t, WA, WS_WA); WSP(bf16_t, WKVB, WS_WKVB); WSP(bf16_t, WO, WS_WO); WSP(bf16_t, WGU, WS_WGU); WSP(bf16_t, WD, WS_WD); WSP(bf16_t, WMKV, WS_WMKV);
        WSP(bf16_t, XB, WS_XB); WSP(bf16_t, MEMB, WS_MEMB);
        float* LB = sm + SM_LB / 4; float* COS = sm + SM_COS / 4; float* SIN = sm + SM_SIN / 4; float* SS0 = sm + SM_SS0 / 4; float* SS1 = sm + SM_SS1 / 4; float* SS2 = sm + SM_SS2 / 4; float* SS3 = sm + SM_SS3 / 4; float* SSM = sm + SM_SSM / 4;
        int tid = threadIdx.x; asm volatile("" : "+v"(tid)); const int lane = tid & 63, wave = __builtin_amdgcn_readfirstlane(tid >> 6);
        LAS float* scr = (LAS float*)(lds + wave * 16384);
        const int gw = vcu * NWAVES + wave, NGW = G * NWAVES;
        int base = 0;
#define WJOB(W_, g_, K_, N_, o_, map_) do { const int ni_ = ((K_) / 64) * ((N_) / 32); int first_ = gw - (base % NGW); if (first_ < 0) first_ += NGW; \
            for (int it = first_; it < ni_; it += NGW) p0_transpose_item(W_, g_, K_, N_, o_, map_, scr, it, lane); base += ni_; } while (0)
        WJOB(a_w_in, norm_mix, DM, A_COLS, WA, MAP_WA);
        WJOB(w_kv, kv_norm, DM, 2 * AW, WKVB, MAP_KV);
        WJOB(b_w_in, norm_mix + DM, DM, B_COLS, WKVB, MAP_BIN);
        WJOB(w_out, (const float*)nullptr, DM, DM, WO, MAP_STD);
        WJOB(w_out + (size_t)DM * DM, (const float*)nullptr, DM, DM, WO + (size_t)DM * DM, MAP_STD);
        WJOB(w_gate_up, norm_ffn, DM, 2 * FFN, WGU, MAP_GU);
        WJOB(w_gate_up + (size_t)DM * 2 * FFN, norm_ffn + DM, DM, 2 * FFN, WGU + (size_t)2 * FFN * DM, MAP_GU);
        WJOB(w_down, (const float*)nullptr, FFN, DM, WD, MAP_STD);
        WJOB(w_down + (size_t)FFN * DM, (const float*)nullptr, FFN, DM, WD + (size_t)DM * FFN, MAP_STD);
        WJOB(w_mem_kv, mem_norm, DM, 512, WMKV, MAP_MKV0);
        WJOB(w_mem_kv + (size_t)DM * 512, mem_norm + DM, DM, 512, WMKV, MAP_MKV1);
#undef WJOB
        for (int m = gw; m < T; m += NGW) p0_row(x + (size_t)m * DM, XB + (size_t)m * DM, SS0 + m, lane);
        for (int m = gw; m < MROWS; m += NGW) p0_row(mem + (size_t)m * DM, MEMB + (size_t)m * DM, SSM + m, lane);
        const int gt = vcu * NTHREADS + tid, NGT = G * NTHREADS;
        for (int i = gt; i < 4096 * 64; i += NGT) { const int pos = i >> 6, fi = i & 63; const float inv = powf(10000.f, -(float)fi / 64.f); const float ang = (float)pos * inv;
            COS[i] = cosf(ang); SIN[i] = sinf(ang); }
        for (int i = gt; i < T; i += NGT) { SS1[i] = 0.f; SS2[i] = 0.f; SS3[i] = 0.f; }
        for (int i = gt; i < AW; i += NGT) { const float a0 = a_lb[i], a1 = a_lb[AW + i]; const float mx = fmaxf(a0, a1); const float e0 = expf(a0 - mx), e1 = expf(a1 - mx); LB[i] = e0 / (e0 + e1); }
        asm volatile("s_waitcnt vmcnt(0) lgkmcnt(0)" ::: "memory"); __syncthreads();
    }
    SEAM(PH_PRO);
    if (IN(PH_GEMM1)) {
        PHASE_PTRS;
        WSP(bf16_t, WA, WS_WA); WSP(bf16_t, WMKV, WS_WMKV); WSP(bf16_t, XB, WS_XB); WSP(bf16_t, MEMB, WS_MEMB); WSP(bf16_t, MK, WS_MK); WSP(bf16_t, MV, WS_MV);
        WSP(bf16_t, QS, WS_QS); WSP(bf16_t, VV, WS_VV); WSP(bf16_t, SG, WS_SG); WSP(bf16_t, MQ0, WS_MQ0); WSP(float, LF, WS_LF);
        float* LB = sm + SM_LB / 4; float* SS0 = sm + SM_SS0 / 4; float* SSM = sm + SM_SSM / 4;
        { pg8::StaticOrder S; S.init(MROWS, 1024, G, (bx + G / 2) % G);
          pg8::EpiMemKV E{SSM, mem_knorm, MK, MV};
          pg8::gemm_phase(lds, MEMB, WMKV, MROWS, 1024, DM, S, E); }
        { pg8::StaticOrder S; S.init(T, A_COLS, G, bx);
          pg8::EpiInproj0 E{SS0, LB, mem_qnorm, QS, LF, VV, SG, MQ0};
          pg8::gemm_phase(lds, XB, WA, T, A_COLS, DM, S, E); }
    }
    SEAM(PH_GEMM1);
    if (IN(2)) { PHASE_PTRS; WSP(float, LF, WS_LF); WSP(bf16_t, VV, WS_VV); WSP(bf16_t, MQ0, WS_MQ0); WSP(bf16_t, MK, WS_MK); WSP(bf16_t, MV, WS_MV); WSP(bf16_t, MIX, WS_MIX);
        bf16_t* DS = (bf16_t*)H; float* DEC = H + (size_t)24 * 1024 * 1024;
        int tid = threadIdx.x; asm volatile("" : "+v"(tid));
#pragma unroll 1
        for (int i = 0; i < HG_UNITS / 256; ++i) { const int u = vcu * (HG_UNITS / 256) + i; if (G == 256) hgA_unit(lds, u, LF, VV, DS, DEC, tid); }
#pragma unroll 1
        for (int i = 0; i < 4; ++i) { const int u = vcu * 4 + i; if (G == 256) mem_unit(lds, u, MQ0, MK, MV, MIX, tid); }
    }
    SEAM(2);
    if (IN(3)) { bf16_t* DS = (bf16_t*)H; const float* DEC = H + (size_t)24 * 1024 * 1024;
        int tid = threadIdx.x; asm volatile("" : "+v"(tid));
#pragma unroll 1
        for (int it = bx * NTHREADS + tid; it < BATCH * NH * 2048; it += G * NTHREADS) hgB_item(it, DS, DEC);
    }
    SEAM(3);
    if (IN(4)) { PHASE_PTRS; WSP(float, LF, WS_LF); WSP(bf16_t, QS, WS_QS); WSP(bf16_t, VV, WS_VV); WSP(bf16_t, SG, WS_SG); WSP(bf16_t, MIX, WS_MIX);
        const bf16_t* SP = (const bf16_t*)H;
        int tid = threadIdx.x; asm volatile("" : "+v"(tid));
#pragma unroll 1
        for (int i = 0; i < HG_UNITS / 256; ++i) { const int u = vcu * (HG_UNITS / 256) + i; if (G == 256) hgC_unit(lds, u, LF, QS, VV, SG, SP, a_onorm, MIX, tid); }
    }
    SEAM(4);
#pragma unroll 1
    for (int l = 0; l < 2; ++l) {
        const int pb = l == 0 ? PH_WO0 : PH_WO1;
        if (IN(pb)) { PHASE_PTRS; WSP(bf16_t, WO, WS_WO); WSP(bf16_t, XB, WS_XB); WSP(bf16_t, MIX, WS_MIX); float* SS1 = sm + SM_SS1 / 4; float* SS3 = sm + SM_SS3 / 4;
            pg8::StaticOrder S; S.init(T, DM, G, bx);
            pg8::EpiResid E{l == 0 ? x : (const float*)H, H, XB, l == 0 ? SS1 : SS3};
            pg8::gemm_phase(lds, MIX, WO + (size_t)l * DM * DM, T, DM, DM, S, E); }
        SEAM(pb);
        if (IN(pb + 1)) { PHASE_PTRS; WSP(bf16_t, WGU, WS_WGU); WSP(bf16_t, XB, WS_XB); WSP(bf16_t, ACT, WS_ACT); float* SS1 = sm + SM_SS1 / 4; float* SS3 = sm + SM_SS3 / 4;
            pg8::StaticOrder S; S.init(T, 2 * FFN, G, bx);
            pg8::EpiGateUp E{l == 0 ? SS1 : SS3, ACT};
            pg8::gemm_phase(lds, XB, WGU + (size_t)l * 2 * FFN * DM, T, 2 * FFN, DM, S, E); }
        SEAM(pb + 1);
        if (IN(pb + 2)) { PHASE_PTRS; WSP(bf16_t, WD, WS_WD); WSP(bf16_t, XB, WS_XB); WSP(bf16_t, ACT, WS_ACT); float* SS2 = sm + SM_SS2 / 4;
            pg8::StaticOrder S; S.init(T, DM, G, bx);
            pg8::EpiResid E{(const float*)H, H, l == 0 ? XB : (bf16_t*)nullptr, SS2};
            pg8::gemm_phase(lds, ACT, WD + (size_t)l * DM * FFN, T, DM, FFN, S, E); }
        if (l == 0) {
            SEAM(PH_DN0);
            if (IN(PH_KVB)) { PHASE_PTRS; WSP(bf16_t, WKVB, WS_WKVB); WSP(bf16_t, XB, WS_XB); WSP(bf16_t, KR, WS_KR); WSP(bf16_t, VS, WS_VS); WSP(bf16_t, QG, WS_QG); WSP(bf16_t, MQ1, WS_MQ1);
                float* COS = sm + SM_COS / 4; float* SIN = sm + SM_SIN / 4; float* SS2 = sm + SM_SS2 / 4;
                pg8::StaticOrder S; S.init(T, KVB_COLS, G, bx);
                pg8::EpiKVB E{SS2, b_knorm, b_qnorm, mem_qnorm + 64, COS, SIN, KR, VS, QG, MQ1};
                pg8::gemm_phase(lds, XB, WKVB, T, KVB_COLS, DM, S, E); }
            SEAM(PH_KVB);
            if (IN(9)) { PHASE_PTRS; WSP(bf16_t, KR, WS_KR); WSP(bf16_t, VS, WS_VS); WSP(bf16_t, QG, WS_QG); WSP(bf16_t, MQ1, WS_MQ1); WSP(bf16_t, MK, WS_MK); WSP(bf16_t, MV, WS_MV); WSP(bf16_t, MIX, WS_MIX); WSP(float, LSE, WS_LSE);
                int tid = threadIdx.x; asm volatile("" : "+v"(tid));
#pragma unroll 1
                for (int i = 0; i < 18; ++i) { const int u = vcu * 18 + i; if (G == 256) dil_unit(lds, u, KR, VS, QG, LSE, tid); }
#pragma unroll 1
                for (int i = 0; i < 4; ++i) { const int u = vcu * 4 + i; if (G == 256) mem_unit(lds, u, MQ1, MK + (size_t)MROWS * MW, MV + (size_t)MROWS * MW, MIX, tid); }
            }
            SEAM(9);
            if (IN(10)) { PHASE_PTRS; WSP(bf16_t, QG, WS_QG); WSP(bf16_t, MIX, WS_MIX); WSP(float, LSE, WS_LSE);
                int tid = threadIdx.x; asm volatile("" : "+v"(tid));
#pragma unroll 1
                for (int it = bx * NTHREADS + tid; it < T * 96; it += G * NTHREADS) { const int row = it / 96, c8 = it % 96, h = c8 >> 4;
                    const float l0 = LSE[(size_t)row * NH + h], l1 = LSE[((size_t)T + row) * NH + h], l2 = LSE[((size_t)2 * T + row) * NH + h];
                    const float mm = fmaxf(l0, fmaxf(l1, l2)); float w0 = __builtin_amdgcn_exp2f(l0 - mm), w1 = __builtin_amdgcn_exp2f(l1 - mm), w2 = __builtin_amdgcn_exp2f(l2 - mm);
                    const float wi = __builtin_amdgcn_rcpf(w0 + w1 + w2); w0 *= wi; w1 *= wi; w2 *= wi;
                    const u32x4 a = *(const u32x4*)(QG + (size_t)row * AW + c8 * 8), bq = *(const u32x4*)(QG + ((size_t)T + row) * AW + c8 * 8), cq = *(const u32x4*)(QG + ((size_t)2 * T + row) * AW + c8 * 8);
                    const unsigned av[4] = {a.x, a.y, a.z, a.w}, bv[4] = {bq.x, bq.y, bq.z, bq.w}, cv[4] = {cq.x, cq.y, cq.z, cq.w}; unsigned ov[4];
#pragma unroll
                    for (int i = 0; i < 4; ++i) { const float lo = w0 * __uint_as_float(av[i] << 16) + w1 * __uint_as_float(bv[i] << 16) + w2 * __uint_as_float(cv[i] << 16);
                        const float hi = w0 * __uint_as_float(av[i] & 0xffff0000u) + w1 * __uint_as_float(bv[i] & 0xffff0000u) + w2 * __uint_as_float(cv[i] & 0xffff0000u); ov[i] = cvt_pk_bf16(lo, hi); }
                    *(u32x4*)(MIX + (size_t)row * DM + c8 * 8) = (u32x4){ov[0], ov[1], ov[2], ov[3]}; }
            }
            SEAM(10);
        }
    }
#undef IN
#undef SEAM
}

static int g_grid = 0;
static void launch_mk(Args& a, int lo, int hi, hipStream_t stream) {
    a.ph_lo = lo; a.ph_hi = hi;
    void* kargs[] = {&a};
    hipLaunchCooperativeKernel((const void*)mk_fwd, dim3(g_grid), dim3(NTHREADS), kargs, LDS_BYTES, stream);
}
extern "C" void kernel_launch(void* const* d_in, const int* in_sizes, int n_in, void* d_out, int out_size, void* d_ws, size_t ws_size, hipStream_t stream) {
    if (ws_size < WS_END || n_in != 19 || out_size != T * DM) return;
    if (g_grid == 0) {
        int dev = 0, cus = 0, per_cu = 0;
        hipGetDevice(&dev); hipDeviceGetAttribute(&cus, hipDeviceAttributeMultiprocessorCount, dev);
        hipFuncSetAttribute((const void*)mk_fwd, hipFuncAttributeMaxDynamicSharedMemorySize, LDS_BYTES);
        hipOccupancyMaxActiveBlocksPerMultiprocessor(&per_cu, (const void*)mk_fwd, NTHREADS, LDS_BYTES);
        (void)hipGetLastError();
        g_grid = (per_cu >= 1) ? cus : -1;
    }
    if (g_grid < 0) return;
    const float* x = (const float*)d_in[0];
    const float* a_onorm = (const float*)d_in[6];
    char* ws = (char*)d_ws;
    float* sm = (float*)(ws + WS_SMALL);
    bf16_t* MK = (bf16_t*)(ws + WS_MK); bf16_t* MV = (bf16_t*)(ws + WS_MV);
    bf16_t* QS = (bf16_t*)(ws + WS_QS); bf16_t* VV = (bf16_t*)(ws + WS_VV); bf16_t* SG = (bf16_t*)(ws + WS_SG); bf16_t* MQ0 = (bf16_t*)(ws + WS_MQ0);
    float* LF = (float*)(ws + WS_LF);
    bf16_t* KR = (bf16_t*)(ws + WS_KR); bf16_t* VS = (bf16_t*)(ws + WS_VS); bf16_t* QG = (bf16_t*)(ws + WS_QG); bf16_t* MQ1 = (bf16_t*)(ws + WS_MQ1);
    bf16_t* MIX = (bf16_t*)(ws + WS_MIX);
    Args a{};
    for (int i = 0; i < 19; ++i) a.in[i] = (const float*)d_in[i];
    a.out = (float*)d_out; a.ws = (unsigned char*)d_ws;

    launch_mk(a, PH_PRO, PH_END, stream);
}
```

```cpp
#include <hip/hip_runtime.h>
#include <stdint.h>

typedef unsigned short bf16_t;
typedef short bf16x8 __attribute__((ext_vector_type(8)));
typedef float f32x4 __attribute__((ext_vector_type(4)));
typedef unsigned u32x4 __attribute__((ext_vector_type(4)));
typedef unsigned u32x2 __attribute__((ext_vector_type(2)));

constexpr int DM = 1024, BATCH = 8, SEQ = 4096, T = BATCH * SEQ;
constexpr int HD = 128, NH = 6, AW = 768;
constexpr int MEMT = 256, MH = 4, MHD = 64, MW = 256, MROWS = BATCH * MEMT;
constexpr int A_COLS = 4 * AW + MW;
constexpr int B_COLS = 3 * AW + MW;
constexpr int KVB_COLS = 2 * AW + B_COLS;
constexpr int FFN = 2816;
constexpr float EPS = 1e-6f;
constexpr float LOG2E = 1.4426950408889634f;

constexpr size_t MiB = 1u << 20;
constexpr size_t WS_WA    = 0;
constexpr size_t WS_WKVB  = WS_WA + 7 * MiB;
constexpr size_t WS_WO    = WS_WKVB + 8 * MiB;
constexpr size_t WS_WGU   = WS_WO + 4 * MiB;
constexpr size_t WS_WD    = WS_WGU + 22 * MiB;
constexpr size_t WS_WMKV  = WS_WD + 11 * MiB;
constexpr size_t WS_SMALL = WS_WMKV + 2 * MiB;
constexpr size_t SM_LB = 0, SM_COS = 4096, SM_SIN = SM_COS + 4096 * 64 * 4, SM_SS0 = SM_SIN + 4096 * 64 * 4,
                 SM_SS1 = SM_SS0 + T * 4, SM_SS2 = SM_SS1 + T * 4, SM_SS3 = SM_SS2 + T * 4, SM_SSM = SM_SS3 + T * 4, SM_END = SM_SSM + MROWS * 4;
static_assert(SM_END <= 3 * MiB, "small");
constexpr size_t WS_CTL = WS_WMKV + 2 * MiB + 3 * MiB + 512 * 1024;
constexpr size_t WS_XB    = WS_SMALL + 4 * MiB;
constexpr size_t WS_MEMB  = WS_XB + 64 * MiB;
constexpr size_t WS_MK    = WS_MEMB + 4 * MiB;
constexpr size_t WS_MV    = WS_MK + 2 * MiB;
constexpr size_t WS_R1    = WS_MV + 2 * MiB;
constexpr size_t WS_QS    = WS_R1;
constexpr size_t WS_VV    = WS_QS + 48 * MiB;
constexpr size_t WS_SG    = WS_VV + 48 * MiB;
constexpr size_t WS_MQ0   = WS_SG + 48 * MiB;
constexpr size_t WS_LF    = WS_MQ0 + 16 * MiB;
constexpr size_t WS_MIX   = WS_R1 + 256 * MiB;
constexpr size_t WS_TMP   = WS_MIX + 64 * MiB;
constexpr size_t WS_ACT   = WS_R1;
constexpr size_t WS_TMP2  = WS_ACT + 176 * MiB;
constexpr size_t WS_KR    = WS_R1;
constexpr size_t WS_VS    = WS_KR + 48 * MiB;
constexpr size_t WS_QG    = WS_VS + 48 * MiB;
constexpr size_t WS_MQ1   = WS_QG + 144 * MiB;
constexpr size_t WS_LSE   = WS_TMP;
constexpr size_t WS_END   = 512 * MiB;

__device__ __forceinline__ float bf2f(bf16_t v) { return __uint_as_float((unsigned)v << 16); }
__device__ __forceinline__ bf16_t f2bf(float f) { unsigned u = __float_as_uint(f); return (bf16_t)((u + 0x7fffu + ((u >> 16) & 1u)) >> 16); }
__device__ __forceinline__ float silu_f(float v) { return v / (1.f + __expf(-v)); }
__device__ __forceinline__ float wave_sum(float v) {
#pragma unroll
    for (int o = 1; o < 64; o <<= 1) v += __shfl_xor(v, o);
    return v;
}
__device__ __forceinline__ float wave_max(float v) {
#pragma unroll
    for (int o = 1; o < 64; o <<= 1) v = fmaxf(v, __shfl_xor(v, o));
    return v;
}

namespace nv {
__global__ void wt_kernel(const float* __restrict__ W, const float* __restrict__ gain, bf16_t* __restrict__ out, int K, int N, int row_off) {
    __shared__ float tile[32][33];
    const int n0 = blockIdx.x * 32, k0 = blockIdx.y * 32;
    const int tx = threadIdx.x & 31, ty = threadIdx.x >> 5;
    for (int i = ty; i < 32; i += 8) tile[i][tx] = W[(size_t)(k0 + i) * N + n0 + tx] * (gain ? gain[k0 + i] : 1.f);
    __syncthreads();
    for (int i = ty; i < 32; i += 8) out[(size_t)(row_off + n0 + i) * K + k0 + tx] = f2bf(tile[tx][i]);
}
__global__ void rows_kernel(const float* __restrict__ x, bf16_t* __restrict__ xb, float* __restrict__ ss, int rows) {
    const int row = blockIdx.x * 4 + (threadIdx.x >> 6), lane = threadIdx.x & 63;
    if (row >= rows) return;
    const f32x4* xr = (const f32x4*)(x + (size_t)row * DM) + lane;
    float s = 0.f;
#pragma unroll
    for (int j = 0; j < 4; ++j) { f32x4 v = xr[64 * j]; s += v.x * v.x + v.y * v.y + v.z * v.z + v.w * v.w;
        u32x2 o; o.x = f2bf(v.x) | ((unsigned)f2bf(v.y) << 16); o.y = f2bf(v.z) | ((unsigned)f2bf(v.w) << 16);
        *((u32x2*)(xb + (size_t)row * DM) + lane + 64 * j) = o; }
    s = wave_sum(s);
    if (lane == 0) ss[row] = s;
}
__global__ void misc_kernel(const float* __restrict__ lb_logits, float* __restrict__ sm) {
    const int i = blockIdx.x * blockDim.x + threadIdx.x;
    if (i < AW) { const float a0 = lb_logits[i], a1 = lb_logits[AW + i]; const float m = fmaxf(a0, a1); const float e0 = expf(a0 - m), e1 = expf(a1 - m); sm[SM_LB / 4 + i] = e0 / (e0 + e1); }
    if (i < 4096 * 64) { const int pos = i >> 6, fi = i & 63; const float inv = powf(10000.f, -(float)fi / 64.f); const float ang = (float)pos * inv;
        sm[SM_COS / 4 + i] = cosf(ang); sm[SM_SIN / 4 + i] = sinf(ang); }
    if (i < T) { sm[SM_SS1 / 4 + i] = 0.f; sm[SM_SS2 / 4 + i] = 0.f; sm[SM_SS3 / 4 + i] = 0.f; }
}
__global__ __launch_bounds__(256) void gemm_kernel(const bf16_t* __restrict__ A, const bf16_t* __restrict__ Bt, float* __restrict__ C, int K, int ldc) {
    const int wave = threadIdx.x >> 6, lane = threadIdx.x & 63, r = lane & 15, g = lane >> 4;
    const int m0 = blockIdx.y * 128 + (wave >> 1) * 64, n0 = blockIdx.x * 128 + (wave & 1) * 64;
    f32x4 acc[4][4];
#pragma unroll
    for (int i = 0; i < 4; ++i)
#pragma unroll
        for (int j = 0; j < 4; ++j) acc[i][j] = (f32x4){0.f, 0.f, 0.f, 0.f};
    for (int k0 = 0; k0 < K; k0 += 32) {
        bf16x8 a[4], b[4];
#pragma unroll
        for (int i = 0; i < 4; ++i) a[i] = *(const bf16x8*)(A + (size_t)(m0 + 16 * i + r) * K + k0 + 8 * g);
#pragma unroll
        for (int j = 0; j < 4; ++j) b[j] = *(const bf16x8*)(Bt + (size_t)(n0 + 16 * j + r) * K + k0 + 8 * g);
#pragma unroll
        for (int i = 0; i < 4; ++i)
#pragma unroll
            for (int j = 0; j < 4; ++j) acc[i][j] = __builtin_amdgcn_mfma_f32_16x16x32_bf16(a[i], b[j], acc[i][j], 0, 0, 0);
    }
#pragma unroll
    for (int i = 0; i < 4; ++i)
#pragma unroll
        for (int j = 0; j < 4; ++j)
#pragma unroll
            for (int e = 0; e < 4; ++e) C[(size_t)(m0 + 16 * i + 4 * g + e) * ldc + n0 + 16 * j + r] = acc[i][j][e];
}
__device__ __forceinline__ float rs_of(const float* ss, int row) { return rsqrtf(ss[row] * (1.f / DM) + EPS); }

__global__ __launch_bounds__(256) void epi_inproj0(const float* __restrict__ C, int row0, const float* __restrict__ ss, const float* __restrict__ lb, const float* __restrict__ mqn,
                                                   bf16_t* QS, float* LF, bf16_t* VV, bf16_t* SG, bf16_t* MQ) {
    const int lr = blockIdx.x, row = row0 + lr, tid = threadIdx.x;
    const float rs = rs_of(ss, row);
    const float* c = C + (size_t)lr * A_COLS;
    for (int d = tid; d < AW; d += 256) {
        QS[(size_t)row * AW + d] = f2bf(silu_f(c[d] * rs));
        const float z = c[AW + d] * rs, l = lb[d]; const float f = l + (1.f - l) / (1.f + __expf(-z));
        LF[(size_t)row * AW + d] = __logf(f);
        VV[(size_t)row * AW + d] = f2bf(c[2 * AW + d] * rs);
        SG[(size_t)row * AW + d] = f2bf(silu_f(c[3 * AW + d] * rs));
    }
    const int w = tid >> 6, lane = tid & 63;
    const float v = c[4 * AW + w * 64 + lane] * rs;
    const float s2 = wave_sum(v * v);
    const float r2 = rsqrtf(s2 * (1.f / 64.f) + EPS);
    MQ[(size_t)row * MW + w * 64 + lane] = f2bf(v * r2 * mqn[lane] * (0.125f * LOG2E));
}
__global__ __launch_bounds__(256) void epi_memkv(const float* __restrict__ C, const float* __restrict__ ss, const float* __restrict__ mkn, bf16_t* MK, bf16_t* MV) {
    const int row = blockIdx.x, tid = threadIdx.x, w = tid >> 6, lane = tid & 63;
    const float rs = rs_of(ss, row);
    const float* c = C + (size_t)row * 1024;
    for (int l = 0; l < 2; ++l) {
        const float v = c[l * 512 + w * 64 + lane] * rs;
        const float s2 = wave_sum(v * v);
        const float r2 = rsqrtf(s2 * (1.f / 64.f) + EPS);
        MK[((size_t)l * MROWS + row) * MW + w * 64 + lane] = f2bf(v * r2 * mkn[l * 64 + lane]);
        MV[((size_t)l * MROWS + row) * MW + tid] = f2bf(c[l * 512 + 256 + tid] * rs);
    }
}
__global__ __launch_bounds__(256) void epi_resid(const float* __restrict__ C, int row0, const float* base, float* H, bf16_t* HB, float* ssn) {
    __shared__ float red[4];
    const int lr = blockIdx.x, row = row0 + lr, tid = threadIdx.x;
    float s = 0.f;
    for (int d = tid; d < DM; d += 256) { const float v = base[(size_t)row * DM + d] + C[(size_t)lr * DM + d]; H[(size_t)row * DM + d] = v; if (HB) HB[(size_t)row * DM + d] = f2bf(v); s += v * v; }
    s = wave_sum(s);
    if ((tid & 63) == 0) red[tid >> 6] = s;
    __syncthreads();
    if (tid == 0 && ssn) ssn[row] = red[0] + red[1] + red[2] + red[3];
}
__global__ __launch_bounds__(256) void epi_gateup(const float* __restrict__ C, int row0, const float* __restrict__ ss, bf16_t* ACT) {
    const int lr = blockIdx.x, row = row0 + lr, tid = threadIdx.x;
    const float rs = rs_of(ss, row);
    const float* c = C + (size_t)lr * (2 * FFN);
    for (int j = tid; j < FFN; j += 256) ACT[(size_t)row * FFN + j] = f2bf(silu_f(c[j] * rs) * (c[FFN + j] * rs));
}
__global__ __launch_bounds__(256) void epi_kvb(const float* __restrict__ C, int row0, const float* __restrict__ ss, const float* __restrict__ knorm, const float* __restrict__ qnorm  ,
                                               const float* __restrict__ mqn, const float* __restrict__ cs, const float* __restrict__ sn,
                                               bf16_t* KR, bf16_t* VS, bf16_t* QG, bf16_t* MQ) {
    const int lr = blockIdx.x, row = row0 + lr, tid = threadIdx.x, w = tid >> 6, lane = tid & 63;
    const int pos = row & (SEQ - 1);
    const float rs = rs_of(ss, row);
    const float* c = C + (size_t)lr * KVB_COLS;
    const float co = cs[pos * 64 + lane], si = sn[pos * 64 + lane];
    for (int hv = w; hv < 30; hv += 4) {
        const float x1 = c[hv * 128 + lane] * rs, x2 = c[hv * 128 + 64 + lane] * rs;
        if (hv >= 6 && hv < 12) { VS[(size_t)row * AW + (hv - 6) * 128 + lane] = f2bf(x1); VS[(size_t)row * AW + (hv - 6) * 128 + 64 + lane] = f2bf(x2); continue; }
        const float s2 = wave_sum(x1 * x1 + x2 * x2);
        const float r2 = rsqrtf(s2 * (1.f / 128.f) + EPS);
        const float* gn = hv < 6 ? knorm : qnorm + ((hv - 12) / 6) * 128;
        const float sc = hv < 6 ? 1.f : (0.08838834764831845f * LOG2E);
        const float y1 = x1 * r2 * gn[lane] * sc, y2 = x2 * r2 * gn[64 + lane] * sc;
        const float o1 = y1 * co - y2 * si, o2 = y2 * co + y1 * si;
        bf16_t* dst = hv < 6 ? KR + (size_t)row * AW + hv * 128 : QG + ((size_t)((hv - 12) / 6) * T + row) * AW + ((hv - 12) % 6) * 128;
        dst[lane] = f2bf(o1); dst[64 + lane] = f2bf(o2);
    }
    const float v = c[30 * 128 + w * 64 + lane] * rs;
    const float s2 = wave_sum(v * v);
    const float r2 = rsqrtf(s2 * (1.f / 64.f) + EPS);
    MQ[(size_t)row * MW + w * 64 + lane] = f2bf(v * r2 * mqn[lane] * (0.125f * LOG2E));
}
__global__ __launch_bounds__(256) void hgrn_kernel(const bf16_t* __restrict__ QS, const float* __restrict__ LF, const bf16_t* __restrict__ VV, const bf16_t* __restrict__ SG,
                                                   const float* __restrict__ onorm, bf16_t* MIX) {
    __shared__ float qs[128], kk[128], ff[128], vv[128], part[256], red[2];
    const int b = blockIdx.x / NH, h = blockIdx.x % NH, tid = threadIdx.x, dv = tid & 127, half = tid >> 7;
    float S[64];
#pragma unroll
    for (int i = 0; i < 64; ++i) S[i] = 0.f;
    for (int t = 0; t < SEQ; ++t) {
        const size_t off = (size_t)(b * SEQ + t) * AW + h * 128;
        if (tid < 128) { const float f = __expf(LF[off + tid]); ff[tid] = f; kk[tid] = 1.f - f; qs[tid] = bf2f(QS[off + tid]); vv[tid] = bf2f(VV[off + tid]); }
        __syncthreads();
        const float v = vv[dv]; float o = 0.f;
#pragma unroll
        for (int i = 0; i < 64; ++i) { const int dk = half * 64 + i; S[i] = ff[dk] * S[i] + kk[dk] * v; o += S[i] * qs[dk]; }
        part[tid] = o;
        __syncthreads();
        if (tid < 128) { o = part[tid] + part[tid + 128]; const float s2 = wave_sum(o * o); if ((tid & 63) == 0) red[tid >> 6] = s2; part[tid] = o; }
        __syncthreads();
        if (tid < 128) { const float r2 = rsqrtf((red[0] + red[1]) * (1.f / 128.f) + EPS);
            MIX[(size_t)(b * SEQ + t) * DM + h * 128 + tid] = f2bf(part[tid] * r2 * onorm[h * 128 + tid] * bf2f(SG[off + tid])); }
    }
}
__global__ __launch_bounds__(256) void memattn_kernel(const bf16_t* __restrict__ MQ, const bf16_t* __restrict__ MK, const bf16_t* __restrict__ MV, bf16_t* MIX) {
    __shared__ float qsh[4][64];
    const int w = threadIdx.x >> 6, lane = threadIdx.x & 63;
    const int item = blockIdx.x * 4 + w, row = item >> 2, hd = item & 3, b = row / SEQ;
    qsh[w][lane] = bf2f(MQ[(size_t)row * MW + hd * 64 + lane]);
    __syncthreads();
    float s[4], m = -1e30f;
#pragma unroll
    for (int j = 0; j < 4; ++j) { const bf16_t* kr = MK + ((size_t)(b * MEMT + lane + 64 * j)) * MW + hd * 64; float a = 0.f;
        for (int c8 = 0; c8 < 8; ++c8) { const bf16x8 kv = *(const bf16x8*)(kr + 8 * c8);
#pragma unroll
            for (int e = 0; e < 8; ++e) a += qsh[w][c8 * 8 + e] * bf2f((bf16_t)kv[e]); }
        s[j] = a; m = fmaxf(m, a); }
    m = wave_max(m);
    float l = 0.f;
#pragma unroll
    for (int j = 0; j < 4; ++j) { s[j] = exp2f(s[j] - m); l += s[j]; }
    l = wave_sum(l);
    float o = 0.f;
#pragma unroll
    for (int j = 0; j < 4; ++j)
        for (int kq = 0; kq < 64; ++kq) { const float p = __shfl(s[j], kq); o += p * bf2f(MV[((size_t)(b * MEMT + kq + 64 * j)) * MW + hd * 64 + lane]); }
    MIX[(size_t)row * DM + AW + hd * 64 + lane] = f2bf(o / l);
}
__global__ __launch_bounds__(256) void dilattn_kernel(const bf16_t* __restrict__ QG, const bf16_t* __restrict__ KR, const bf16_t* __restrict__ VS, bf16_t* MIX) {
    __shared__ float qsh[4][3][128];
    const int w = threadIdx.x >> 6, lane = threadIdx.x & 63;
    const int item = blockIdx.x * 4 + w, row = item / NH, h = item % NH, b = row / SEQ, t = row % SEQ;
#pragma unroll
    for (int g = 0; g < 3; ++g) { qsh[w][g][lane] = bf2f(QG[((size_t)g * T + row) * AW + h * 128 + lane]); qsh[w][g][64 + lane] = bf2f(QG[((size_t)g * T + row) * AW + h * 128 + 64 + lane]); }
    __syncthreads();
    float s[3][3]; float m = -1e30f;
#pragma unroll
    for (int g = 0; g < 3; ++g) { const int dil = g == 0 ? 1 : (g == 1 ? 4 : 16);
#pragma unroll
        for (int jj = 0; jj < 3; ++jj) { const int j = lane + 64 * jj; const int pk = t - j * dil; float a = -1e30f;
            if (j <= 128 && pk >= 0) { const bf16_t* kr = KR + ((size_t)(b * SEQ + pk)) * AW + h * 128; a = 0.f; for (int c8 = 0; c8 < 16; ++c8) { const bf16x8 kv = *(const bf16x8*)(kr + 8 * c8);
#pragma unroll
                for (int e = 0; e < 8; ++e) a += qsh[w][g][c8 * 8 + e] * bf2f((bf16_t)kv[e]); } }
            s[g][jj] = a; m = fmaxf(m, a); } }
    m = wave_max(m);
    float l = 0.f;
#pragma unroll
    for (int g = 0; g < 3; ++g)
#pragma unroll
        for (int jj = 0; jj < 3; ++jj) { const float p = s[g][jj] > -1e29f ? exp2f(s[g][jj] - m) : 0.f; s[g][jj] = p; l += p; }
    l = wave_sum(l);
    float o0 = 0.f, o1 = 0.f;
#pragma unroll
    for (int g = 0; g < 3; ++g) { const int dil = g == 0 ? 1 : (g == 1 ? 4 : 16);
#pragma unroll
        for (int jj = 0; jj < 3; ++jj) {
            const int nk = jj < 2 ? 64 : 1;
            for (int kq = 0; kq < nk; ++kq) { const int j = kq + 64 * jj; const int pk = t - j * dil; if (pk < 0) break;
                const float p = __shfl(s[g][jj], kq);
                const bf16_t* vr = VS + ((size_t)(b * SEQ + pk)) * AW + h * 128;
                o0 += p * bf2f(vr[lane]); o1 += p * bf2f(vr[64 + lane]); } } }
    MIX[(size_t)row * DM + h * 128 + lane] = f2bf(o0 / l); MIX[(size_t)row * DM + h * 128 + 64 + lane] = f2bf(o1 / l);
}
}

#define LAS __attribute__((address_space(3)))
#define GAS __attribute__((address_space(1)))

constexpr int NTHREADS = 512, NWAVES = 8;
constexpr int RING_BYTES = 131072;
constexpr int XSCR_OFF = RING_BYTES;
constexpr int LDS_BYTES = 147456;
constexpr int MISC_OFF = LDS_BYTES - 256;

__host__ __device__ __forceinline__ int rho_of(int r) { return 16 * ((r >> 2) & 1) + 4 * (r >> 3) + (r & 3); }
__host__ __device__ __forceinline__ int slot_std(int c) { return (c & ~31) + rho_of(c & 31); }
__host__ __device__ __forceinline__ int slot_rope(int d) { return 32 * ((d & 63) >> 4) + 16 * (d >> 6) + (d & 15); }
__host__ __device__ __forceinline__ int slot_mq(int c) { return 128 * ((c >> 5) & 1) + 32 * (c >> 6) + rho_of(c & 31); }
enum { MAP_WA = 0, MAP_KV = 1, MAP_BIN = 2, MAP_STD = 3, MAP_GU = 4, MAP_MKV0 = 5, MAP_MKV1 = 6 };
__device__ __forceinline__ int dst_row(int map, int n) {
    switch (map) {
    case MAP_WA:  return n < 3072 ? (n & ~127) + slot_std(n & 127) : 3072 + slot_mq(n - 3072);
    case MAP_KV:  return n < 768 ? (n & ~127) + slot_rope(n & 127) : (n & ~127) + slot_std(n & 127);
    case MAP_BIN: return n < 2304 ? 1536 + (n & ~127) + slot_rope(n & 127) : 3840 + slot_mq(n - 2304);
    case MAP_STD: return (n & ~127) + slot_std(n & 127);
    case MAP_GU:  return n < FFN ? 256 * (n >> 7) + slot_std(n & 127) : 256 * ((n - FFN) >> 7) + 128 + slot_std((n - FFN) & 127);
    case MAP_MKV0: return n < 256 ? slot_mq(n) : 256 + ((n - 256) & ~127) + slot_std((n - 256) & 127);
    default:       return 512 + (n < 256 ? slot_mq(n) : 256 + ((n - 256) & ~127) + slot_std((n - 256) & 127));
    }
}

typedef float f32x2_t __attribute__((ext_vector_type(2))); typedef __bf16 bf16x2_t __attribute__((ext_vector_type(2)));
__device__ __forceinline__ unsigned cvt_pk_bf16(float lo, float hi) { f32x2_t v = {lo, hi}; bf16x2_t b = __builtin_convertvector(v, bf16x2_t); return __builtin_bit_cast(unsigned, b); }
__device__ __forceinline__ float fast_sigmoid(float v) { return __builtin_amdgcn_rcpf(1.f + __builtin_amdgcn_exp2f(-LOG2E * v)); }
__device__ __forceinline__ float fast_silu(float v) { return v * fast_sigmoid(v); }

namespace pg8 {
constexpr int BM = 256, BK = 64, HALF = 128, HTB = HALF * BK * 2, STAGE_BYTES = 8 * HTB, NXCD = 8, WGM = 8;
__host__ __device__ __forceinline__ int lds_byte(int r, int c) { const int st = (r >> 4) * 2 + (c >> 5), rr = r & 15, cc = c & 31, ob = rr * 64 + cc * 2; return st * 1024 + (ob ^ (((ob >> 9) & 1) << 5)); }
__host__ __device__ __forceinline__ void stage_rc(int b, int& R, int& C) { const int st = b / 1024, sb = b % 1024, swz = sb ^ (((sb >> 9) & 1) << 5); R = (st >> 1) * 16 + swz / 64; C = (st & 1) * 32 + (swz % 64) / 2; }
struct Unit { int pm, pn; };
struct StaticOrder {
    int nM, nN, nwg, G, c;
    __device__ void init(int M, int N, int G_, int c_) { nM = M / BM; nN = N / BM; nwg = nM * nN; G = G_; c = c_; }
    __device__ bool next(int i, Unit& u) const {
        const long L = (long)i * G + c; if (L >= nwg) return false;
        int wgid = (int)L; { const int q = nwg / NXCD, r = nwg % NXCD, xcd = wgid % NXCD, off = wgid / NXCD; wgid = (xcd < r ? xcd * (q + 1) : r * (q + 1) + (xcd - r) * q) + off; }
        const int nig = WGM * nN, gid = wgid / nig, fm = gid * WGM, gsz = (nM - fm) < WGM ? (nM - fm) : WGM;
        u.pm = fm + ((wgid % nig) % gsz); u.pn = (wgid % nig) / gsz; return true;
    }
};
typedef f32x4 Acc[2][2][4][2];

template <class Epi>
__device__ __forceinline__ void gemm_phase(LAS unsigned char* lds, const bf16_t* A, const bf16_t* Bt, int M, int N, int K, const StaticOrder& S, const Epi& E) {
    int tid = threadIdx.x; asm volatile("" : "+v"(tid));
    const int wid = __builtin_amdgcn_readfirstlane(tid >> 6), lane = tid & 63, wr = wid >> 2, wc = wid & 3, fr = lane & 15, fq = lane >> 4;
    const int nt = K / BK;
    unsigned voff[2];
#pragma unroll
    for (int i = 0; i < 2; ++i) { int R, C; stage_rc(tid * 16 + i * 8192, R, C); voff[i] = (unsigned)(R * K + C) * 2u; }
    const size_t kstep = (size_t)(BK * 2);
    const size_t hstep = (size_t)HALF * K * 2;
    const size_t tstep = 2 * hstep;
    const unsigned ldsw = (unsigned)wid * 1024u;
    const int aoff = lds_byte(wr * 64 + fr, fq * 8), boff = lds_byte(wc * 32 + fr, fq * 8);
#define PG8_SA(b, h) (((b) * 2 + (h)) * HTB)
#define PG8_SB(b, h) ((4 + (b) * 2 + (h)) * HTB)
#define PG8_STAGE(bufoff, gbase) do { _Pragma("unroll") for (int _i = 0; _i < 2; ++_i) \
        __builtin_amdgcn_global_load_lds((const unsigned*)((const char*)(gbase) + voff[_i]), (LAS unsigned*)(lds + (bufoff) + ldsw + _i * 8192), 16, 0, 0); } while (0)
#define PG8_LDA(dst, b, h) do { _Pragma("unroll") for (int m = 0; m < 4; ++m) _Pragma("unroll") for (int k = 0; k < 2; ++k) dst[m][k] = *(const LAS bf16x8*)(lds + PG8_SA(b, h) + aoff + m * 2048 + k * 1024); } while (0)
#define PG8_LDB(dst, b, h) do { _Pragma("unroll") for (int n = 0; n < 2; ++n) _Pragma("unroll") for (int k = 0; k < 2; ++k) dst[n][k] = *(const LAS bf16x8*)(lds + PG8_SB(b, h) + boff + n * 2048 + k * 1024); } while (0)
#define PG8_MMA(ai, bj, At, Bt_) do { __builtin_amdgcn_s_setprio(1); _Pragma("unroll") for (int m = 0; m < 4; ++m) _Pragma("unroll") for (int n = 0; n < 2; ++n) _Pragma("unroll") for (int k = 0; k < 2; ++k) \
        acc[ai][bj][m][n] = __builtin_amdgcn_mfma_f32_16x16x32_bf16(Bt_[n][k], At[m][k], acc[ai][bj][m][n], 0, 0, 0); __builtin_amdgcn_s_setprio(0); } while (0)
#define PG8_WAIT_V(n) asm volatile("s_waitcnt vmcnt(" #n ")" ::: "memory")
#define PG8_WAIT_L(n) asm volatile("s_waitcnt lgkmcnt(" #n ")" ::: "memory")
#define PG8_BAR __builtin_amdgcn_s_barrier()
#define PG8_SCHED __builtin_amdgcn_sched_barrier(0)
    Unit cur, nxt; int ui = 0;
    if (!S.next(0, cur)) return;
    Acc acc;
#pragma unroll
    for (int a = 0; a < 2; ++a)
#pragma unroll
        for (int b = 0; b < 2; ++b)
#pragma unroll
            for (int m = 0; m < 4; ++m)
#pragma unroll
                for (int n = 0; n < 2; ++n) acc[a][b][m][n] = (f32x4){0.f, 0.f, 0.f, 0.f};
    bf16x8 At[4][2], B0[2][2], B1[2][2];
    const char* cA = (const char*)A + (size_t)cur.pm * tstep; const char* cB = (const char*)Bt + (size_t)cur.pn * tstep;
    PG8_STAGE(PG8_SB(0, 0), cB); PG8_STAGE(PG8_SB(0, 1), cB + hstep); PG8_STAGE(PG8_SA(0, 0), cA); PG8_STAGE(PG8_SA(0, 1), cA + hstep);
    if (wr == 1) PG8_BAR;
    PG8_WAIT_V(2); PG8_BAR;
    PG8_STAGE(PG8_SB(1, 0), cB + kstep); PG8_STAGE(PG8_SA(1, 0), cA + kstep); PG8_STAGE(PG8_SB(1, 1), cB + hstep + kstep);
    PG8_WAIT_V(6); PG8_BAR;
    for (;;) {
        const bool has_next = S.next(ui + 1, nxt);
        const char* nA = has_next ? (const char*)A + (size_t)nxt.pm * tstep : cA; const char* nB = has_next ? (const char*)Bt + (size_t)nxt.pn * tstep : cB;
        for (int t = 0; t < nt; t += 2) {
            const bool last = (t == nt - 2);
            const char* a1 = cA + (size_t)(t + 1) * kstep;
            const char* a2 = last ? nA : cA + (size_t)(t + 2) * kstep; const char* b2 = last ? nB : cB + (size_t)(t + 2) * kstep;
            const char* a3 = a2 + kstep; const char* b3 = b2 + kstep;
            PG8_LDB(B0, 0, 0); PG8_LDB(B1, 0, 1); PG8_SCHED; PG8_LDA(At, 0, 0); PG8_STAGE(PG8_SA(1, 1), a1 + hstep);
            PG8_WAIT_V(8); PG8_WAIT_L(0); PG8_BAR; PG8_MMA(0, 0, At, B0); PG8_MMA(0, 1, At, B1); PG8_BAR; PG8_SCHED;
            PG8_LDA(At, 0, 1); PG8_STAGE(PG8_SB(0, 0), b2); PG8_STAGE(PG8_SB(0, 1), b2 + hstep); PG8_STAGE(PG8_SA(0, 0), a2);
            PG8_WAIT_V(8); PG8_WAIT_L(0); PG8_BAR; PG8_MMA(1, 0, At, B0); PG8_MMA(1, 1, At, B1); PG8_BAR; PG8_SCHED;
            PG8_LDB(B0, 1, 0); PG8_LDB(B1, 1, 1); PG8_SCHED; PG8_LDA(At, 1, 0); PG8_STAGE(PG8_SA(0, 1), a2 + hstep);
            PG8_WAIT_V(8); PG8_WAIT_L(0); PG8_BAR; PG8_MMA(0, 0, At, B0); PG8_MMA(0, 1, At, B1); PG8_BAR; PG8_SCHED;
            PG8_LDA(At, 1, 1); PG8_STAGE(PG8_SB(1, 0), b3); PG8_STAGE(PG8_SB(1, 1), b3 + hstep); PG8_STAGE(PG8_SA(1, 0), a3);
            PG8_WAIT_V(8); PG8_WAIT_L(0); PG8_BAR; PG8_MMA(1, 0, At, B0); PG8_MMA(1, 1, At, B1); PG8_BAR; PG8_SCHED;
        }
        if (wr == 0) PG8_BAR;
        E(acc, cur, wr, wc, fr, fq, lds);
        if (!has_next) break;
#pragma unroll
        for (int a = 0; a < 2; ++a)
#pragma unroll
            for (int b = 0; b < 2; ++b)
#pragma unroll
                for (int m = 0; m < 4; ++m)
#pragma unroll
                    for (int n = 0; n < 2; ++n) acc[a][b][m][n] = (f32x4){0.f, 0.f, 0.f, 0.f};
        cur = nxt; cA = nA; cB = nB; ++ui;
        if (wr == 1) PG8_BAR;
    }
    PG8_WAIT_V(0);
    PG8_BAR;
#undef PG8_SA
#undef PG8_SB
#undef PG8_STAGE
#undef PG8_LDA
#undef PG8_LDB
#undef PG8_MMA
#undef PG8_WAIT_V
#undef PG8_WAIT_L
#undef PG8_BAR
#undef PG8_SCHED
}

__device__ __forceinline__ float rs_of(const float* ss, int row) { return __builtin_amdgcn_rsqf(ss[row] * (1.f / DM) + EPS); }
__device__ __forceinline__ u32x4 pack8(const f32x4& a, const f32x4& b) { u32x4 w; w.x = cvt_pk_bf16(a[0], a[1]); w.y = cvt_pk_bf16(a[2], a[3]); w.z = cvt_pk_bf16(b[0], b[1]); w.w = cvt_pk_bf16(b[2], b[3]); return w; }

__device__ __forceinline__ void head64_store(f32x4 a0, f32x4 a1, f32x4 b0, f32x4 b1, float rs, const float* gain, float scale, bf16_t* dst  , int fq) {
    a0 *= rs; a1 *= rs; b0 *= rs; b1 *= rs;
    float s = 0.f;
#pragma unroll
    for (int e = 0; e < 4; ++e) s += a0[e] * a0[e] + a1[e] * a1[e] + b0[e] * b0[e] + b1[e] * b1[e];
    s += __shfl_xor(s, 16); s += __shfl_xor(s, 32);
    const float r2 = __builtin_amdgcn_rsqf(s * (1.f / 64.f) + EPS) * scale;
    const f32x4 g0 = *(const f32x4*)(gain + 8 * fq), g1 = *(const f32x4*)(gain + 8 * fq + 4), g2 = *(const f32x4*)(gain + 32 + 8 * fq), g3 = *(const f32x4*)(gain + 32 + 8 * fq + 4);
    *(u32x4*)(dst + 8 * fq) = pack8(a0 * g0 * r2, a1 * g1 * r2);
    *(u32x4*)(dst + 32 + 8 * fq) = pack8(b0 * g2 * r2, b1 * g3 * r2);
}

struct EpiInproj0 {
    const float* ss; const float* lb; const float* mqn; bf16_t* QS; float* LF; bf16_t* VV; bf16_t* SG; bf16_t* MQ;
    __device__ __forceinline__ void operator()(const Acc& acc, const Unit& u, int wr, int wc, int fr, int fq, LAS unsigned char*) const {
        const int row0 = u.pm * BM + wr * 64 + fr, pn = u.pn;
        if (pn == 12) {
#pragma unroll
            for (int ai = 0; ai < 2; ++ai)
#pragma unroll
                for (int m = 0; m < 4; ++m) { const int row = row0 + ai * HALF + m * 16;
                    head64_store(acc[ai][0][m][0], acc[ai][0][m][1], acc[ai][1][m][0], acc[ai][1][m][1], rs_of(ss, row), mqn, 0.125f * LOG2E, MQ + (size_t)row * MW + 64 * wc, fq); }
            return;
        }
        const int kind = pn / 3, colb = (pn % 3) * 256 + wc * 32 + 8 * fq;
        f32x4 lbv[2][2];
        if (kind == 1) {
#pragma unroll
            for (int bj = 0; bj < 2; ++bj) { lbv[bj][0] = *(const f32x4*)(lb + colb + bj * HALF); lbv[bj][1] = *(const f32x4*)(lb + colb + bj * HALF + 4); }
        }
#pragma unroll
        for (int ai = 0; ai < 2; ++ai)
#pragma unroll
            for (int m = 0; m < 4; ++m) { const int row = row0 + ai * HALF + m * 16; const float rs = rs_of(ss, row);
#pragma unroll
                for (int bj = 0; bj < 2; ++bj) { f32x4 v0 = acc[ai][bj][m][0] * rs, v1 = acc[ai][bj][m][1] * rs; const size_t o = (size_t)row * AW + colb + bj * HALF;
                    if (kind == 1) {
#pragma unroll
                        for (int e = 0; e < 4; ++e) { const float l0 = lbv[bj][0][e], l1 = lbv[bj][1][e];
                            v0[e] = __builtin_amdgcn_logf(l0 + (1.f - l0) * fast_sigmoid(v0[e])) * 0.6931471805599453f; v1[e] = __builtin_amdgcn_logf(l1 + (1.f - l1) * fast_sigmoid(v1[e])) * 0.6931471805599453f; }
                        *(f32x4*)(LF + o) = v0; *(f32x4*)(LF + o + 4) = v1;
                    } else {
                        if (kind != 2) {
#pragma unroll
                            for (int e = 0; e < 4; ++e) { v0[e] = fast_silu(v0[e]); v1[e] = fast_silu(v1[e]); } }
                        bf16_t* dst = QS + (size_t)(kind == 0 ? 0 : kind - 1) * ((size_t)T * AW);
                        *(u32x4*)(dst + o) = pack8(v0, v1);
                    } } }
    }
};
struct EpiMemKV {
    const float* ss; const float* mkn; bf16_t* MK; bf16_t* MV;
    __device__ __forceinline__ void operator()(const Acc& acc, const Unit& u, int wr, int wc, int fr, int fq, LAS unsigned char*) const {
        const int row0 = u.pm * BM + wr * 64 + fr, l = u.pn >> 1;
#pragma unroll
        for (int ai = 0; ai < 2; ++ai)
#pragma unroll
            for (int m = 0; m < 4; ++m) { const int row = row0 + ai * HALF + m * 16; const float rs = rs_of(ss, row);
                if ((u.pn & 1) == 0) head64_store(acc[ai][0][m][0], acc[ai][0][m][1], acc[ai][1][m][0], acc[ai][1][m][1], rs, mkn + l * 64, 1.f, MK + ((size_t)l * MROWS + row) * MW + 64 * wc, fq);
                else {
#pragma unroll
                    for (int bj = 0; bj < 2; ++bj) *(u32x4*)(MV + ((size_t)l * MROWS + row) * MW + bj * HALF + wc * 32 + 8 * fq) = pack8(acc[ai][bj][m][0] * rs, acc[ai][bj][m][1] * rs); } }
    }
};
struct EpiResid {
    const float* base; float* H; bf16_t* HB; float* ssn;
    __device__ __forceinline__ void operator()(const Acc& acc, const Unit& u, int wr, int wc, int fr, int fq, LAS unsigned char*) const {
        const int row0 = u.pm * BM + wr * 64 + fr, col0 = u.pn * BM + wc * 32 + 8 * fq;
#pragma unroll
        for (int ai = 0; ai < 2; ++ai)
#pragma unroll
            for (int m = 0; m < 4; ++m) { const int row = row0 + ai * HALF + m * 16; float s = 0.f;
#pragma unroll
                for (int bj = 0; bj < 2; ++bj) { const size_t o = (size_t)row * DM + col0 + bj * HALF;
                    const f32x4 v0 = *(const f32x4*)(base + o) + acc[ai][bj][m][0], v1 = *(const f32x4*)(base + o + 4) + acc[ai][bj][m][1];
                    *(f32x4*)(H + o) = v0; *(f32x4*)(H + o + 4) = v1;
                    if (HB) { *(u32x4*)(HB + o) = pack8(v0, v1);
#pragma unroll
                        for (int e = 0; e < 4; ++e) s += v0[e] * v0[e] + v1[e] * v1[e]; } }
                if (HB) { s += __shfl_xor(s, 16); s += __shfl_xor(s, 32); if (fq == 0) atomicAdd(ssn + row, s); }
                if (m & 1) asm volatile("" ::: "memory"); }
    }
};
struct EpiGateUp {
    const float* ss; bf16_t* ACT;
    __device__ __forceinline__ void operator()(const Acc& acc, const Unit& u, int wr, int wc, int fr, int fq, LAS unsigned char*) const {
        const int row0 = u.pm * BM + wr * 64 + fr, col0 = u.pn * HALF + wc * 32 + 8 * fq;
#pragma unroll
        for (int ai = 0; ai < 2; ++ai)
#pragma unroll
            for (int m = 0; m < 4; ++m) { const int row = row0 + ai * HALF + m * 16; const float rs = rs_of(ss, row);
                f32x4 o0, o1;
#pragma unroll
                for (int e = 0; e < 4; ++e) { o0[e] = fast_silu(acc[ai][0][m][0][e] * rs) * (acc[ai][1][m][0][e] * rs); o1[e] = fast_silu(acc[ai][0][m][1][e] * rs) * (acc[ai][1][m][1][e] * rs); }
                *(u32x4*)(ACT + (size_t)row * FFN + col0) = pack8(o0, o1); }
    }
};
struct EpiKVB {
    const float* ss; const float* knorm; const float* qnorm; const float* mqn; const float* cs; const float* sn; bf16_t* KR; bf16_t* VS; bf16_t* QG; bf16_t* MQ;
    __device__ __forceinline__ void operator()(const Acc& acc, const Unit& u, int wr, int wc, int fr, int fq, LAS unsigned char* lds) const {
        const int row0 = u.pm * BM + wr * 64 + fr, pn = u.pn;
        if (pn == 15) {
#pragma unroll
            for (int ai = 0; ai < 2; ++ai)
#pragma unroll
                for (int m = 0; m < 4; ++m) { const int row = row0 + ai * HALF + m * 16;
                    head64_store(acc[ai][0][m][0], acc[ai][0][m][1], acc[ai][1][m][0], acc[ai][1][m][1], rs_of(ss, row), mqn, 0.125f * LOG2E, MQ + (size_t)row * MW + 64 * wc, fq); }
            return;
        }
        if (pn >= 3 && pn < 6) {
#pragma unroll
            for (int ai = 0; ai < 2; ++ai)
#pragma unroll
                for (int m = 0; m < 4; ++m) { const int row = row0 + ai * HALF + m * 16; const float rs = rs_of(ss, row);
#pragma unroll
                    for (int bj = 0; bj < 2; ++bj) *(u32x4*)(VS + (size_t)row * AW + (pn - 3) * 256 + bj * HALF + wc * 32 + 8 * fq) = pack8(acc[ai][bj][m][0] * rs, acc[ai][bj][m][1] * rs); }
            return;
        }
        LAS float* P = (LAS float*)(lds + XSCR_OFF);
#pragma unroll
        for (int ai = 0; ai < 2; ++ai)
#pragma unroll
            for (int m = 0; m < 4; ++m) { const int rl = ai * HALF + wr * 64 + m * 16 + fr; const float rs = rs_of(ss, u.pm * BM + rl);
#pragma unroll
                for (int bj = 0; bj < 2; ++bj) { const f32x4 a = acc[ai][bj][m][0] * rs, b = acc[ai][bj][m][1] * rs; float s = 0.f;
#pragma unroll
                    for (int e = 0; e < 4; ++e) s += a[e] * a[e] + b[e] * b[e];
                    s += __shfl_xor(s, 16); s += __shfl_xor(s, 32);
                    if (fq == 0) P[(rl * 2 + bj) * 4 + wc] = s; } }
        asm volatile("s_waitcnt lgkmcnt(0)" ::: "memory"); __builtin_amdgcn_s_barrier(); asm volatile("" ::: "memory");
        const bool isk = pn < 3; const int grp = isk ? 0 : (pn - 6) / 3, hp = isk ? pn : (pn - 6) % 3;
        const float* gn = isk ? knorm : qnorm + grp * 128; const float sc = isk ? 1.f : (0.08838834764831845f * LOG2E);
        bf16_t* dstb = KR + (size_t)(isk ? 0 : 2 + grp) * ((size_t)T * AW);
        const int d = 16 * wc + 4 * fq;
        const f32x4 g1 = *(const f32x4*)(gn + d), g2 = *(const f32x4*)(gn + 64 + d);
#pragma unroll
        for (int ai = 0; ai < 2; ++ai)
#pragma unroll
            for (int m = 0; m < 4; ++m) { const int rl = ai * HALF + wr * 64 + m * 16 + fr, row = u.pm * BM + rl, pos = row & (SEQ - 1); const float rs = rs_of(ss, row);
                const f32x4 co = *(const f32x4*)(cs + pos * 64 + d), si = *(const f32x4*)(sn + pos * 64 + d);
#pragma unroll
                for (int bj = 0; bj < 2; ++bj) { const f32x4 pp = *(const LAS f32x4*)(P + (rl * 2 + bj) * 4);
                    const float r2 = __builtin_amdgcn_rsqf(((pp[0] + pp[1]) + (pp[2] + pp[3])) * (1.f / 128.f) + EPS) * rs * sc;
                    const f32x4 y1 = acc[ai][bj][m][0] * g1 * r2, y2 = acc[ai][bj][m][1] * g2 * r2;
                    const f32x4 o1 = y1 * co - y2 * si, o2 = y2 * co + y1 * si;
                    bf16_t* dst = dstb + (size_t)row * AW + (2 * hp + bj) * 128 + d;
                    u32x2 w1, w2; w1.x = cvt_pk_bf16(o1[0], o1[1]); w1.y = cvt_pk_bf16(o1[2], o1[3]); w2.x = cvt_pk_bf16(o2[0], o2[1]); w2.y = cvt_pk_bf16(o2[2], o2[3]);
                    *(u32x2*)dst = w1; *(u32x2*)(dst + 64) = w2; }
                asm volatile("" ::: "memory"); }
    }
};
}


typedef short s16x4 __attribute__((ext_vector_type(4)));
__device__ __forceinline__ unsigned off_b(unsigned row, unsigned ch) { return 256u * row + 16u * (ch ^ (((row & 3) << 2) | ((row >> 2) & 3))); }
__device__ __forceinline__ unsigned rowrd16(unsigned lane, unsigned rb, unsigned s) { return off_b((lane & 15) + 16 * rb, 4 * s + (lane >> 4)); }
__device__ __forceinline__ unsigned trrd(unsigned lane, unsigned rowbase, unsigned c) { const unsigned q = (lane & 15) >> 2, p = lane & 3; return off_b(rowbase + q, 2 * c + (p >> 1)) + 8 * (p & 1); }
__device__ __forceinline__ unsigned off_h(unsigned row, unsigned ch) { return 128u * row + 16u * (ch ^ ((row >> 1) & 7)); }
__device__ __forceinline__ s16x4 tr_read(LAS unsigned char* p) { return __builtin_bit_cast(s16x4, __builtin_amdgcn_ds_read_tr16_b64_v4i16((LAS s16x4*)p)); }
__device__ __forceinline__ bf16x8 cat8(s16x4 lo, s16x4 hi) { return (bf16x8){lo[0], lo[1], lo[2], lo[3], hi[0], hi[1], hi[2], hi[3]}; }
#define MFMA16(a, b, c) __builtin_amdgcn_mfma_f32_16x16x32_bf16(a, b, c, 0, 0, 0)
#define LDS_BARRIER() do { asm volatile("s_waitcnt vmcnt(0) lgkmcnt(0)" ::: "memory"); __builtin_amdgcn_s_barrier(); asm volatile("" ::: "memory"); } while (0)

template <int NT, int NDT>
__device__ __forceinline__ float attn_softmax_pv(LAS unsigned char* Vimg, f32x4 (&st)[NT], int t0, int lane, f32x4 (&o)[NDT], float& mx_out) {
    const int g = lane >> 4;
    float mx = -1e30f;
#pragma unroll
    for (int i = 0; i < NT; ++i)
#pragma unroll
        for (int e = 0; e < 4; ++e) mx = fmaxf(mx, st[i][e]);
    mx = fmaxf(mx, __shfl_xor(mx, 16)); mx = fmaxf(mx, __shfl_xor(mx, 32));
    float l = 0.f;
#pragma unroll
    for (int i = 0; i < NT; ++i)
#pragma unroll
        for (int e = 0; e < 4; ++e) { const float p = __builtin_amdgcn_exp2f(st[i][e] - mx); st[i][e] = p; l += p; }
    l += __shfl_xor(l, 16); l += __shfl_xor(l, 32);
#pragma unroll
    for (int dt = 0; dt < NDT; ++dt) o[dt] = (f32x4){0.f, 0.f, 0.f, 0.f};
#pragma unroll
    for (int pr = 0; pr < (NT + 1) / 2; ++pr) {
        const bool has1 = (2 * pr + 1 < NT);
        const int T0 = t0 + 2 * pr; int T1 = T0 + 1; if (T1 > 15) T1 = 15;
        u32x4 pw; pw.x = cvt_pk_bf16(st[2 * pr][0], st[2 * pr][1]); pw.y = cvt_pk_bf16(st[2 * pr][2], st[2 * pr][3]);
        if (has1) { pw.z = cvt_pk_bf16(st[has1 ? 2 * pr + 1 : 0][0], st[has1 ? 2 * pr + 1 : 0][1]); pw.w = cvt_pk_bf16(st[has1 ? 2 * pr + 1 : 0][2], st[has1 ? 2 * pr + 1 : 0][3]); } else { pw.z = 0u; pw.w = 0u; }
        const bf16x8 pb = __builtin_bit_cast(bf16x8, pw);
#pragma unroll
        for (int dt = 0; dt < NDT; ++dt) {
            const s16x4 lo = tr_read(Vimg + trrd(lane, 16 * T0 + 4 * g, dt)), hi = tr_read(Vimg + trrd(lane, 16 * T1 + 4 * g, dt));
            o[dt] = MFMA16(cat8(lo, hi), pb, o[dt]);
        }
    }
    mx_out = mx;
    return l;
}

__device__ __forceinline__ void dil_unit(LAS unsigned char* lds, int u, const bf16_t* KR, const bf16_t* VS, bf16_t* QG, float* LSE, int tid) {
    LAS unsigned char* Kimg = lds; LAS unsigned char* Vimg = lds + 65536;
    const int lane = tid & 63, w = __builtin_amdgcn_readfirstlane(tid >> 6), g = lane >> 4, lq = lane & 15;
    const int bh = u / 96, b = bh / NH, h = bh % NH, v = u % 96, grp = v >> 5, vv = v & 31;
    const int dil = grp == 0 ? 1 : (grp == 1 ? 4 : 16), nbk = 32 >> (2 * grp), r = vv / nbk, qb = vv % nbk, m0 = 128 * qb;
#pragma unroll
    for (int i = 0; i < 8; ++i) { const int idx = i * 512 + tid, row = idx >> 4, ch = idx & 15; int m = m0 - 128 + row; if (m < 0) m = 0;
        const size_t go = ((size_t)(b * SEQ + m * dil + r)) * AW + h * 128 + ch * 8;
        const u32x4 kv = *(const u32x4*)(KR + go), vx = *(const u32x4*)(VS + go);
        *(LAS u32x4*)(Kimg + off_b(row, ch)) = kv; *(LAS u32x4*)(Vimg + off_b(row, ch)) = vx; }
    const size_t qrow = (size_t)(b * SEQ + (m0 + 16 * w + lq) * dil + r);
    bf16_t* qp = QG + ((size_t)grp * T + qrow) * AW + h * 128;
    bf16x8 qf[4];
#pragma unroll
    for (int s = 0; s < 4; ++s) qf[s] = *(const bf16x8*)(qp + 32 * s + 8 * g);
    LDS_BARRIER();
    f32x4 st[9];
#pragma unroll
    for (int i = 0; i < 9; ++i) { const int tile = w + i; f32x4 acc = (f32x4){0.f, 0.f, 0.f, 0.f};
#pragma unroll
        for (int s = 0; s < 4; ++s) acc = MFMA16(*(const LAS bf16x8*)(Kimg + rowrd16(lane, tile, s)), qf[s], acc);
#pragma unroll
        for (int e = 0; e < 4; ++e) { const int kk = 16 * tile + 4 * g + e, dist = 128 + 16 * w + lq - kk; const bool ok = dist >= 0 && dist <= 128 && (m0 - 128 + kk) >= 0; st[i][e] = ok ? acc[e] : -1e30f; } }
    f32x4 o[8]; float mx;
    const float l = attn_softmax_pv<9, 8>(Vimg, st, w, lane, o, mx);
    const float inv = __builtin_amdgcn_rcpf(l);
#pragma unroll
    for (int dt = 0; dt < 8; ++dt) { u32x2 ow; ow.x = cvt_pk_bf16(o[dt][0] * inv, o[dt][1] * inv); ow.y = cvt_pk_bf16(o[dt][2] * inv, o[dt][3] * inv); *(u32x2*)(qp + 16 * dt + 4 * g) = ow; }
    if (g == 0) LSE[((size_t)grp * T + qrow) * NH + h] = mx + __builtin_amdgcn_logf(l);
    LDS_BARRIER();
}
__device__ __forceinline__ void mem_unit(LAS unsigned char* lds, int u, const bf16_t* MQ, const bf16_t* MKl, const bf16_t* MVl, bf16_t* MIX, int tid) {
    LAS unsigned char* Kimg = lds; LAS unsigned char* Vimg = lds + 65536;
    const int lane = tid & 63, w = __builtin_amdgcn_readfirstlane(tid >> 6), g = lane >> 4, lq = lane & 15;
    const int b = u >> 7, hd = (u >> 5) & 3, qblk = u & 31;
#pragma unroll
    for (int i = 0; i < 4; ++i) { const int idx = i * 512 + tid, row = idx >> 3, ch = idx & 7;
        const size_t go = ((size_t)(b * MEMT + row)) * MW + hd * 64 + ch * 8;
        const u32x4 kv = *(const u32x4*)(MKl + go), vx = *(const u32x4*)(MVl + go);
        *(LAS u32x4*)(Kimg + off_b(row, ch)) = kv; *(LAS u32x4*)(Vimg + off_b(row, ch)) = vx; }
    const size_t qrow = (size_t)(b * SEQ + 128 * qblk + 16 * w + lq);
    const bf16_t* qp = MQ + qrow * MW + hd * 64;
    bf16x8 qf[2];
#pragma unroll
    for (int s = 0; s < 2; ++s) qf[s] = *(const bf16x8*)(qp + 32 * s + 8 * g);
    LDS_BARRIER();
    f32x4 st[16];
#pragma unroll
    for (int i = 0; i < 16; ++i) { f32x4 acc = (f32x4){0.f, 0.f, 0.f, 0.f};
#pragma unroll
        for (int s = 0; s < 2; ++s) acc = MFMA16(*(const LAS bf16x8*)(Kimg + rowrd16(lane, i, s)), qf[s], acc);
        st[i] = acc; }
    f32x4 o[4]; float mx;
    const float l = attn_softmax_pv<16, 4>(Vimg, st, 0, lane, o, mx);
    const float inv = __builtin_amdgcn_rcpf(l);
#pragma unroll
    for (int dt = 0; dt < 4; ++dt) { u32x2 ow; ow.x = cvt_pk_bf16(o[dt][0] * inv, o[dt][1] * inv); ow.y = cvt_pk_bf16(o[dt][2] * inv, o[dt][3] * inv); *(u32x2*)(MIX + qrow * DM + AW + hd * 64 + 16 * dt + 4 * g) = ow; }
    LDS_BARRIER();
}

constexpr int HG_UNITS = BATCH * NH * (SEQ / 64);
__device__ __forceinline__ void hg_cumsum(LAS float* tot, const float* LF, size_t rowbase, int h, int tid, float (&lf)[16], float (&bc)[16], float& bend) {
    const int d = tid & 127, rg = tid >> 7;
    float c = 0.f;
#pragma unroll
    for (int i = 0; i < 16; ++i) { lf[i] = LF[(rowbase + 16 * rg + i) * AW + h * 128 + d]; }
#pragma unroll
    for (int i = 0; i < 16; ++i) { c += lf[i]; bc[i] = c; }
    tot[rg * 128 + d] = c;
    LDS_BARRIER();
    const float t0 = tot[d], t1 = tot[128 + d], t2 = tot[256 + d], t3 = tot[384 + d];
    const float pre = rg == 0 ? 0.f : (rg == 1 ? t0 : (rg == 2 ? t0 + t1 : t0 + t1 + t2));
    bend = (t0 + t1) + (t2 + t3);
#pragma unroll
    for (int i = 0; i < 16; ++i) bc[i] += pre;
}
__device__ __forceinline__ float ex(float v) { return __builtin_amdgcn_exp2f(v * LOG2E); }
__device__ __forceinline__ void hgA_unit(LAS unsigned char* lds, int u, const float* LF, const bf16_t* VV, bf16_t* DS, float* DEC, int tid) {
    LAS unsigned char* KT = lds;
    LAS unsigned char* Vimg = lds + 16384;
    LAS float* tot = (LAS float*)(lds + 32768);
    const int lane = tid & 63, w = __builtin_amdgcn_readfirstlane(tid >> 6), g = lane >> 4;
    const int bh = u >> 6, c = u & 63, b = bh / NH, h = bh % NH; const size_t rowbase = (size_t)b * SEQ + 64 * c;
    float lf[16], bc[16], bend;
    hg_cumsum(tot, LF, rowbase, h, tid, lf, bc, bend);
    const int d = tid & 127, rg = tid >> 7;
    { u32x4 w0, w1; float ko[16];
#pragma unroll
      for (int i = 0; i < 16; ++i) ko[i] = (1.f - ex(lf[i])) * ex(bend - bc[i]);
      w0.x = cvt_pk_bf16(ko[0], ko[1]); w0.y = cvt_pk_bf16(ko[2], ko[3]); w0.z = cvt_pk_bf16(ko[4], ko[5]); w0.w = cvt_pk_bf16(ko[6], ko[7]);
      w1.x = cvt_pk_bf16(ko[8], ko[9]); w1.y = cvt_pk_bf16(ko[10], ko[11]); w1.z = cvt_pk_bf16(ko[12], ko[13]); w1.w = cvt_pk_bf16(ko[14], ko[15]);
      *(LAS u32x4*)(KT + off_h(d, 2 * rg)) = w0; *(LAS u32x4*)(KT + off_h(d, 2 * rg + 1)) = w1;
      if (rg == 0) DEC[(size_t)u * 128 + d] = ex(bend); }
#pragma unroll
    for (int i = 0; i < 2; ++i) { const int idx = i * 512 + tid, row = idx >> 4, ch = idx & 15;
        *(LAS u32x4*)(Vimg + off_b(row, ch)) = *(const u32x4*)(VV + (rowbase + row) * AW + h * 128 + ch * 8); }
    LDS_BARRIER();
    bf16x8 af[2];
#pragma unroll
    for (int ks = 0; ks < 2; ++ks) af[ks] = *(const LAS bf16x8*)(KT + off_h(16 * w + (lane & 15), 4 * ks + g));
    bf16_t* dsu = DS + (size_t)u * 16384;
#pragma unroll
    for (int j = 0; j < 8; ++j) { f32x4 acc = (f32x4){0.f, 0.f, 0.f, 0.f};
#pragma unroll
        for (int ks = 0; ks < 2; ++ks) { const s16x4 lo = tr_read(Vimg + trrd(lane, 32 * ks + 8 * g, j)), hi = tr_read(Vimg + trrd(lane, 32 * ks + 8 * g + 4, j));
            acc = MFMA16(af[ks], cat8(lo, hi), acc); }
        u32x2 ow; ow.x = cvt_pk_bf16(acc[0], acc[1]); ow.y = cvt_pk_bf16(acc[2], acc[3]);
        *(u32x2*)(dsu + (size_t)(16 * j + (lane & 15)) * 128 + 16 * w + 4 * g) = ow; }
    LDS_BARRIER();
}
__device__ __forceinline__ void hgB_item(int it, bf16_t* DS, const float* DEC) {
    const int bh = it >> 11, e8 = it & 2047;
    const int dk0 = 8 * (e8 & 15);
    float S[8];
#pragma unroll
    for (int i = 0; i < 8; ++i) S[i] = 0.f;
#pragma unroll 4
    for (int c = 0; c < 64; ++c) { const size_t un = (size_t)(bh * 64 + c);
        u32x4* p = (u32x4*)(DS + un * 16384 + (size_t)e8 * 8);
        const u32x4 dsv = *p; const f32x4 d0 = *(const f32x4*)(DEC + un * 128 + dk0), d1 = *(const f32x4*)(DEC + un * 128 + dk0 + 4);
        u32x4 o; o.x = cvt_pk_bf16(S[0], S[1]); o.y = cvt_pk_bf16(S[2], S[3]); o.z = cvt_pk_bf16(S[4], S[5]); o.w = cvt_pk_bf16(S[6], S[7]);
        *p = o;
        const unsigned wv[4] = {dsv.x, dsv.y, dsv.z, dsv.w};
#pragma unroll
        for (int i = 0; i < 4; ++i) { const float dl = (i < 2 ? d0 : d1)[(2 * i) & 3], dh = (i < 2 ? d0 : d1)[(2 * i + 1) & 3];
            S[2 * i] = dl * S[2 * i] + __uint_as_float(wv[i] << 16); S[2 * i + 1] = dh * S[2 * i + 1] + __uint_as_float(wv[i] & 0xffff0000u); } }
}
__device__ __forceinline__ void hgC_unit(LAS unsigned char* lds, int u, const float* LF, const bf16_t* QS, const bf16_t* VV, const bf16_t* SG, const bf16_t* SP, const float* onorm, bf16_t* MIX, int tid) {
    LAS unsigned char* QI = lds;
    LAS unsigned char* KI = lds + 16384;
    LAS unsigned char* Vimg = lds + 32768;
    LAS unsigned char* STi = lds + 49152;
    LAS unsigned char* AT = lds + 81920;
    LAS float* tot = (LAS float*)(lds + 90112);
    LAS float* red = (LAS float*)(lds + 92160);
    const int lane = tid & 63, w = __builtin_amdgcn_readfirstlane(tid >> 6), g = lane >> 4, lq = lane & 15;
    const int bh = u >> 6, c = u & 63, b = bh / NH, h = bh % NH; const size_t rowbase = (size_t)b * SEQ + 64 * c;
    float lf[16], bc[16], bend;
    hg_cumsum(tot, LF, rowbase, h, tid, lf, bc, bend);
    const int d = tid & 127, rg = tid >> 7;
#pragma unroll
    for (int i = 0; i < 16; ++i) { const int t = 16 * rg + i; const float q = bf2f(QS[(rowbase + t) * AW + h * 128 + d]);
        const float eb = ex(bc[i]);
        const unsigned a = off_b(t, d >> 3) + (d & 7) * 2;
        *(LAS bf16_t*)(QI + a) = (bf16_t)(cvt_pk_bf16(q * eb, 0.f) & 0xffffu);
        *(LAS bf16_t*)(KI + a) = (bf16_t)(cvt_pk_bf16((1.f - ex(lf[i])) * __builtin_amdgcn_rcpf(eb), 0.f) & 0xffffu); }
#pragma unroll
    for (int i = 0; i < 2; ++i) { const int idx = i * 512 + tid, row = idx >> 4, ch = idx & 15;
        *(LAS u32x4*)(Vimg + off_b(row, ch)) = *(const u32x4*)(VV + (rowbase + row) * AW + h * 128 + ch * 8); }
#pragma unroll
    for (int i = 0; i < 4; ++i) { const int idx = i * 512 + tid, row = idx >> 4, ch = idx & 15;
        *(LAS u32x4*)(STi + off_b(row, ch)) = *(const u32x4*)(SP + (size_t)u * 16384 + row * 128 + ch * 8); }
    LDS_BARRIER();
    { const int ti = w & 3;
#pragma unroll
      for (int k2 = 0; k2 < 2; ++k2) { const int si = 2 * (w >> 2) + k2; f32x4 acc = (f32x4){0.f, 0.f, 0.f, 0.f};
        if (si <= ti) {
#pragma unroll
            for (int s = 0; s < 4; ++s) acc = MFMA16(*(const LAS bf16x8*)(KI + rowrd16(lane, si, s)), *(const LAS bf16x8*)(QI + rowrd16(lane, ti, s)), acc);
        }
        const int t = 16 * ti + lq, s0 = 16 * si + 4 * g;
        u32x2 ow; ow.x = cvt_pk_bf16(s0 <= t ? acc[0] : 0.f, s0 + 1 <= t ? acc[1] : 0.f); ow.y = cvt_pk_bf16(s0 + 2 <= t ? acc[2] : 0.f, s0 + 3 <= t ? acc[3] : 0.f);
        *(LAS u32x2*)(AT + off_h(t, s0 >> 3) + (s0 & 7) * 2) = ow; } }
    LDS_BARRIER();
    const int ti = w & 3, jh = w >> 2;
    bf16x8 aq[4], aa[2];
#pragma unroll
    for (int s = 0; s < 4; ++s) aq[s] = *(const LAS bf16x8*)(QI + rowrd16(lane, ti, s));
#pragma unroll
    for (int s = 0; s < 2; ++s) aa[s] = *(const LAS bf16x8*)(AT + off_h(16 * ti + lq, 4 * s + g));
    f32x4 o[4]; float ssq[4] = {0.f, 0.f, 0.f, 0.f};
#pragma unroll
    for (int jj = 0; jj < 4; ++jj) { const int j = 4 * jh + jj; f32x4 acc = (f32x4){0.f, 0.f, 0.f, 0.f};
#pragma unroll
        for (int s = 0; s < 4; ++s) acc = MFMA16(aq[s], *(const LAS bf16x8*)(STi + rowrd16(lane, j, s)), acc);
#pragma unroll
        for (int ks = 0; ks < 2; ++ks) { const s16x4 lo = tr_read(Vimg + trrd(lane, 32 * ks + 8 * g, j)), hi = tr_read(Vimg + trrd(lane, 32 * ks + 8 * g + 4, j));
            acc = MFMA16(aa[ks], cat8(lo, hi), acc); }
        o[jj] = acc;
#pragma unroll
        for (int e = 0; e < 4; ++e) ssq[e] += acc[e] * acc[e]; }
#pragma unroll
    for (int e = 0; e < 4; ++e) { float s = ssq[e]; s += __shfl_xor(s, 1); s += __shfl_xor(s, 2); s += __shfl_xor(s, 4); s += __shfl_xor(s, 8); ssq[e] = s; }
    if (lq == 0) {
#pragma unroll
        for (int e = 0; e < 4; ++e) red[(16 * ti + 4 * g + e) * 2 + jh] = ssq[e]; }
    LDS_BARRIER();
#pragma unroll
    for (int e = 0; e < 4; ++e) { const int t = 16 * ti + 4 * g + e; const float r2 = __builtin_amdgcn_rsqf((red[t * 2] + red[t * 2 + 1]) * (1.f / 128.f) + EPS);
#pragma unroll
        for (int jj = 0; jj < 4; ++jj) { const int dv = 16 * (4 * jh + jj) + lq; const size_t ro = rowbase + t;
            const float gt = bf2f(SG[ro * AW + h * 128 + dv]);
            MIX[ro * DM + h * 128 + dv] = (bf16_t)(cvt_pk_bf16(o[jj][e] * r2 * onorm[h * 128 + dv] * gt, 0.f) & 0xffffu); } }
    LDS_BARRIER();
}


#define XB_TMO      128
#define XB_XCNT(j)  (256  + 64 * (j))
#define XB_XSUB(j)  (1280 + 64 * (j))
#define XB_XGEN(j)  (2304 + 64 * (j))
#define XB_TOP      3328
#define XB_TOPGEN   3392
#define XCD_BAR_WORDS 3456
#define XB_SPIN_CAP (1u << 18)
__device__ __forceinline__ unsigned xb_ld(unsigned* p)              { return __hip_atomic_load(p, __ATOMIC_RELAXED, __HIP_MEMORY_SCOPE_AGENT); }
__device__ __forceinline__ unsigned xb_add(unsigned* p, unsigned v) { return __hip_atomic_fetch_add(p, v, __ATOMIC_RELAXED, __HIP_MEMORY_SCOPE_AGENT); }
__device__ __forceinline__ unsigned xb_xcc_id() { return (unsigned)__builtin_amdgcn_s_getreg((3 << 11) | 20) & 0xFu; }
#define XB_SPIN(cond, bar) do { unsigned _sp = 0; while (cond) { __builtin_amdgcn_s_sleep(1); \
    if ((++_sp & 255u) == 0u) { if (xb_ld(&(bar)[XB_TMO])) break; if (_sp > XB_SPIN_CAP) { atomicAdd(&(bar)[XB_TMO], 1u); break; } } } } while (0)
struct XcdBarrier { unsigned* bar; unsigned x; volatile LAS unsigned* st; };
__device__ __forceinline__ XcdBarrier xcd_barrier_post(unsigned* bar, volatile LAS unsigned* st) {
    XcdBarrier b; b.bar = bar; b.x = xb_xcc_id(); b.st = st;
    if (threadIdx.x == 0) (void)xb_add(&bar[XB_XCNT(b.x)], 1u);
    return b;
}
__device__ __forceinline__ void xcd_barrier_complete(unsigned* bar, unsigned x, unsigned& nloc, unsigned& nx) {
    const unsigned G = gridDim.x * gridDim.y * gridDim.z;
    unsigned sum, cnt, mine, sp = 0u;
    for (;;) {
        sum = 0u; cnt = 0u; mine = 0u;
#pragma unroll
        for (unsigned j = 0; j < 16; ++j) { const unsigned c = xb_ld(&bar[XB_XCNT(j)]); sum += c; cnt += (c > 0u) ? 1u : 0u; mine = (j == x) ? c : mine; }
        if (sum == G) break;
        __builtin_amdgcn_s_sleep(1);
        if ((++sp & 255u) == 0u) { if (xb_ld(&bar[XB_TMO])) break; if (sp > XB_SPIN_CAP) { atomicAdd(&bar[XB_TMO], 1u); break; } }
    }
    nloc = mine > 0u ? mine : 1u; nx = cnt > 0u ? cnt : 1u;
}
__device__ __forceinline__ void xcd_barrier(const XcdBarrier& b) {
    asm volatile("s_waitcnt vmcnt(0)" ::: "memory");
    __syncthreads();
    if (threadIdx.x == 0) {
        unsigned* bar = b.bar;
        __builtin_amdgcn_s_waitcnt(0);
        unsigned nloc = b.st[0], nx = b.st[1];
        if (nloc == 0u) { xcd_barrier_complete(bar, b.x, nloc, nx); b.st[0] = nloc; b.st[1] = nx; }
        const unsigned old = xb_add(&bar[XB_XSUB(b.x)], 1u);
        const unsigned gen = old / nloc;
        if (old + 1u == (gen + 1u) * nloc) {
            __builtin_amdgcn_fence(__ATOMIC_RELEASE, "agent");
            asm volatile("s_waitcnt vmcnt(0)" ::: "memory");
            const unsigned og = xb_add(&bar[XB_TOP], 1u);
            const unsigned tg = og / nx;
            if (og + 1u == (tg + 1u) * nx) xb_add(&bar[XB_TOPGEN], 1u);
            else XB_SPIN(xb_ld(&bar[XB_TOPGEN]) == tg, bar);
            __builtin_amdgcn_fence(__ATOMIC_ACQUIRE, "agent");
            xb_add(&bar[XB_XGEN(b.x)], 1u);
            asm volatile("s_waitcnt vmcnt(0)" ::: "memory");
        } else {
            XB_SPIN(xb_ld(&bar[XB_XGEN(b.x)]) == gen, bar);
            __builtin_amdgcn_fence(__ATOMIC_ACQUIRE, "agent");
            asm volatile("s_waitcnt vmcnt(0)" ::: "memory");
        }
    }
    __syncthreads();
}

struct Args {
    const float* in[19]; float* out; unsigned char* ws; int ph_lo, ph_hi;
};
enum { PH_PRO = 0, PH_GEMM1 = 1, PH_WO0 = 5, PH_GU0 = 6, PH_DN0 = 7, PH_KVB = 8, PH_WO1 = 11, PH_GU1 = 12, PH_DN1 = 13, PH_END = 14 };

__device__ __forceinline__ void p0_transpose_item(const float* W, const float* gain, int K, int N, bf16_t* WT, int map, LAS float* scr, int item, int lane) {
    const int nblk = N / 32, kb = item / nblk, nb = item % nblk, k0 = 64 * kb, n0 = 32 * nb;
#pragma unroll 8
    for (int i = 0; i < 32; ++i) { const int kk = 2 * i + (lane >> 5); scr[kk * 33 + (lane & 31)] = W[(size_t)(k0 + kk) * N + n0 + (lane & 31)] * (gain ? gain[k0 + kk] : 1.f); }
    asm volatile("s_waitcnt lgkmcnt(0)" ::: "memory");
    const int c = lane & 7;
#pragma unroll
    for (int j = 0; j < 4; ++j) { const int n = (lane >> 3) + 8 * j; const LAS float* s = scr + (8 * c) * 33 + n;
        u32x4 o; o.x = cvt_pk_bf16(s[0 * 33], s[1 * 33]); o.y = cvt_pk_bf16(s[2 * 33], s[3 * 33]); o.z = cvt_pk_bf16(s[4 * 33], s[5 * 33]); o.w = cvt_pk_bf16(s[6 * 33], s[7 * 33]);
        *(u32x4*)(WT + (size_t)dst_row(map, n0 + n) * K + k0 + 8 * c) = o; }
    asm volatile("s_waitcnt lgkmcnt(0)" ::: "memory");
}
__device__ __forceinline__ void p0_row(const float* xrow, bf16_t* orow, float* ss, int lane) {
    const f32x4* xr = (const f32x4*)xrow + lane; f32x4 v[4]; float s = 0.f;
#pragma unroll
    for (int j = 0; j < 4; ++j) { v[j] = xr[64 * j]; s += (v[j].x * v[j].x + v[j].y * v[j].y) + (v[j].z * v[j].z + v[j].w * v[j].w); }
    s = wave_sum(s);
#pragma unroll
    for (int j = 0; j < 4; ++j) { u32x2 o; o.x = cvt_pk_bf16(v[j].x, v[j].y); o.y = cvt_pk_bf16(v[j].z, v[j].w); *((u32x2*)orow + lane + 64 * j) = o; }
    if (lane == 0) *ss = s;
}

__global__ void __launch_bounds__(NTHREADS, 2) mk_fwd(Args args) {
    extern __shared__ __attribute__((aligned(16))) unsigned char lds_raw[];
    LAS unsigned char* lds = (LAS unsigned char*)lds_raw;
    const int G = gridDim.x, bx = blockIdx.x;
    const int vcu = (G % 8 == 0) ? (bx % 8) * (G / 8) + bx / 8 : bx;
    const float* x = (const float*)(const GAS float*)args.in[0]; const float* mem = (const float*)(const GAS float*)args.in[1]; const float* norm_mix = (const float*)(const GAS float*)args.in[2]; const float* norm_ffn = (const float*)(const GAS float*)args.in[3];
    const float* a_w_in = (const float*)(const GAS float*)args.in[4]; const float* a_lb = (const float*)(const GAS float*)args.in[5]; const float* a_onorm = (const float*)(const GAS float*)args.in[6]; const float* b_w_in = (const float*)(const GAS float*)args.in[7]; const float* b_qnorm = (const float*)(const GAS float*)args.in[8];
    const float* kv_norm = (const float*)(const GAS float*)args.in[9]; const float* w_kv = (const float*)(const GAS float*)args.in[10]; const float* b_knorm = (const float*)(const GAS float*)args.in[11]; const float* mem_norm = (const float*)(const GAS float*)args.in[12]; const float* w_mem_kv = (const float*)(const GAS float*)args.in[13];
    const float* mem_qnorm = (const float*)(const GAS float*)args.in[14]; const float* mem_knorm = (const float*)(const GAS float*)args.in[15]; const float* w_out = (const float*)(const GAS float*)args.in[16]; const float* w_gate_up = (const float*)(const GAS float*)args.in[17]; const float* w_down = (const float*)(const GAS float*)args.in[18];
#define WSP(type, name, off) type* name = (type*)(GAS type*)(wsp + (off))
#define PHASE_PTRS GAS unsigned char* wsp = (GAS unsigned char*)args.ws; asm volatile("" : "+s"(wsp)); float* sm = (float*)(GAS float*)(wsp + WS_SMALL); (void)sm
    float* H = (float*)(GAS float*)args.out;
    const int lo = args.ph_lo, hi = args.ph_hi;
    volatile LAS unsigned* MISC = (volatile LAS unsigned*)(lds + MISC_OFF);
    if (threadIdx.x < 16) MISC[threadIdx.x] = 0u;
    __syncthreads();
    const XcdBarrier gbar = xcd_barrier_post((unsigned*)((GAS unsigned char*)args.ws + WS_CTL), MISC);
#define IN(k) (lo <= (k) && (k) < hi)
#define SEAM(k) do { if (IN(k) && IN((k) + 1)) xcd_barrier(gbar); } while (0)

    if (IN(PH_PRO)) {
        PHASE_PTRS;
        WSP(bf16_t, WA, WS_WA); WSP(bf16_t, WKVB, WS_WKVB); WSP(bf16_t, WO, WS_WO); WSP(bf16_t, WGU, WS_WGU); WSP(bf16_t, WD, WS_WD); WSP(bf16_t, WMKV, WS_WMKV);
        WSP(bf16_t, XB, WS_XB); WSP(bf16_t, MEMB, WS_MEMB);
        float* LB = sm + SM_LB / 4; float* COS = sm + SM_COS / 4; float* SIN = sm + SM_SIN / 4; float* SS0 = sm + SM_SS0 / 4; float* SS1 = sm + SM_SS1 / 4; float* SS2 = sm + SM_SS2 / 4; float* SS3 = sm + SM_SS3 / 4; float* SSM = sm + SM_SSM / 4;
        int tid = threadIdx.x; asm volatile("" : "+v"(tid)); const int lane = tid & 63, wave = __builtin_amdgcn_readfirstlane(tid >> 6);
        LAS float* scr = (LAS float*)(lds + wave * 16384);
        const int gw = vcu * NWAVES + wave, NGW = G * NWAVES;
        int base = 0;
#define WJOB(W_, g_, K_, N_, o_, map_) do { const int ni_ = ((K_) / 64) * ((N_) / 32); int first_ = gw - (base % NGW); if (first_ < 0) first_ += NGW; \
            for (int it = first_; it < ni_; it += NGW) p0_transpose_item(W_, g_, K_, N_, o_, map_, scr, it, lane); base += ni_; } while (0)
        WJOB(a_w_in, norm_mix, DM, A_COLS, WA, MAP_WA);
        WJOB(w_kv, kv_norm, DM, 2 * AW, WKVB, MAP_KV);
        WJOB(b_w_in, norm_mix + DM, DM, B_COLS, WKVB, MAP_BIN);
        WJOB(w_out, (const float*)nullptr, DM, DM, WO, MAP_STD);
        WJOB(w_out + (size_t)DM * DM, (const float*)nullptr, DM, DM, WO + (size_t)DM * DM, MAP_STD);
        WJOB(w_gate_up, norm_ffn, DM, 2 * FFN, WGU, MAP_GU);
        WJOB(w_gate_up + (size_t)DM * 2 * FFN, norm_ffn + DM, DM, 2 * FFN, WGU + (size_t)2 * FFN * DM, MAP_GU);
        WJOB(w_down, (const float*)nullptr, FFN, DM, WD, MAP_STD);
        WJOB(w_down + (size_t)FFN * DM, (const float*)nullptr, FFN, DM, WD + (size_t)DM * FFN, MAP_STD);
        WJOB(w_mem_kv, mem_norm, DM, 512, WMKV, MAP_MKV0);
        WJOB(w_mem_kv + (size_t)DM * 512, mem_norm + DM, DM, 512, WMKV, MAP_MKV1);
#undef WJOB
        for (int m = gw; m < T; m += NGW) p0_row(x + (size_t)m * DM, XB + (size_t)m * DM, SS0 + m, lane);
        for (int m = gw; m < MROWS; m += NGW) p0_row(mem + (size_t)m * DM, MEMB + (size_t)m * DM, SSM + m, lane);
        const int gt = vcu * NTHREADS + tid, NGT = G * NTHREADS;
        for (int i = gt; i < 4096 * 64; i += NGT) { const int pos = i >> 6, fi = i & 63; const float inv = powf(10000.f, -(float)fi / 64.f); const float ang = (float)pos * inv;
            COS[i] = cosf(ang); SIN[i] = sinf(ang); }
        for (int i = gt; i < T; i += NGT) { SS1[i] = 0.f; SS2[i] = 0.f; SS3[i] = 0.f; }
        for (int i = gt; i < AW; i += NGT) { const float a0 = a_lb[i], a1 = a_lb[AW + i]; const float mx = fmaxf(a0, a1); const float e0 = expf(a0 - mx), e1 = expf(a1 - mx); LB[i] = e0 / (e0 + e1); }
        asm volatile("s_waitcnt vmcnt(0) lgkmcnt(0)" ::: "memory"); __syncthreads();
    }
    SEAM(PH_PRO);
    if (IN(PH_GEMM1)) {
        PHASE_PTRS;
        WSP(bf16_t, WA, WS_WA); WSP(bf16_t, WMKV, WS_WMKV); WSP(bf16_t, XB, WS_XB); WSP(bf16_t, MEMB, WS_MEMB); WSP(bf16_t, MK, WS_MK); WSP(bf16_t, MV, WS_MV);
        WSP(bf16_t, QS, WS_QS); WSP(bf16_t, VV, WS_VV); WSP(bf16_t, SG, WS_SG); WSP(bf16_t, MQ0, WS_MQ0); WSP(float, LF, WS_LF);
        float* LB = sm + SM_LB / 4; float* SS0 = sm + SM_SS0 / 4; float* SSM = sm + SM_SSM / 4;
        { pg8::StaticOrder S; S.init(MROWS, 1024, G, (bx + G / 2) % G);
          pg8::EpiMemKV E{SSM, mem_knorm, MK, MV};
          pg8::gemm_phase(lds, MEMB, WMKV, MROWS, 1024, DM, S, E); }
        { pg8::StaticOrder S; S.init(T, A_COLS, G, bx);
          pg8::EpiInproj0 E{SS0, LB, mem_qnorm, QS, LF, VV, SG, MQ0};
          pg8::gemm_phase(lds, XB, WA, T, A_COLS, DM, S, E); }
    }
    SEAM(PH_GEMM1);
    if (IN(2)) { PHASE_PTRS; WSP(float, LF, WS_LF); WSP(bf16_t, VV, WS_VV); WSP(bf16_t, MQ0, WS_MQ0); WSP(bf16_t, MK, WS_MK); WSP(bf16_t, MV, WS_MV); WSP(bf16_t, MIX, WS_MIX);
        bf16_t* DS = (bf16_t*)H; float* DEC = H + (size_t)24 * 1024 * 1024;
        int tid = threadIdx.x; asm volatile("" : "+v"(tid));
#pragma unroll 1
        for (int i = 0; i < HG_UNITS / 256; ++i) { const int u = vcu * (HG_UNITS / 256) + i; if (G == 256) hgA_unit(lds, u, LF, VV, DS, DEC, tid); }
#pragma unroll 1
        for (int i = 0; i < 4; ++i) { const int u = vcu * 4 + i; if (G == 256) mem_unit(lds, u, MQ0, MK, MV, MIX, tid); }
    }
    SEAM(2);
    if (IN(3)) { bf16_t* DS = (bf16_t*)H; const float* DEC = H + (size_t)24 * 1024 * 1024;
        int tid = threadIdx.x; asm volatile("" : "+v"(tid));
#pragma unroll 1
        for (int it = bx * NTHREADS + tid; it < BATCH * NH * 2048; it += G * NTHREADS) hgB_item(it, DS, DEC);
    }
    SEAM(3);
    if (IN(4)) { PHASE_PTRS; WSP(float, LF, WS_LF); WSP(bf16_t, QS, WS_QS); WSP(bf16_t, VV, WS_VV); WSP(bf16_t, SG, WS_SG); WSP(bf16_t, MIX, WS_MIX);
        const bf16_t* SP = (const bf16_t*)H;
        int tid = threadIdx.x; asm volatile("" : "+v"(tid));
#pragma unroll 1
        for (int i = 0; i < HG_UNITS / 256; ++i) { const int u = vcu * (HG_UNITS / 256) + i; if (G == 256) hgC_unit(lds, u, LF, QS, VV, SG, SP, a_onorm, MIX, tid); }
    }
    SEAM(4);
#pragma unroll 1
    for (int l = 0; l < 2; ++l) {
        const int pb = l == 0 ? PH_WO0 : PH_WO1;
        if (IN(pb)) { PHASE_PTRS; WSP(bf16_t, WO, WS_WO); WSP(bf16_t, XB, WS_XB); WSP(bf16_t, MIX, WS_MIX); float* SS1 = sm + SM_SS1 / 4; float* SS3 = sm + SM_SS3 / 4;
            pg8::StaticOrder S; S.init(T, DM, G, bx);
            pg8::EpiResid E{l == 0 ? x : (const float*)H, H, XB, l == 0 ? SS1 : SS3};
            pg8::gemm_phase(lds, MIX, WO + (size_t)l * DM * DM, T, DM, DM, S, E); }
        SEAM(pb);
        if (IN(pb + 1)) { PHASE_PTRS; WSP(bf16_t, WGU, WS_WGU); WSP(bf16_t, XB, WS_XB); WSP(bf16_t, ACT, WS_ACT); float* SS1 = sm + SM_SS1 / 4; float* SS3 = sm + SM_SS3 / 4;
            pg8::StaticOrder S; S.init(T, 2 * FFN, G, bx);
            pg8::EpiGateUp E{l == 0 ? SS1 : SS3, ACT};
            pg8::gemm_phase(lds, XB, WGU + (size_t)l * 2 * FFN * DM, T, 2 * FFN, DM, S, E); }
        SEAM(pb + 1);
        if (IN(pb + 2)) { PHASE_PTRS; WSP(bf16_t, WD, WS_WD); WSP(bf16_t, XB, WS_XB); WSP(bf16_t, ACT, WS_ACT); float* SS2 = sm + SM_SS2 / 4;
            pg8::StaticOrder S; S.init(T, DM, G, bx);
            pg8::EpiResid E{(const float*)H, H, l == 0 ? XB : (bf16_t*)nullptr, SS2};
            pg8::gemm_phase(lds, ACT, WD + (size_t)l * DM * FFN, T, DM, FFN, S, E); }
        if (l == 0) {
            SEAM(PH_DN0);
            if (IN(PH_KVB)) { PHASE_PTRS; WSP(bf16_t, WKVB, WS_WKVB); WSP(bf16_t, XB, WS_XB); WSP(bf16_t, KR, WS_KR); WSP(bf16_t, VS, WS_VS); WSP(bf16_t, QG, WS_QG); WSP(bf16_t, MQ1, WS_MQ1);
                float* COS = sm + SM_COS / 4; float* SIN = sm + SM_SIN / 4; float* SS2 = sm + SM_SS2 / 4;
                pg8::StaticOrder S; S.init(T, KVB_COLS, G, bx);
                pg8::EpiKVB E{SS2, b_knorm, b_qnorm, mem_qnorm + 64, COS, SIN, KR, VS, QG, MQ1};
                pg8::gemm_phase(lds, XB, WKVB, T, KVB_COLS, DM, S, E); }
            SEAM(PH_KVB);
            if (IN(9)) { PHASE_PTRS; WSP(bf16_t, KR, WS_KR); WSP(bf16_t, VS, WS_VS); WSP(bf16_t, QG, WS_QG); WSP(bf16_t, MQ1, WS_MQ1); WSP(bf16_t, MK, WS_MK); WSP(bf16_t, MV, WS_MV); WSP(bf16_t, MIX, WS_MIX); WSP(float, LSE, WS_LSE);
                int tid = threadIdx.x; asm volatile("" : "+v"(tid));
#pragma unroll 1
                for (int i = 0; i < 18; ++i) { const int u = vcu * 18 + i; if (G == 256) dil_unit(lds, u, KR, VS, QG, LSE, tid); }
#pragma unroll 1
                for (int i = 0; i < 4; ++i) { const int u = vcu * 4 + i; if (G == 256) mem_unit(lds, u, MQ1, MK + (size_t)MROWS * MW, MV + (size_t)MROWS * MW, MIX, tid); }
            }
            SEAM(9);
            if (IN(10)) { PHASE_PTRS; WSP(bf16_t, QG, WS_QG); WSP(bf16_t, MIX, WS_MIX); WSP(float, LSE, WS_LSE);
                int tid = threadIdx.x; asm volatile("" : "+v"(tid));
#pragma unroll 1
                for (int it = bx * NTHREADS + tid; it < T * 96; it += G * NTHREADS) { const int row = it / 96, c8 = it % 96, h = c8 >> 4;
                    const float l0 = LSE[(size_t)row * NH + h], l1 = LSE[((size_t)T + row) * NH + h], l2 = LSE[((size_t)2 * T + row) * NH + h];
                    const float mm = fmaxf(l0, fmaxf(l1, l2)); float w0 = __builtin_amdgcn_exp2f(l0 - mm), w1 = __builtin_amdgcn_exp2f(l1 - mm), w2 = __builtin_amdgcn_exp2f(l2 - mm);
                    const float wi = __builtin_amdgcn_rcpf(w0 + w1 + w2); w0 *= wi; w1 *= wi; w2 *= wi;
                    const u32x4 a = *(const u32x4*)(QG + (size_t)row * AW + c8 * 8), bq = *(const u32x4*)(QG + ((size_t)T + row) * AW + c8 * 8), cq = *(const u32x4*)(QG + ((size_t)2 * T + row) * AW + c8 * 8);
                    const unsigned av[4] = {a.x, a.y, a.z, a.w}, bv[4] = {bq.x, bq.y, bq.z, bq.w}, cv[4] = {cq.x, cq.y, cq.z, cq.w}; unsigned ov[4];
#pragma unroll
                    for (int i = 0; i < 4; ++i) { const float lo = w0 * __uint_as_float(av[i] << 16) + w1 * __uint_as_float(bv[i] << 16) + w2 * __uint_as_float(cv[i] << 16);
                        const float hi = w0 * __uint_as_float(av[i] & 0xffff0000u) + w1 * __uint_as_float(bv[i] & 0xffff0000u) + w2 * __uint_as_float(cv[i] & 0xffff0000u); ov[i] = cvt_pk_bf16(lo, hi); }
                    *(u32x4*)(MIX + (size_t)row * DM + c8 * 8) = (u32x4){ov[0], ov[1], ov[2], ov[3]}; }
            }
            SEAM(10);
        }
    }
#undef IN
#undef SEAM
}

static int g_grid = 0;
static void launch_mk(Args& a, int lo, int hi, hipStream_t stream) {
    a.ph_lo = lo; a.ph_hi = hi;
    void* kargs[] = {&a};
    (void)kargs; hipLaunchKernelGGL(mk_fwd, dim3(g_grid), dim3(NTHREADS), LDS_BYTES, stream, a);
}
extern "C" void kernel_launch(void* const* d_in, const int* in_sizes, int n_in, void* d_out, int out_size, void* d_ws, size_t ws_size, hipStream_t stream) {
    if (ws_size < WS_END || n_in != 19 || out_size != T * DM) return;
    if (g_grid == 0) {
        int dev = 0, cus = 0, per_cu = 0;
        hipGetDevice(&dev); hipDeviceGetAttribute(&cus, hipDeviceAttributeMultiprocessorCount, dev);
        hipFuncSetAttribute((const void*)mk_fwd, hipFuncAttributeMaxDynamicSharedMemorySize, LDS_BYTES);
        hipOccupancyMaxActiveBlocksPerMultiprocessor(&per_cu, (const void*)mk_fwd, NTHREADS, LDS_BYTES);
        (void)hipGetLastError();
        g_grid = (per_cu >= 1) ? cus : -1;
    }
    if (g_grid < 0) return;
    const float* x = (const float*)d_in[0];
    const float* a_onorm = (const float*)d_in[6];
    char* ws = (char*)d_ws;
    float* sm = (float*)(ws + WS_SMALL);
    bf16_t* MK = (bf16_t*)(ws + WS_MK); bf16_t* MV = (bf16_t*)(ws + WS_MV);
    bf16_t* QS = (bf16_t*)(ws + WS_QS); bf16_t* VV = (bf16_t*)(ws + WS_VV); bf16_t* SG = (bf16_t*)(ws + WS_SG); bf16_t* MQ0 = (bf16_t*)(ws + WS_MQ0);
    float* LF = (float*)(ws + WS_LF);
    bf16_t* KR = (bf16_t*)(ws + WS_KR); bf16_t* VS = (bf16_t*)(ws + WS_VS); bf16_t* QG = (bf16_t*)(ws + WS_QG); bf16_t* MQ1 = (bf16_t*)(ws + WS_MQ1);
    bf16_t* MIX = (bf16_t*)(ws + WS_MIX);
    Args a{};
    for (int i = 0; i < 19; ++i) a.in[i] = (const float*)d_in[i];
    a.out = (float*)d_out; a.ws = (unsigned char*)d_ws;

    hipMemsetAsync((char*)d_ws + WS_CTL, 0, 16384, stream);
    launch_mk(a, PH_PRO, PH_END, stream);
}
```

```cpp
#include <hip/hip_runtime.h>
#include <stdint.h>

typedef unsigned short bf16_t;
typedef short bf16x8 __attribute__((ext_vector_type(8)));
typedef float f32x4 __attribute__((ext_vector_type(4)));
typedef unsigned u32x4 __attribute__((ext_vector_type(4)));
typedef unsigned u32x2 __attribute__((ext_vector_type(2)));

constexpr int DM = 1024, BATCH = 8, SEQ = 4096, T = BATCH * SEQ;
constexpr int HD = 128, NH = 6, AW = 768;
constexpr int MEMT = 256, MH = 4, MHD = 64, MW = 256, MROWS = BATCH * MEMT;
constexpr int A_COLS = 4 * AW + MW;
constexpr int B_COLS = 3 * AW + MW;
constexpr int KVB_COLS = 2 * AW + B_COLS;
constexpr int FFN = 2816;
constexpr float EPS = 1e-6f;
constexpr float LOG2E = 1.4426950408889634f;

constexpr size_t MiB = 1u << 20;
constexpr size_t WS_WA    = 0;
constexpr size_t WS_WKVB  = WS_WA + 7 * MiB;
constexpr size_t WS_WO    = WS_WKVB + 8 * MiB;
constexpr size_t WS_WGU   = WS_WO + 4 * MiB;
constexpr size_t WS_WD    = WS_WGU + 22 * MiB;
constexpr size_t WS_WMKV  = WS_WD + 11 * MiB;
constexpr size_t WS_SMALL = WS_WMKV + 2 * MiB;
constexpr size_t SM_LB = 0, SM_COS = 4096, SM_SIN = SM_COS + 4096 * 64 * 4, SM_SS0 = SM_SIN + 4096 * 64 * 4,
                 SM_SS1 = SM_SS0 + T * 4, SM_SS2 = SM_SS1 + T * 4, SM_SS3 = SM_SS2 + T * 4, SM_SSM = SM_SS3 + T * 4, SM_END = SM_SSM + MROWS * 4;
static_assert(SM_END <= 3 * MiB, "small");
constexpr size_t WS_CTL = WS_WMKV + 2 * MiB + 3 * MiB + 512 * 1024;
constexpr size_t WS_XB    = WS_SMALL + 4 * MiB;
constexpr size_t WS_MEMB  = WS_XB + 64 * MiB;
constexpr size_t WS_MK    = WS_MEMB + 4 * MiB;
constexpr size_t WS_MV    = WS_MK + 2 * MiB;
constexpr size_t WS_R1    = WS_MV + 2 * MiB;
constexpr size_t WS_QS    = WS_R1;
constexpr size_t WS_VV    = WS_QS + 48 * MiB;
constexpr size_t WS_SG    = WS_VV + 48 * MiB;
constexpr size_t WS_MQ0   = WS_SG + 48 * MiB;
constexpr size_t WS_LF    = WS_MQ0 + 16 * MiB;
constexpr size_t WS_MIX   = WS_R1 + 256 * MiB;
constexpr size_t WS_TMP   = WS_MIX + 64 * MiB;
constexpr size_t WS_ACT   = WS_R1;
constexpr size_t WS_TMP2  = WS_ACT + 176 * MiB;
constexpr size_t WS_KR    = WS_R1;
constexpr size_t WS_VS    = WS_KR + 48 * MiB;
constexpr size_t WS_QG    = WS_VS + 48 * MiB;
constexpr size_t WS_MQ1   = WS_QG + 144 * MiB;
constexpr size_t WS_LSE   = WS_TMP;
constexpr size_t WS_CSH   = WS_TMP + 4 * MiB;
constexpr size_t WS_END   = 512 * MiB;

__device__ __forceinline__ float bf2f(bf16_t v) { return __uint_as_float((unsigned)v << 16); }
__device__ __forceinline__ bf16_t f2bf(float f) { unsigned u = __float_as_uint(f); return (bf16_t)((u + 0x7fffu + ((u >> 16) & 1u)) >> 16); }
__device__ __forceinline__ float silu_f(float v) { return v / (1.f + __expf(-v)); }
__device__ __forceinline__ float wave_sum(float v) {
#pragma unroll
    for (int o = 1; o < 64; o <<= 1) v += __shfl_xor(v, o);
    return v;
}
__device__ __forceinline__ float wave_max(float v) {
#pragma unroll
    for (int o = 1; o < 64; o <<= 1) v = fmaxf(v, __shfl_xor(v, o));
    return v;
}

namespace nv {
__global__ void wt_kernel(const float* __restrict__ W, const float* __restrict__ gain, bf16_t* __restrict__ out, int K, int N, int row_off) {
    __shared__ float tile[32][33];
    const int n0 = blockIdx.x * 32, k0 = blockIdx.y * 32;
    const int tx = threadIdx.x & 31, ty = threadIdx.x >> 5;
    for (int i = ty; i < 32; i += 8) tile[i][tx] = W[(size_t)(k0 + i) * N + n0 + tx] * (gain ? gain[k0 + i] : 1.f);
    __syncthreads();
    for (int i = ty; i < 32; i += 8) out[(size_t)(row_off + n0 + i) * K + k0 + tx] = f2bf(tile[tx][i]);
}
__global__ void rows_kernel(const float* __restrict__ x, bf16_t* __restrict__ xb, float* __restrict__ ss, int rows) {
    const int row = blockIdx.x * 4 + (threadIdx.x >> 6), lane = threadIdx.x & 63;
    if (row >= rows) return;
    const f32x4* xr = (const f32x4*)(x + (size_t)row * DM) + lane;
    float s = 0.f;
#pragma unroll
    for (int j = 0; j < 4; ++j) { f32x4 v = xr[64 * j]; s += v.x * v.x + v.y * v.y + v.z * v.z + v.w * v.w;
        u32x2 o; o.x = f2bf(v.x) | ((unsigned)f2bf(v.y) << 16); o.y = f2bf(v.z) | ((unsigned)f2bf(v.w) << 16);
        *((u32x2*)(xb + (size_t)row * DM) + lane + 64 * j) = o; }
    s = wave_sum(s);
    if (lane == 0) ss[row] = s;
}
__global__ void misc_kernel(const float* __restrict__ lb_logits, float* __restrict__ sm) {
    const int i = blockIdx.x * blockDim.x + threadIdx.x;
    if (i < AW) { const float a0 = lb_logits[i], a1 = lb_logits[AW + i]; const float m = fmaxf(a0, a1); const float e0 = expf(a0 - m), e1 = expf(a1 - m); sm[SM_LB / 4 + i] = e0 / (e0 + e1); }
    if (i < 4096 * 64) { const int pos = i >> 6, fi = i & 63; const float inv = powf(10000.f, -(float)fi / 64.f); const float ang = (float)pos * inv;
        sm[SM_COS / 4 + i] = cosf(ang); sm[SM_SIN / 4 + i] = sinf(ang); }
    if (i < T) { sm[SM_SS1 / 4 + i] = 0.f; sm[SM_SS2 / 4 + i] = 0.f; sm[SM_SS3 / 4 + i] = 0.f; }
}
__global__ __launch_bounds__(256) void gemm_kernel(const bf16_t* __restrict__ A, const bf16_t* __restrict__ Bt, float* __restrict__ C, int K, int ldc) {
    const int wave = threadIdx.x >> 6, lane = threadIdx.x & 63, r = lane & 15, g = lane >> 4;
    const int m0 = blockIdx.y * 128 + (wave >> 1) * 64, n0 = blockIdx.x * 128 + (wave & 1) * 64;
    f32x4 acc[4][4];
#pragma unroll
    for (int i = 0; i < 4; ++i)
#pragma unroll
        for (int j = 0; j < 4; ++j) acc[i][j] = (f32x4){0.f, 0.f, 0.f, 0.f};
    for (int k0 = 0; k0 < K; k0 += 32) {
        bf16x8 a[4], b[4];
#pragma unroll
        for (int i = 0; i < 4; ++i) a[i] = *(const bf16x8*)(A + (size_t)(m0 + 16 * i + r) * K + k0 + 8 * g);
#pragma unroll
        for (int j = 0; j < 4; ++j) b[j] = *(const bf16x8*)(Bt + (size_t)(n0 + 16 * j + r) * K + k0 + 8 * g);
#pragma unroll
        for (int i = 0; i < 4; ++i)
#pragma unroll
            for (int j = 0; j < 4; ++j) acc[i][j] = __builtin_amdgcn_mfma_f32_16x16x32_bf16(a[i], b[j], acc[i][j], 0, 0, 0);
    }
#pragma unroll
    for (int i = 0; i < 4; ++i)
#pragma unroll
        for (int j = 0; j < 4; ++j)
#pragma unroll
            for (int e = 0; e < 4; ++e) C[(size_t)(m0 + 16 * i + 4 * g + e) * ldc + n0 + 16 * j + r] = acc[i][j][e];
}
__device__ __forceinline__ float rs_of(const float* ss, int row) { return rsqrtf(ss[row] * (1.f / DM) + EPS); }

__global__ __launch_bounds__(256) void epi_inproj0(const float* __restrict__ C, int row0, const float* __restrict__ ss, const float* __restrict__ lb, const float* __restrict__ mqn,
                                                   bf16_t* QS, float* LF, bf16_t* VV, bf16_t* SG, bf16_t* MQ) {
    const int lr = blockIdx.x, row = row0 + lr, tid = threadIdx.x;
    const float rs = rs_of(ss, row);
    const float* c = C + (size_t)lr * A_COLS;
    for (int d = tid; d < AW; d += 256) {
        QS[(size_t)row * AW + d] = f2bf(silu_f(c[d] * rs));
        const float z = c[AW + d] * rs, l = lb[d]; const float f = l + (1.f - l) / (1.f + __expf(-z));
        LF[(size_t)row * AW + d] = __logf(f);
        VV[(size_t)row * AW + d] = f2bf(c[2 * AW + d] * rs);
        SG[(size_t)row * AW + d] = f2bf(silu_f(c[3 * AW + d] * rs));
    }
    const int w = tid >> 6, lane = tid & 63;
    const float v = c[4 * AW + w * 64 + lane] * rs;
    const float s2 = wave_sum(v * v);
    const float r2 = rsqrtf(s2 * (1.f / 64.f) + EPS);
    MQ[(size_t)row * MW + w * 64 + lane] = f2bf(v * r2 * mqn[lane] * (0.125f * LOG2E));
}
__global__ __launch_bounds__(256) void epi_memkv(const float* __restrict__ C, const float* __restrict__ ss, const float* __restrict__ mkn, bf16_t* MK, bf16_t* MV) {
    const int row = blockIdx.x, tid = threadIdx.x, w = tid >> 6, lane = tid & 63;
    const float rs = rs_of(ss, row);
    const float* c = C + (size_t)row * 1024;
    for (int l = 0; l < 2; ++l) {
        const float v = c[l * 512 + w * 64 + lane] * rs;
        const float s2 = wave_sum(v * v);
        const float r2 = rsqrtf(s2 * (1.f / 64.f) + EPS);
        MK[((size_t)l * MROWS + row) * MW + w * 64 + lane] = f2bf(v * r2 * mkn[l * 64 + lane]);
        MV[((size_t)l * MROWS + row) * MW + tid] = f2bf(c[l * 512 + 256 + tid] * rs);
    }
}
__global__ __launch_bounds__(256) void epi_resid(const float* __restrict__ C, int row0, const float* base, float* H, bf16_t* HB, float* ssn) {
    __shared__ float red[4];
    const int lr = blockIdx.x, row = row0 + lr, tid = threadIdx.x;
    float s = 0.f;
    for (int d = tid; d < DM; d += 256) { const float v = base[(size_t)row * DM + d] + C[(size_t)lr * DM + d]; H[(size_t)row * DM + d] = v; if (HB) HB[(size_t)row * DM + d] = f2bf(v); s += v * v; }
    s = wave_sum(s);
    if ((tid & 63) == 0) red[tid >> 6] = s;
    __syncthreads();
    if (tid == 0 && ssn) ssn[row] = red[0] + red[1] + red[2] + red[3];
}
__global__ __launch_bounds__(256) void epi_gateup(const float* __restrict__ C, int row0, const float* __restrict__ ss, bf16_t* ACT) {
    const int lr = blockIdx.x, row = row0 + lr, tid = threadIdx.x;
    const float rs = rs_of(ss, row);
    const float* c = C + (size_t)lr * (2 * FFN);
    for (int j = tid; j < FFN; j += 256) ACT[(size_t)row * FFN + j] = f2bf(silu_f(c[j] * rs) * (c[FFN + j] * rs));
}
__global__ __launch_bounds__(256) void epi_kvb(const float* __restrict__ C, int row0, const float* __restrict__ ss, const float* __restrict__ knorm, const float* __restrict__ qnorm  ,
                                               const float* __restrict__ mqn, const float* __restrict__ cs, const float* __restrict__ sn,
                                               bf16_t* KR, bf16_t* VS, bf16_t* QG, bf16_t* MQ) {
    const int lr = blockIdx.x, row = row0 + lr, tid = threadIdx.x, w = tid >> 6, lane = tid & 63;
    const int pos = row & (SEQ - 1);
    const float rs = rs_of(ss, row);
    const float* c = C + (size_t)lr * KVB_COLS;
    const float co = cs[pos * 64 + lane], si = sn[pos * 64 + lane];
    for (int hv = w; hv < 30; hv += 4) {
        const float x1 = c[hv * 128 + lane] * rs, x2 = c[hv * 128 + 64 + lane] * rs;
        if (hv >= 6 && hv < 12) { VS[(size_t)row * AW + (hv - 6) * 128 + lane] = f2bf(x1); VS[(size_t)row * AW + (hv - 6) * 128 + 64 + lane] = f2bf(x2); continue; }
        const float s2 = wave_sum(x1 * x1 + x2 * x2);
        const float r2 = rsqrtf(s2 * (1.f / 128.f) + EPS);
        const float* gn = hv < 6 ? knorm : qnorm + ((hv - 12) / 6) * 128;
        const float sc = hv < 6 ? 1.f : (0.08838834764831845f * LOG2E);
        const float y1 = x1 * r2 * gn[lane] * sc, y2 = x2 * r2 * gn[64 + lane] * sc;
        const float o1 = y1 * co - y2 * si, o2 = y2 * co + y1 * si;
        bf16_t* dst = hv < 6 ? KR + (size_t)row * AW + hv * 128 : QG + ((size_t)((hv - 12) / 6) * T + row) * AW + ((hv - 12) % 6) * 128;
        dst[lane] = f2bf(o1); dst[64 + lane] = f2bf(o2);
    }
    const float v = c[30 * 128 + w * 64 + lane] * rs;
    const float s2 = wave_sum(v * v);
    const float r2 = rsqrtf(s2 * (1.f / 64.f) + EPS);
    MQ[(size_t)row * MW + w * 64 + lane] = f2bf(v * r2 * mqn[lane] * (0.125f * LOG2E));
}
__global__ __launch_bounds__(256) void hgrn_kernel(const bf16_t* __restrict__ QS, const float* __restrict__ LF, const bf16_t* __restrict__ VV, const bf16_t* __restrict__ SG,
                                                   const float* __restrict__ onorm, bf16_t* MIX) {
    __shared__ float qs[128], kk[128], ff[128], vv[128], part[256], red[2];
    const int b = blockIdx.x / NH, h = blockIdx.x % NH, tid = threadIdx.x, dv = tid & 127, half = tid >> 7;
    float S[64];
#pragma unroll
    for (int i = 0; i < 64; ++i) S[i] = 0.f;
    for (int t = 0; t < SEQ; ++t) {
        const size_t off = (size_t)(b * SEQ + t) * AW + h * 128;
        if (tid < 128) { const float f = __expf(LF[off + tid]); ff[tid] = f; kk[tid] = 1.f - f; qs[tid] = bf2f(QS[off + tid]); vv[tid] = bf2f(VV[off + tid]); }
        __syncthreads();
        const float v = vv[dv]; float o = 0.f;
#pragma unroll
        for (int i = 0; i < 64; ++i) { const int dk = half * 64 + i; S[i] = ff[dk] * S[i] + kk[dk] * v; o += S[i] * qs[dk]; }
        part[tid] = o;
        __syncthreads();
        if (tid < 128) { o = part[tid] + part[tid + 128]; const float s2 = wave_sum(o * o); if ((tid & 63) == 0) red[tid >> 6] = s2; part[tid] = o; }
        __syncthreads();
        if (tid < 128) { const float r2 = rsqrtf((red[0] + red[1]) * (1.f / 128.f) + EPS);
            MIX[(size_t)(b * SEQ + t) * DM + h * 128 + tid] = f2bf(part[tid] * r2 * onorm[h * 128 + tid] * bf2f(SG[off + tid])); }
    }
}
__global__ __launch_bounds__(256) void memattn_kernel(const bf16_t* __restrict__ MQ, const bf16_t* __restrict__ MK, const bf16_t* __restrict__ MV, bf16_t* MIX) {
    __shared__ float qsh[4][64];
    const int w = threadIdx.x >> 6, lane = threadIdx.x & 63;
    const int item = blockIdx.x * 4 + w, row = item >> 2, hd = item & 3, b = row / SEQ;
    qsh[w][lane] = bf2f(MQ[(size_t)row * MW + hd * 64 + lane]);
    __syncthreads();
    float s[4], m = -1e30f;
#pragma unroll
    for (int j = 0; j < 4; ++j) { const bf16_t* kr = MK + ((size_t)(b * MEMT + lane + 64 * j)) * MW + hd * 64; float a = 0.f;
        for (int c8 = 0; c8 < 8; ++c8) { const bf16x8 kv = *(const bf16x8*)(kr + 8 * c8);
#pragma unroll
            for (int e = 0; e < 8; ++e) a += qsh[w][c8 * 8 + e] * bf2f((bf16_t)kv[e]); }
        s[j] = a; m = fmaxf(m, a); }
    m = wave_max(m);
    float l = 0.f;
#pragma unroll
    for (int j = 0; j < 4; ++j) { s[j] = exp2f(s[j] - m); l += s[j]; }
    l = wave_sum(l);
    float o = 0.f;
#pragma unroll
    for (int j = 0; j < 4; ++j)
        for (int kq = 0; kq < 64; ++kq) { const float p = __shfl(s[j], kq); o += p * bf2f(MV[((size_t)(b * MEMT + kq + 64 * j)) * MW + hd * 64 + lane]); }
    MIX[(size_t)row * DM + AW + hd * 64 + lane] = f2bf(o / l);
}
__global__ __launch_bounds__(256) void dilattn_kernel(const bf16_t* __restrict__ QG, const bf16_t* __restrict__ KR, const bf16_t* __restrict__ VS, bf16_t* MIX) {
    __shared__ float qsh[4][3][128];
    const int w = threadIdx.x >> 6, lane = threadIdx.x & 63;
    const int item = blockIdx.x * 4 + w, row = item / NH, h = item % NH, b = row / SEQ, t = row % SEQ;
#pragma unroll
    for (int g = 0; g < 3; ++g) { qsh[w][g][lane] = bf2f(QG[((size_t)g * T + row) * AW + h * 128 + lane]); qsh[w][g][64 + lane] = bf2f(QG[((size_t)g * T + row) * AW + h * 128 + 64 + lane]); }
    __syncthreads();
    float s[3][3]; float m = -1e30f;
#pragma unroll
    for (int g = 0; g < 3; ++g) { const int dil = g == 0 ? 1 : (g == 1 ? 4 : 16);
#pragma unroll
        for (int jj = 0; jj < 3; ++jj) { const int j = lane + 64 * jj; const int pk = t - j * dil; float a = -1e30f;
            if (j <= 128 && pk >= 0) { const bf16_t* kr = KR + ((size_t)(b * SEQ + pk)) * AW + h * 128; a = 0.f; for (int c8 = 0; c8 < 16; ++c8) { const bf16x8 kv = *(const bf16x8*)(kr + 8 * c8);
#pragma unroll
                for (int e = 0; e < 8; ++e) a += qsh[w][g][c8 * 8 + e] * bf2f((bf16_t)kv[e]); } }
            s[g][jj] = a; m = fmaxf(m, a); } }
    m = wave_max(m);
    float l = 0.f;
#pragma unroll
    for (int g = 0; g < 3; ++g)
#pragma unroll
        for (int jj = 0; jj < 3; ++jj) { const float p = s[g][jj] > -1e29f ? exp2f(s[g][jj] - m) : 0.f; s[g][jj] = p; l += p; }
    l = wave_sum(l);
    float o0 = 0.f, o1 = 0.f;
#pragma unroll
    for (int g = 0; g < 3; ++g) { const int dil = g == 0 ? 1 : (g == 1 ? 4 : 16);
#pragma unroll
        for (int jj = 0; jj < 3; ++jj) {
            const int nk = jj < 2 ? 64 : 1;
            for (int kq = 0; kq < nk; ++kq) { const int j = kq + 64 * jj; const int pk = t - j * dil; if (pk < 0) break;
                const float p = __shfl(s[g][jj], kq);
                const bf16_t* vr = VS + ((size_t)(b * SEQ + pk)) * AW + h * 128;
                o0 += p * bf2f(vr[lane]); o1 += p * bf2f(vr[64 + lane]); } } }
    MIX[(size_t)row * DM + h * 128 + lane] = f2bf(o0 / l); MIX[(size_t)row * DM + h * 128 + 64 + lane] = f2bf(o1 / l);
}
}

#define LAS __attribute__((address_space(3)))
#define GAS __attribute__((address_space(1)))

constexpr int NTHREADS = 512, NWAVES = 8;
constexpr int RING_BYTES = 131072;
constexpr int XSCR_OFF = RING_BYTES;
constexpr int LDS_BYTES = 151552;
constexpr int OST_OFF = 133120;
constexpr int MISC_OFF = LDS_BYTES - 256;

__host__ __device__ __forceinline__ int rho_of(int r) { return 16 * ((r >> 2) & 1) + 4 * (r >> 3) + (r & 3); }
__host__ __device__ __forceinline__ int slot_std(int c) { return (c & ~31) + rho_of(c & 31); }
__host__ __device__ __forceinline__ int slot_rope(int d) { return 32 * ((d & 63) >> 4) + 16 * (d >> 6) + (d & 15); }
__host__ __device__ __forceinline__ int slot_mq(int c) { return 128 * ((c >> 5) & 1) + 32 * (c >> 6) + rho_of(c & 31); }
enum { MAP_WA = 0, MAP_KV = 1, MAP_BIN = 2, MAP_STD = 3, MAP_GU = 4, MAP_MKV0 = 5, MAP_MKV1 = 6 };
__device__ __forceinline__ int dst_row(int map, int n) {
    switch (map) {
    case MAP_WA:  return n < 3072 ? (n & ~127) + slot_std(n & 127) : 3072 + slot_mq(n - 3072);
    case MAP_KV:  return n < 768 ? (n & ~127) + slot_rope(n & 127) : (n & ~127) + slot_std(n & 127);
    case MAP_BIN: return n < 2304 ? 1536 + (n & ~127) + slot_std(n & 127) : 3840 + slot_mq(n - 2304);
    case MAP_STD: return (n & ~127) + slot_std(n & 127);
    case MAP_GU:  return n < FFN ? 256 * (n >> 7) + slot_std(n & 127) : 256 * ((n - FFN) >> 7) + 128 + slot_std((n - FFN) & 127);
    case MAP_MKV0: return n < 256 ? slot_mq(n) : 256 + ((n - 256) & ~127) + slot_std((n - 256) & 127);
    default:       return 512 + (n < 256 ? slot_mq(n) : 256 + ((n - 256) & ~127) + slot_std((n - 256) & 127));
    }
}

typedef float f32x2_t __attribute__((ext_vector_type(2))); typedef __bf16 bf16x2_t __attribute__((ext_vector_type(2)));
__device__ __forceinline__ unsigned cvt_pk_bf16(float lo, float hi) { f32x2_t v = {lo, hi}; bf16x2_t b = __builtin_convertvector(v, bf16x2_t); return __builtin_bit_cast(unsigned, b); }
__device__ __forceinline__ float fast_sigmoid(float v) { return __builtin_amdgcn_rcpf(1.f + __builtin_amdgcn_exp2f(-LOG2E * v)); }
__device__ __forceinline__ float fast_silu(float v) { return v * fast_sigmoid(v); }

__device__ __forceinline__ float row16_sum(float v) {
    v += __builtin_bit_cast(float, __builtin_amdgcn_mov_dpp(__builtin_bit_cast(int, v), 0x128, 0xf, 0xf, true));
    v += __builtin_bit_cast(float, __builtin_amdgcn_mov_dpp(__builtin_bit_cast(int, v), 0x124, 0xf, 0xf, true));
    v += __builtin_bit_cast(float, __builtin_amdgcn_mov_dpp(__builtin_bit_cast(int, v), 0x122, 0xf, 0xf, true));
    v += __builtin_bit_cast(float, __builtin_amdgcn_mov_dpp(__builtin_bit_cast(int, v), 0x121, 0xf, 0xf, true));
    return v; }
__device__ __forceinline__ float xrow_sum(float v) {
    { auto r = __builtin_amdgcn_permlane16_swap(__float_as_uint(v), __float_as_uint(v), false, false); v = __uint_as_float(r[0]) + __uint_as_float(r[1]); }
    { auto r = __builtin_amdgcn_permlane32_swap(__float_as_uint(v), __float_as_uint(v), false, false); v = __uint_as_float(r[0]) + __uint_as_float(r[1]); }
    return v; }
__device__ __forceinline__ float xrow_max(float v) {
    { auto r = __builtin_amdgcn_permlane16_swap(__float_as_uint(v), __float_as_uint(v), false, false); v = fmaxf(__uint_as_float(r[0]), __uint_as_float(r[1])); }
    { auto r = __builtin_amdgcn_permlane32_swap(__float_as_uint(v), __float_as_uint(v), false, false); v = fmaxf(__uint_as_float(r[0]), __uint_as_float(r[1])); }
    return v; }
__device__ __forceinline__ int fresh_tid(int wave_s) { int t = wave_s * 64 + (int)__builtin_amdgcn_mbcnt_hi(~0u, __builtin_amdgcn_mbcnt_lo(~0u, 0u)); asm volatile("" : "+v"(t)); return t; }
namespace pg8 {
constexpr int BM = 256, BK = 64, HALF = 128, HTB = HALF * BK * 2, STAGE_BYTES = 8 * HTB, NXCD = 8, WGM = 8;
__host__ __device__ __forceinline__ int lds_byte(int r, int c) { const int st = (r >> 4) * 2 + (c >> 5), rr = r & 15, cc = c & 31, ob = rr * 64 + cc * 2; return st * 1024 + (ob ^ (((ob >> 9) & 1) << 5)); }
__host__ __device__ __forceinline__ void stage_rc(int b, int& R, int& C) { const int st = b / 1024, sb = b % 1024, swz = sb ^ (((sb >> 9) & 1) << 5); R = (st >> 1) * 16 + swz / 64; C = (st & 1) * 32 + (swz % 64) / 2; }
struct Unit { int pm, pn; };
struct StaticOrder {
    int nM, nN, nwg, G, c;
    __device__ void init(int M, int N, int G_, int c_) { nM = M / BM; nN = N / BM; nwg = nM * nN; G = G_; c = c_; }
    __device__ bool next(int i, Unit& u) const {
        const long L = (long)i * G + c; if (L >= nwg) return false;
        int wgid = (int)L; { const int q = nwg / NXCD, r = nwg % NXCD, xcd = wgid % NXCD, off = wgid / NXCD; wgid = (xcd < r ? xcd * (q + 1) : r * (q + 1) + (xcd - r) * q) + off; }
        const int nig = WGM * nN, gid = wgid / nig, fm = gid * WGM, gsz = (nM - fm) < WGM ? (nM - fm) : WGM;
        u.pm = fm + ((wgid % nig) % gsz); u.pn = (wgid % nig) / gsz; return true;
    }
};
typedef f32x4 Acc[2][2][4][2];

template <bool ALIGN_EPI = true, class Epi>
__device__ __forceinline__ void gemm_phase(LAS unsigned char* lds, int wave_s, const bf16_t* A, const bf16_t* Bt, int M, int N, int K, const StaticOrder& S, const Epi& E) {
    const int tid = fresh_tid(wave_s);
    const int wid = __builtin_amdgcn_readfirstlane(tid >> 6), lane = tid & 63, wr = wid >> 2, wc = wid & 3, fr = lane & 15, fq = lane >> 4;
    const int nt = K / BK;
#ifdef STAGGER_TICKS
    { const unsigned long long t0 = __builtin_amdgcn_s_memrealtime(); const unsigned long long dl = (unsigned long long)((blockIdx.x >> 3) & 3) * STAGGER_TICKS;
      while (__builtin_amdgcn_s_memrealtime() - t0 < dl) __builtin_amdgcn_s_sleep(16); }
#endif
    unsigned voff[2];
#pragma unroll
    for (int i = 0; i < 2; ++i) { int R, C; stage_rc(tid * 16 + i * 8192, R, C); voff[i] = (unsigned)(R * K + C) * 2u; }
    const size_t kstep = (size_t)(BK * 2);
    const size_t hstep = (size_t)HALF * K * 2;
    const size_t tstep = 2 * hstep;
    const unsigned ldsw = (unsigned)wid * 1024u;
    const int aoff = lds_byte(wr * 64 + fr, fq * 8), boff = lds_byte(wc * 32 + fr, fq * 8);
#define PG8_SA(b, h) (((b) * 2 + (h)) * HTB)
#define PG8_SB(b, h) ((4 + (b) * 2 + (h)) * HTB)
#define PG8_STAGE(bufoff, gbase) do { _Pragma("unroll") for (int _i = 0; _i < 2; ++_i) \
        __builtin_amdgcn_global_load_lds((const unsigned*)((const char*)(gbase) + voff[_i]), (LAS unsigned*)(lds + (bufoff) + ldsw + _i * 8192), 16, 0, 0); } while (0)
#define PG8_LDA(dst, b, h) do { _Pragma("unroll") for (int m = 0; m < 4; ++m) _Pragma("unroll") for (int k = 0; k < 2; ++k) dst[m][k] = *(const LAS bf16x8*)(lds + PG8_SA(b, h) + aoff + m * 2048 + k * 1024); } while (0)
#define PG8_LDB(dst, b, h) do { _Pragma("unroll") for (int n = 0; n < 2; ++n) _Pragma("unroll") for (int k = 0; k < 2; ++k) dst[n][k] = *(const LAS bf16x8*)(lds + PG8_SB(b, h) + boff + n * 2048 + k * 1024); } while (0)
#define PG8_MMA(ai, bj, At, Bt_) do { __builtin_amdgcn_s_setprio(1); _Pragma("unroll") for (int m = 0; m < 4; ++m) _Pragma("unroll") for (int n = 0; n < 2; ++n) _Pragma("unroll") for (int k = 0; k < 2; ++k) \
        acc[ai][bj][m][n] = __builtin_amdgcn_mfma_f32_16x16x32_bf16(Bt_[n][k], At[m][k], acc[ai][bj][m][n], 0, 0, 0); __builtin_amdgcn_s_setprio(0); } while (0)
#define PG8_WAIT_V(n) asm volatile("s_waitcnt vmcnt(" #n ")" ::: "memory")
#define PG8_WAIT_L(n) asm volatile("s_waitcnt lgkmcnt(" #n ")" ::: "memory")
#define PG8_BAR __builtin_amdgcn_s_barrier()
#define PG8_SCHED __builtin_amdgcn_sched_barrier(0)
    Unit cur, nxt; int ui = 0;
    if (!S.next(0, cur)) return;
    Acc acc;
#pragma unroll
    for (int a = 0; a < 2; ++a)
#pragma unroll
        for (int b = 0; b < 2; ++b)
#pragma unroll
            for (int m = 0; m < 4; ++m)
#pragma unroll
                for (int n = 0; n < 2; ++n) acc[a][b][m][n] = (f32x4){0.f, 0.f, 0.f, 0.f};
    bf16x8 At[4][2], B0[2][2], B1[2][2];
    const char* cA = (const char*)A + (size_t)cur.pm * tstep; const char* cB = (const char*)Bt + (size_t)cur.pn * tstep;
    PG8_STAGE(PG8_SB(0, 0), cB); PG8_STAGE(PG8_SB(0, 1), cB + hstep); PG8_STAGE(PG8_SA(0, 0), cA); PG8_STAGE(PG8_SA(0, 1), cA + hstep);
    if (wr == 1) PG8_BAR;
    PG8_WAIT_V(2); PG8_BAR;
    PG8_STAGE(PG8_SB(1, 0), cB + kstep); PG8_STAGE(PG8_SA(1, 0), cA + kstep); PG8_STAGE(PG8_SB(1, 1), cB + hstep + kstep);
    PG8_WAIT_V(6); PG8_BAR;
    for (;;) {
        const bool has_next = S.next(ui + 1, nxt);
        const char* nA = has_next ? (const char*)A + (size_t)nxt.pm * tstep : cA; const char* nB = has_next ? (const char*)Bt + (size_t)nxt.pn * tstep : cB;
        for (int t = 0; t < nt; t += 2) {
            const bool last = (t == nt - 2);
            const char* a1 = cA + (size_t)(t + 1) * kstep;
            const char* a2 = last ? nA : cA + (size_t)(t + 2) * kstep; const char* b2 = last ? nB : cB + (size_t)(t + 2) * kstep;
            const char* a3 = a2 + kstep; const char* b3 = b2 + kstep;
            PG8_LDB(B0, 0, 0); PG8_LDB(B1, 0, 1); PG8_SCHED; PG8_LDA(At, 0, 0); PG8_STAGE(PG8_SA(1, 1), a1 + hstep);
            PG8_WAIT_V(8); PG8_WAIT_L(0); PG8_BAR; PG8_MMA(0, 0, At, B0); PG8_MMA(0, 1, At, B1); PG8_BAR; PG8_SCHED;
            PG8_LDA(At, 0, 1); PG8_STAGE(PG8_SB(0, 0), b2); PG8_STAGE(PG8_SB(0, 1), b2 + hstep); PG8_STAGE(PG8_SA(0, 0), a2);
            PG8_WAIT_V(8); PG8_WAIT_L(0); PG8_BAR; PG8_MMA(1, 0, At, B0); PG8_MMA(1, 1, At, B1); PG8_BAR; PG8_SCHED;
            PG8_LDB(B0, 1, 0); PG8_LDB(B1, 1, 1); PG8_SCHED; PG8_LDA(At, 1, 0); PG8_STAGE(PG8_SA(0, 1), a2 + hstep);
            PG8_WAIT_V(8); PG8_WAIT_L(0); PG8_BAR; PG8_MMA(0, 0, At, B0); PG8_MMA(0, 1, At, B1); PG8_BAR; PG8_SCHED;
            PG8_LDA(At, 1, 1); PG8_STAGE(PG8_SB(1, 0), b3); PG8_STAGE(PG8_SB(1, 1), b3 + hstep); PG8_STAGE(PG8_SA(1, 0), a3);
            PG8_WAIT_V(8); PG8_WAIT_L(0); PG8_BAR; PG8_MMA(1, 0, At, B0); PG8_MMA(1, 1, At, B1); PG8_BAR; PG8_SCHED;
        }
        if (ALIGN_EPI) { if (wr == 0) PG8_BAR; }
        { int fr_ = fr, fq_ = fq; asm volatile("" : "+v"(fr_), "+v"(fq_));
          E(acc, cur, wr, wc, fr_, fq_, lds); }
        if (!has_next) break;
#pragma unroll
        for (int a = 0; a < 2; ++a)
#pragma unroll
            for (int b = 0; b < 2; ++b)
#pragma unroll
                for (int m = 0; m < 4; ++m)
#pragma unroll
                    for (int n = 0; n < 2; ++n) acc[a][b][m][n] = (f32x4){0.f, 0.f, 0.f, 0.f};
        cur = nxt; cA = nA; cB = nB; ++ui;
        if (ALIGN_EPI) { if (wr == 1) PG8_BAR; }
    }
    PG8_WAIT_V(0);
    if (!ALIGN_EPI) { if (wr == 0) PG8_BAR; }
    PG8_BAR;
#undef PG8_SA
#undef PG8_SB
#undef PG8_STAGE
#undef PG8_LDA
#undef PG8_LDB
#undef PG8_MMA
#undef PG8_WAIT_V
#undef PG8_WAIT_L
#undef PG8_BAR
#undef PG8_SCHED
}

__device__ __forceinline__ float rs_of(const float* ss, int row) { return __builtin_amdgcn_rsqf(ss[row] * (1.f / DM) + EPS); }
__device__ __forceinline__ u32x4 pack8(const f32x4& a, const f32x4& b) { u32x4 w; w.x = cvt_pk_bf16(a[0], a[1]); w.y = cvt_pk_bf16(a[2], a[3]); w.z = cvt_pk_bf16(b[0], b[1]); w.w = cvt_pk_bf16(b[2], b[3]); return w; }
__device__ __forceinline__ void load_rs8(const float* ss, int row0, float (&rs)[2][4]) {
#pragma unroll
    for (int ai = 0; ai < 2; ++ai)
#pragma unroll
        for (int m = 0; m < 4; ++m) rs[ai][m] = ss[row0 + ai * HALF + m * 16];
#pragma unroll
    for (int ai = 0; ai < 2; ++ai)
#pragma unroll
        for (int m = 0; m < 4; ++m) rs[ai][m] = __builtin_amdgcn_rsqf(rs[ai][m] * (1.f / DM) + EPS);
}

__device__ __forceinline__ void head64_store(f32x4 a0, f32x4 a1, f32x4 b0, f32x4 b1, float rs, const f32x4 (&gn)[4], float scale, bf16_t* dst  , int fq) {
    a0 *= rs; a1 *= rs; b0 *= rs; b1 *= rs;
    float s = 0.f;
#pragma unroll
    for (int e = 0; e < 4; ++e) s += a0[e] * a0[e] + a1[e] * a1[e] + b0[e] * b0[e] + b1[e] * b1[e];
    s = xrow_sum(s);
    const float r2 = __builtin_amdgcn_rsqf(s * (1.f / 64.f) + EPS) * scale;
    *(u32x4*)(dst + 8 * fq) = pack8(a0 * gn[0] * r2, a1 * gn[1] * r2);
    *(u32x4*)(dst + 32 + 8 * fq) = pack8(b0 * gn[2] * r2, b1 * gn[3] * r2);
}
__device__ __forceinline__ void load_gain64(const float* gain, int fq, f32x4 (&gn)[4]) {
    gn[0] = *(const f32x4*)(gain + 8 * fq); gn[1] = *(const f32x4*)(gain + 8 * fq + 4); gn[2] = *(const f32x4*)(gain + 32 + 8 * fq); gn[3] = *(const f32x4*)(gain + 32 + 8 * fq + 4);
}

struct EpiInproj0 {
    const float* ss; const float* lb; const float* mqn; bf16_t* QS; unsigned short* LF; bf16_t* VV; bf16_t* SG; bf16_t* MQ;
    __device__ __forceinline__ void operator()(const Acc& acc, const Unit& u, int wr, int wc, int fr, int fq, LAS unsigned char*) const {
        const int row0 = u.pm * BM + wr * 64 + fr, pn = u.pn;
        float rs[2][4]; load_rs8(ss, row0, rs);
        if (pn == 12) {
            f32x4 gn[4]; load_gain64(mqn, fq, gn);
#pragma unroll
            for (int ai = 0; ai < 2; ++ai)
#pragma unroll
                for (int m = 0; m < 4; ++m) { const int row = row0 + ai * HALF + m * 16;
                    head64_store(acc[ai][0][m][0], acc[ai][0][m][1], acc[ai][1][m][0], acc[ai][1][m][1], rs[ai][m], gn, 0.125f * LOG2E, MQ + (size_t)row * MW + 64 * wc, fq); }
            return;
        }
        const int kind = pn / 3, colb = (pn % 3) * 256 + wc * 32 + 8 * fq;
        if (kind == 1) {
            f32x4 lbv[2][2];
#pragma unroll
            for (int bj = 0; bj < 2; ++bj) { lbv[bj][0] = *(const f32x4*)(lb + colb + bj * HALF); lbv[bj][1] = *(const f32x4*)(lb + colb + bj * HALF + 4); }
#pragma unroll
            for (int ai = 0; ai < 2; ++ai)
#pragma unroll
                for (int m = 0; m < 4; ++m) { const int row = row0 + ai * HALF + m * 16; const float r = rs[ai][m];
#pragma unroll
                    for (int bj = 0; bj < 2; ++bj) { f32x4 v0 = acc[ai][bj][m][0] * r, v1 = acc[ai][bj][m][1] * r; const size_t o = (size_t)row * AW + colb + bj * HALF;
#pragma unroll
                        for (int e = 0; e < 4; ++e) { const float l0 = lbv[bj][0][e], l1 = lbv[bj][1][e];
                            v0[e] = __builtin_amdgcn_logf(l0 + (1.f - l0) * fast_sigmoid(v0[e])) * 0.6931471805599453f; v1[e] = __builtin_amdgcn_logf(l1 + (1.f - l1) * fast_sigmoid(v1[e])) * 0.6931471805599453f; }
                        typedef _Float16 h2_t __attribute__((ext_vector_type(2)));
                        u32x4 w; { h2_t p0 = {(_Float16)v0[0], (_Float16)v0[1]}, p1 = {(_Float16)v0[2], (_Float16)v0[3]}, p2 = {(_Float16)v1[0], (_Float16)v1[1]}, p3 = {(_Float16)v1[2], (_Float16)v1[3]};
                            w.x = __builtin_bit_cast(unsigned, p0); w.y = __builtin_bit_cast(unsigned, p1); w.z = __builtin_bit_cast(unsigned, p2); w.w = __builtin_bit_cast(unsigned, p3); }
                        *(u32x4*)(LF + o) = w; } }
            return;
        }
        bf16_t* dst = QS + (size_t)(kind == 0 ? 0 : kind - 1) * ((size_t)T * AW);
#pragma unroll
        for (int ai = 0; ai < 2; ++ai)
#pragma unroll
            for (int m = 0; m < 4; ++m) { const int row = row0 + ai * HALF + m * 16; const float r = rs[ai][m];
#pragma unroll
                for (int bj = 0; bj < 2; ++bj) { f32x4 v0 = acc[ai][bj][m][0] * r, v1 = acc[ai][bj][m][1] * r; const size_t o = (size_t)row * AW + colb + bj * HALF;
                    if (kind != 2) {
#pragma unroll
                        for (int e = 0; e < 4; ++e) { v0[e] = fast_silu(v0[e]); v1[e] = fast_silu(v1[e]); } }
                    *(u32x4*)(dst + o) = pack8(v0, v1); } }
    }
};
struct EpiMemKV {
    const float* ss; const float* mkn; bf16_t* MK; bf16_t* MV;
    __device__ __forceinline__ void operator()(const Acc& acc, const Unit& u, int wr, int wc, int fr, int fq, LAS unsigned char*) const {
        const int row0 = u.pm * BM + wr * 64 + fr, l = u.pn >> 1;
        float rs[2][4]; load_rs8(ss, row0, rs);
        f32x4 gn[4]; load_gain64(mkn + l * 64, fq, gn);
#pragma unroll
        for (int ai = 0; ai < 2; ++ai)
#pragma unroll
            for (int m = 0; m < 4; ++m) { const int row = row0 + ai * HALF + m * 16; const float r = rs[ai][m];
                if ((u.pn & 1) == 0) head64_store(acc[ai][0][m][0], acc[ai][0][m][1], acc[ai][1][m][0], acc[ai][1][m][1], r, gn, 1.f, MK + ((size_t)l * MROWS + row) * MW + 64 * wc, fq);
                else {
#pragma unroll
                    for (int bj = 0; bj < 2; ++bj) *(u32x4*)(MV + ((size_t)l * MROWS + row) * MW + bj * HALF + wc * 32 + 8 * fq) = pack8(acc[ai][bj][m][0] * r, acc[ai][bj][m][1] * r); } }
    }
};
template <bool BF_IN, bool F32_OUT>
struct EpiResid {
    const float* base; float* H; bf16_t* HB; float* ssn;
    __device__ __forceinline__ void operator()(const Acc& acc, const Unit& u, int wr, int wc, int fr, int fq, LAS unsigned char*) const {
        const int row0 = u.pm * BM + wr * 64 + fr, col0 = u.pn * BM + wc * 32 + 8 * fq;
        const unsigned e00 = (unsigned)(row0 * DM + col0);
        const char* bp = (const char*)base; char* hp = (char*)H; char* hbp = (char*)HB;
        f32x4 bs[2][2][2][2];
        u32x4 bb[2][2][2];
#define RES_LOAD(buf, k) do { _Pragma("unroll") for (int m2 = 0; m2 < 2; ++m2) _Pragma("unroll") for (int bj = 0; bj < 2; ++bj) { \
            const unsigned e = e00 + (unsigned)((((k) >> 1) * HALF + (((k) & 1) * 2 + m2) * 16) * DM + bj * HALF); \
            if (BF_IN) bb[buf][m2][bj] = *(const u32x4*)(hbp + e * 2u); \
            else { bs[buf][m2][bj][0] = *(const f32x4*)(bp + e * 4u); bs[buf][m2][bj][1] = *(const f32x4*)(bp + e * 4u + 16); } } } while (0)
        RES_LOAD(0, 0);
#pragma unroll
        for (int k = 0; k < 4; ++k) {
            if (k < 3) RES_LOAD((k + 1) & 1, k + 1);
#pragma unroll
            for (int m2 = 0; m2 < 2; ++m2) { const int ai = k >> 1, m = (k & 1) * 2 + m2; const int row = row0 + ai * HALF + m * 16; float s = 0.f;
#pragma unroll
                for (int bj = 0; bj < 2; ++bj) { const unsigned e = e00 + (unsigned)((ai * HALF + m * 16) * DM + bj * HALF);
                    f32x4 b0, b1;
                    if (BF_IN) { const u32x4 w = bb[k & 1][m2][bj];
                        b0 = (f32x4){__uint_as_float(w.x << 16), __uint_as_float(w.x & 0xffff0000u), __uint_as_float(w.y << 16), __uint_as_float(w.y & 0xffff0000u)};
                        b1 = (f32x4){__uint_as_float(w.z << 16), __uint_as_float(w.z & 0xffff0000u), __uint_as_float(w.w << 16), __uint_as_float(w.w & 0xffff0000u)}; }
                    else { b0 = bs[k & 1][m2][bj][0]; b1 = bs[k & 1][m2][bj][1]; }
                    const f32x4 v0 = b0 + acc[ai][bj][m][0], v1 = b1 + acc[ai][bj][m][1];
                    if (F32_OUT) { *(f32x4*)(hp + e * 4u) = v0; *(f32x4*)(hp + e * 4u + 16) = v1; }
                    else { *(u32x4*)(hbp + e * 2u) = pack8(v0, v1);
#pragma unroll
                        for (int q = 0; q < 4; ++q) s += v0[q] * v0[q] + v1[q] * v1[q]; } }
                if (!F32_OUT) { s = xrow_sum(s); if (fq == 0) atomicAdd(ssn + row, s); } }
            asm volatile("" ::: "memory"); }
#undef RES_LOAD
    }
};
struct EpiNull {
    __device__ __forceinline__ void operator()(const Acc& acc, const Unit&, int, int, int, int, LAS unsigned char*) const {
#pragma unroll
        for (int a = 0; a < 2; ++a)
#pragma unroll
            for (int b = 0; b < 2; ++b)
#pragma unroll
                for (int m = 0; m < 4; ++m)
#pragma unroll
                    for (int n = 0; n < 2; ++n) asm volatile("" :: "v"(acc[a][b][m][n]));
    }
};
struct EpiGateUp {
    const float* ss; bf16_t* ACT;
    __device__ __forceinline__ void operator()(const Acc& acc, const Unit& u, int wr, int wc, int fr, int fq, LAS unsigned char*) const {
        const int row0 = u.pm * BM + wr * 64 + fr, col0 = u.pn * HALF + wc * 32 + 8 * fq;
        float rs[2][4]; load_rs8(ss, row0, rs);
#pragma unroll
        for (int ai = 0; ai < 2; ++ai)
#pragma unroll
            for (int m = 0; m < 4; ++m) { const int row = row0 + ai * HALF + m * 16; const float r = rs[ai][m];
                f32x4 o0, o1;
#pragma unroll
                for (int e = 0; e < 4; ++e) { o0[e] = fast_silu(acc[ai][0][m][0][e] * r) * (acc[ai][1][m][0][e] * r); o1[e] = fast_silu(acc[ai][0][m][1][e] * r) * (acc[ai][1][m][1][e] * r); }
                *(u32x4*)(ACT + (size_t)row * FFN + col0) = pack8(o0, o1); }
    }
};
struct EpiKVB {
    const float* ss; const float* knorm; const float* qnorm; const float* mqn; const float* cs; const float* sn; bf16_t* KR; bf16_t* VS; bf16_t* QG; bf16_t* MQ;
    __device__ __forceinline__ void operator()(const Acc& acc, const Unit& u, int wr, int wc, int fr, int fq, LAS unsigned char* lds) const {
        const int row0 = u.pm * BM + wr * 64 + fr, pn = u.pn;
        float rs[2][4]; load_rs8(ss, row0, rs);
        if (pn == 15) {
            f32x4 gn[4]; load_gain64(mqn, fq, gn);
#pragma unroll
            for (int ai = 0; ai < 2; ++ai)
#pragma unroll
                for (int m = 0; m < 4; ++m) { const int row = row0 + ai * HALF + m * 16;
                    head64_store(acc[ai][0][m][0], acc[ai][0][m][1], acc[ai][1][m][0], acc[ai][1][m][1], rs[ai][m], gn, 0.125f * LOG2E, MQ + (size_t)row * MW + 64 * wc, fq); }
            return;
        }
        if (pn >= 3) {
            char* dstb = (char*)(KR + (size_t)(pn / 3) * ((size_t)T * AW));
            const unsigned o0 = (unsigned)(row0 * AW + (pn % 3) * 256 + wc * 32 + 8 * fq) * 2u;
#pragma unroll
            for (int ai = 0; ai < 2; ++ai)
#pragma unroll
                for (int m = 0; m < 4; ++m) { const float r = rs[ai][m];
#pragma unroll
                    for (int bj = 0; bj < 2; ++bj) *(u32x4*)(dstb + o0 + (unsigned)((ai * HALF + m * 16) * AW + bj * HALF) * 2u) = pack8(acc[ai][bj][m][0] * r, acc[ai][bj][m][1] * r); }
            return;
        }
        LAS float* P = (LAS float*)(lds + XSCR_OFF);
        const int d = 16 * wc + 4 * fq;
        f32x4 co[4], si[4];
#define ROPE_LOAD(ai) do { _Pragma("unroll") for (int m = 0; m < 4; ++m) { const int pos = (row0 + (ai) * HALF + m * 16) & (SEQ - 1); co[m] = *(const f32x4*)(cs + pos * 64 + d); si[m] = *(const f32x4*)(sn + pos * 64 + d); } } while (0)
        ROPE_LOAD(0);
#pragma unroll
        for (int ai = 0; ai < 2; ++ai)
#pragma unroll
            for (int m = 0; m < 4; ++m) { const int rl = ai * HALF + wr * 64 + m * 16 + fr; const float r = rs[ai][m];
#pragma unroll
                for (int bj = 0; bj < 2; ++bj) { const f32x4 a = acc[ai][bj][m][0] * r, b = acc[ai][bj][m][1] * r; float s = 0.f;
#pragma unroll
                    for (int e = 0; e < 4; ++e) s += a[e] * a[e] + b[e] * b[e];
                    s = xrow_sum(s);
                    if (fq == 0) P[(rl * 2 + bj) * 4 + wc] = s; } }
        asm volatile("s_waitcnt lgkmcnt(0)" ::: "memory"); __builtin_amdgcn_s_barrier(); asm volatile("" ::: "memory");
        const int hp = pn; const float* gn = knorm; const float sc = 1.f; bf16_t* dstb = KR;
        const f32x4 g1 = *(const f32x4*)(gn + d), g2 = *(const f32x4*)(gn + 64 + d);
#pragma unroll
        for (int ai = 0; ai < 2; ++ai)
#pragma unroll
            for (int m = 0; m < 4; ++m) { const int rl = ai * HALF + wr * 64 + m * 16 + fr, row = u.pm * BM + rl; const float r = rs[ai][m];
                if (ai == 1 && m == 0) { asm volatile("" ::: "memory"); ROPE_LOAD(1); }
#pragma unroll
                for (int bj = 0; bj < 2; ++bj) { const f32x4 pp = *(const LAS f32x4*)(P + (rl * 2 + bj) * 4);
                    const float r2 = __builtin_amdgcn_rsqf(((pp[0] + pp[1]) + (pp[2] + pp[3])) * (1.f / 128.f) + EPS) * r * sc;
                    const f32x4 y1 = acc[ai][bj][m][0] * g1 * r2, y2 = acc[ai][bj][m][1] * g2 * r2;
                    const f32x4 o1 = y1 * co[m] - y2 * si[m], o2 = y2 * co[m] + y1 * si[m];
                    bf16_t* dst = dstb + (size_t)row * AW + (2 * hp + bj) * 128 + d;
                    u32x2 w1, w2; w1.x = cvt_pk_bf16(o1[0], o1[1]); w1.y = cvt_pk_bf16(o1[2], o1[3]); w2.x = cvt_pk_bf16(o2[0], o2[1]); w2.y = cvt_pk_bf16(o2[2], o2[3]);
                    *(u32x2*)dst = w1; *(u32x2*)(dst + 64) = w2; } }
#undef ROPE_LOAD
    }
};
}


typedef short s16x4 __attribute__((ext_vector_type(4)));
__device__ __forceinline__ unsigned off_b(unsigned row, unsigned ch) { return 256u * row + 16u * (ch ^ (((row & 3) << 2) | ((row >> 2) & 3))); }
__device__ __forceinline__ unsigned off_k(unsigned row, unsigned ch) { return 256u * row + 16u * (ch ^ (row & 15)); }
__device__ __forceinline__ unsigned rowrdk(unsigned lane, unsigned rb, unsigned s) { return off_k((lane & 15) + 16 * rb, 4 * s + (lane >> 4)); }
__device__ __forceinline__ unsigned rowrd16(unsigned lane, unsigned rb, unsigned s) { return off_b((lane & 15) + 16 * rb, 4 * s + (lane >> 4)); }
__device__ __forceinline__ unsigned trrd(unsigned lane, unsigned rowbase, unsigned c) { const unsigned q = (lane & 15) >> 2, p = lane & 3; return off_b(rowbase + q, 2 * c + (p >> 1)) + 8 * (p & 1); }
__device__ __forceinline__ unsigned off_v(unsigned row, unsigned ch) { return 256u * row + 16u * (ch ^ (2u * (row & 7u))); }
__device__ __forceinline__ unsigned trrd_v(unsigned lane, unsigned rowbase, unsigned c) { const unsigned q = (lane & 15) >> 2, p = lane & 3; return off_v(rowbase + q, 2 * c + (p >> 1)) + 8 * (p & 1); }
__device__ __forceinline__ unsigned off_h(unsigned row, unsigned ch) { return 128u * row + 16u * (ch ^ ((row >> 1) & 7)); }
__device__ __forceinline__ s16x4 tr_read(LAS unsigned char* p) { return __builtin_bit_cast(s16x4, __builtin_amdgcn_ds_read_tr16_b64_v4i16((LAS s16x4*)p)); }
__device__ __forceinline__ bf16x8 cat8(s16x4 lo, s16x4 hi) { return (bf16x8){lo[0], lo[1], lo[2], lo[3], hi[0], hi[1], hi[2], hi[3]}; }
#define MFMA16(a, b, c) __builtin_amdgcn_mfma_f32_16x16x32_bf16(a, b, c, 0, 0, 0)
#define LDS_BARRIER() do { asm volatile("s_waitcnt vmcnt(0) lgkmcnt(0)" ::: "memory"); __builtin_amdgcn_s_barrier(); asm volatile("" ::: "memory"); } while (0)

template <int NT, int NDT>
__device__ __forceinline__ float attn_softmax_pv(LAS unsigned char* Vimg, f32x4 (&st)[NT], int t0, int lane, f32x4 (&o)[NDT], float& mx_out) {
    const int g = lane >> 4;
    float mx = -1e30f;
#pragma unroll
    for (int i = 0; i < NT; ++i)
#pragma unroll
        for (int e = 0; e < 4; ++e) mx = fmaxf(mx, st[i][e]);
    mx = xrow_max(mx);
    float l = 0.f;
#pragma unroll
    for (int i = 0; i < NT; ++i)
#pragma unroll
        for (int e = 0; e < 4; ++e) { const float p = __builtin_amdgcn_exp2f(st[i][e] - mx); st[i][e] = p; l += p; }
    l = xrow_sum(l);
    u32x4 pwv[(NT + 1) / 2];
#pragma unroll
    for (int pr = 0; pr < (NT + 1) / 2; ++pr) { const bool has1 = (2 * pr + 1 < NT);
        pwv[pr].x = cvt_pk_bf16(st[2 * pr][0], st[2 * pr][1]); pwv[pr].y = cvt_pk_bf16(st[2 * pr][2], st[2 * pr][3]);
        if (has1) { pwv[pr].z = cvt_pk_bf16(st[has1 ? 2 * pr + 1 : 0][0], st[has1 ? 2 * pr + 1 : 0][1]); pwv[pr].w = cvt_pk_bf16(st[has1 ? 2 * pr + 1 : 0][2], st[has1 ? 2 * pr + 1 : 0][3]); } else { pwv[pr].z = 0u; pwv[pr].w = 0u; } }
#pragma unroll
    for (int dt = 0; dt < NDT; ++dt) o[dt] = (f32x4){0.f, 0.f, 0.f, 0.f};
    s16x4 vlo[2][NDT], vhi[2][NDT];
#define ATT_VLOAD(buf, pr_) do { const int T0_ = t0 + 2 * (pr_); int T1_ = T0_ + 1; if (T1_ > 15) T1_ = 15; \
        _Pragma("unroll") for (int dt = 0; dt < NDT; ++dt) { vlo[buf][dt] = tr_read(Vimg + trrd_v(lane, 16 * T0_ + 4 * g, dt)); vhi[buf][dt] = tr_read(Vimg + trrd_v(lane, 16 * T1_ + 4 * g, dt)); } } while (0)
    ATT_VLOAD(0, 0);
#pragma unroll
    for (int pr = 0; pr < (NT + 1) / 2; ++pr) {
        if (pr + 1 < (NT + 1) / 2) ATT_VLOAD((pr + 1) & 1, pr + 1);
        const bf16x8 pb = __builtin_bit_cast(bf16x8, pwv[pr]);
#pragma unroll
        for (int dt = 0; dt < NDT; ++dt) o[dt] = MFMA16(cat8(vlo[pr & 1][dt], vhi[pr & 1][dt]), pb, o[dt]);
    }
#undef ATT_VLOAD
    mx_out = mx;
    return l;
}

struct DilGeo { int b, h, grp, dil, r, m0; };
__device__ __forceinline__ DilGeo dil_geo(int u) { DilGeo q; const int bh = u / 96, v = u % 96, vv = v & 31; q.b = bh / NH; q.h = bh % NH; q.grp = v >> 5; q.dil = q.grp == 0 ? 1 : (q.grp == 1 ? 4 : 16);
    const int nbk = 32 >> (2 * q.grp); q.r = vv / nbk; q.m0 = 128 * (vv % nbk); return q; }
template <int I0>
__device__ __forceinline__ void dil_issue_kv(int u, const bf16_t* KR, const bf16_t* VS, int tid, u32x4 (&kvr)[16]) {
    const DilGeo q = dil_geo(u);
#pragma unroll
    for (int i = I0; i < 8; ++i) { const int idx = i * 512 + tid, row = idx >> 4, ch = idx & 15; int m = q.m0 - 128 + row; if (m < 0) m = 0;
        const size_t go = ((size_t)(q.b * SEQ + m * q.dil + q.r)) * AW + q.h * 128 + ch * 8;
        kvr[i] = *(const u32x4*)(KR + go); kvr[8 + i] = *(const u32x4*)(VS + go); }
}
__device__ __forceinline__ bool dil_cont(int u) { const int v = u % 96, grp = v >> 5, vv = v & 31, nbk = 32 >> (2 * grp); return (vv & (nbk - 1)) != 0; }
__device__ __forceinline__ void dil_issue_q(int u, const bf16_t* QG, int tid, bf16x8 (&qf)[4]) {
    const DilGeo q = dil_geo(u); const int lane = tid & 63, w = tid >> 6, g = lane >> 4, lq = lane & 15;
    const size_t qrow = (size_t)(q.b * SEQ + (q.m0 + 16 * w + lq) * q.dil + q.r);
    const bf16_t* qp = QG + ((size_t)q.grp * T + qrow) * AW + q.h * 128;
#pragma unroll
    for (int s = 0; s < 4; ++s) qf[s] = *(const bf16x8*)(qp + 32 * s + 8 * g);
}
__device__ __forceinline__ void q_norm_rope(const bf16x8 (&qn)[4], const unsigned* csh  , int pos, const LAS float* gq  , int g, bf16x8 (&qc)[4]) {
    float x[4][8]; float ss = 0.f;
#pragma unroll
    for (int s = 0; s < 4; ++s)
#pragma unroll
        for (int j = 0; j < 8; ++j) { x[s][j] = bf2f((bf16_t)qn[s][j]); ss += x[s][j] * x[s][j]; }
    ss = xrow_sum(ss);
    const float r = __builtin_amdgcn_rsqf(ss * (1.f / 128.f) + EPS) * (0.08838834764831845f * LOG2E);
#pragma unroll
    for (int s = 0; s < 4; ++s) { const f32x4 ga = *(const LAS f32x4*)(gq + 32 * s + 8 * g), gb = *(const LAS f32x4*)(gq + 32 * s + 8 * g + 4);
#pragma unroll
        for (int j = 0; j < 8; ++j) x[s][j] *= (j < 4 ? ga[j & 3] : gb[j & 3]) * r; }
    typedef _Float16 h2_t __attribute__((ext_vector_type(2)));
#pragma unroll
    for (int s = 0; s < 2; ++s) { unsigned w1[4], w2[4];
#pragma unroll
        for (int j2 = 0; j2 < 4; ++j2) { float o1[2], o2[2];
#pragma unroll
            for (int k = 0; k < 2; ++k) { const int j = 2 * j2 + k; const h2_t cs2 = __builtin_bit_cast(h2_t, csh[pos * 64 + 32 * s + 8 * g + j]); const float c = (float)cs2[0], sn = (float)cs2[1];
                o1[k] = x[s][j] * c - x[s + 2][j] * sn; o2[k] = x[s + 2][j] * c + x[s][j] * sn; }
            w1[j2] = cvt_pk_bf16(o1[0], o1[1]); w2[j2] = cvt_pk_bf16(o2[0], o2[1]); }
        qc[s] = __builtin_bit_cast(bf16x8, (u32x4){w1[0], w1[1], w1[2], w1[3]}); qc[s + 2] = __builtin_bit_cast(bf16x8, (u32x4){w2[0], w2[1], w2[2], w2[3]}); }
}
__device__ __forceinline__ void dil_stage(LAS unsigned char* lds, int tid, const u32x4 (&kvr)[16]) {
#pragma unroll
    for (int i = 0; i < 8; ++i) { const int idx = i * 512 + tid, row = idx >> 4, ch = idx & 15;
        *(LAS u32x4*)(lds + off_k(row, ch)) = kvr[i]; *(LAS u32x4*)(lds + 65536 + off_v(row, ch)) = kvr[8 + i]; }
}
__device__ __forceinline__ void dil_stage_half(LAS unsigned char* lds, int tid, const u32x4 (&kvr)[16]) {
    u32x4 tk[4], tv[4];
#pragma unroll
    for (int i = 4; i < 8; ++i) { const int idx = i * 512 + tid, row = idx >> 4, ch = idx & 15; tk[i - 4] = *(const LAS u32x4*)(lds + off_k(row, ch)); tv[i - 4] = *(const LAS u32x4*)(lds + 65536 + off_v(row, ch)); }
#pragma unroll
    for (int i = 4; i < 8; ++i) { const int idx = i * 512 + tid, row = idx >> 4, ch = idx & 15;
        *(LAS u32x4*)(lds + off_k(row, ch) - 32768) = tk[i - 4]; *(LAS u32x4*)(lds + 65536 + off_v(row, ch) - 32768) = tv[i - 4];
        *(LAS u32x4*)(lds + off_k(row, ch)) = kvr[i]; *(LAS u32x4*)(lds + 65536 + off_v(row, ch)) = kvr[8 + i]; }
}
__device__ __forceinline__ void dil_compute(LAS unsigned char* lds, int u, const bf16x8 (&qf)[4], bf16_t* QG, float* LSE, int tid, int unext, bf16x8 (&qn)[4]) {
    LAS unsigned char* Kimg = lds; LAS unsigned char* Vimg = lds + 65536;
    const DilGeo q = dil_geo(u); const int lane = tid & 63, w = __builtin_amdgcn_readfirstlane(tid >> 6), g = lane >> 4, lq = lane & 15;
    const size_t qrow = (size_t)(q.b * SEQ + (q.m0 + 16 * w + lq) * q.dil + q.r);
    bf16_t* qp = QG + ((size_t)q.grp * T + qrow) * AW + q.h * 128;
    f32x4 st[9];
    bf16x8 kf[2][4];
#pragma unroll
    for (int s = 0; s < 4; ++s) kf[0][s] = *(const LAS bf16x8*)(Kimg + rowrdk(lane, w, s));
#pragma unroll
    for (int i = 0; i < 9; ++i) { const int tile = w + i; f32x4 acc = (f32x4){0.f, 0.f, 0.f, 0.f};
        if (i + 1 < 9) {
#pragma unroll
            for (int s = 0; s < 4; ++s) kf[(i + 1) & 1][s] = *(const LAS bf16x8*)(Kimg + rowrdk(lane, tile + 1, s)); }
#pragma unroll
        for (int s = 0; s < 4; ++s) acc = MFMA16(kf[i & 1][s], qf[s], acc);
        if (i == 0 || i == 8 || q.m0 == 0) {
#pragma unroll
            for (int e = 0; e < 4; ++e) { const int kk = 16 * tile + 4 * g + e, dist = 128 + 16 * w + lq - kk; const bool ok = dist >= 0 && dist <= 128 && (q.m0 - 128 + kk) >= 0; st[i][e] = ok ? acc[e] : -1e30f; }
        } else st[i] = acc; }
    dil_issue_q(unext, QG, tid, qn);
    f32x4 o[8]; float mx;
    const float l = attn_softmax_pv<9, 8>(Vimg, st, w, lane, o, mx);
    const float inv = __builtin_amdgcn_rcpf(l);
    { LAS unsigned char* ost = lds + OST_OFF + w * 2048; const int rr = lane >> 3, kk = lane & 7;
#pragma unroll
      for (int hf = 0; hf < 2; ++hf) {
#pragma unroll
        for (int d4 = 0; d4 < 4; ++d4) { const int dt = hf * 4 + d4; u32x2 ow; ow.x = cvt_pk_bf16(o[dt][0] * inv, o[dt][1] * inv); ow.y = cvt_pk_bf16(o[dt][2] * inv, o[dt][3] * inv);
            *(LAS u32x2*)(ost + lq * 128 + (((d4 * 4 + g) ^ (lq & 14)) * 8)) = ow; }
#pragma unroll
        for (int i = 0; i < 2; ++i) { const int r = rr + 8 * i; const u32x4 v = *(const LAS u32x4*)(ost + r * 128 + ((kk ^ ((r >> 1) & 7)) * 16));
            const size_t row = (size_t)(q.b * SEQ + (q.m0 + 16 * w + r) * q.dil + q.r);
            *(u32x4*)(QG + ((size_t)q.grp * T + row) * AW + q.h * 128 + hf * 64 + kk * 8) = v; } } }
    if (g == 0) LSE[((size_t)q.grp * T + qrow) * NH + q.h] = mx + __builtin_amdgcn_logf(l);
}
__device__ __forceinline__ void mem_issue_kv(int u, const bf16_t* MKl, const bf16_t* MVl, int tid, u32x4 (&kvr)[16]) {
    const int b = u >> 7, hd = (u >> 5) & 3;
#pragma unroll
    for (int i = 0; i < 4; ++i) { const int idx = i * 512 + tid, row = idx >> 3, ch = idx & 7;
        const size_t go = ((size_t)(b * MEMT + row)) * MW + hd * 64 + ch * 8;
        kvr[i] = *(const u32x4*)(MKl + go); kvr[8 + i] = *(const u32x4*)(MVl + go); }
}
__device__ __forceinline__ void mem_issue_q(int u, const bf16_t* MQ, int tid, bf16x8 (&qf)[4]) {
    const int lane = tid & 63, w = tid >> 6, g = lane >> 4, lq = lane & 15; const int b = u >> 7, hd = (u >> 5) & 3, qblk = u & 31;
    const bf16_t* qp = MQ + (size_t)(b * SEQ + 128 * qblk + 16 * w + lq) * MW + hd * 64;
#pragma unroll
    for (int s = 0; s < 2; ++s) qf[s] = *(const bf16x8*)(qp + 32 * s + 8 * g);
}
__device__ __forceinline__ void mem_stage(LAS unsigned char* lds, int tid, const u32x4 (&kvr)[16]) {
#pragma unroll
    for (int i = 0; i < 4; ++i) { const int idx = i * 512 + tid, row = idx >> 3, ch = idx & 7;
        *(LAS u32x4*)(lds + off_k(row, ch)) = kvr[i]; *(LAS u32x4*)(lds + 65536 + off_v(row, ch)) = kvr[8 + i]; }
}
__device__ __forceinline__ void mem_compute(LAS unsigned char* lds, int u, const bf16x8 (&qf)[4], bf16_t* MIX, int tid) {
    LAS unsigned char* Kimg = lds; LAS unsigned char* Vimg = lds + 65536;
    const int lane = tid & 63, w = __builtin_amdgcn_readfirstlane(tid >> 6), g = lane >> 4, lq = lane & 15; const int b = u >> 7, hd = (u >> 5) & 3, qblk = u & 31;
    const size_t qrow = (size_t)(b * SEQ + 128 * qblk + 16 * w + lq);
    f32x4 st[16];
#pragma unroll
    for (int i = 0; i < 16; ++i) { f32x4 acc = (f32x4){0.f, 0.f, 0.f, 0.f};
#pragma unroll
        for (int s = 0; s < 2; ++s) acc = MFMA16(*(const LAS bf16x8*)(Kimg + rowrdk(lane, i, s)), qf[s], acc);
        st[i] = acc; }
    f32x4 o[4]; float mx;
    const float l = attn_softmax_pv<16, 4>(Vimg, st, 0, lane, o, mx);
    const float inv = __builtin_amdgcn_rcpf(l);
    { LAS unsigned char* ost = lds + OST_OFF + w * 2048; const int rr = lane >> 3, kk = lane & 7;
#pragma unroll
      for (int dt = 0; dt < 4; ++dt) { u32x2 ow; ow.x = cvt_pk_bf16(o[dt][0] * inv, o[dt][1] * inv); ow.y = cvt_pk_bf16(o[dt][2] * inv, o[dt][3] * inv);
          *(LAS u32x2*)(ost + lq * 128 + (((dt * 4 + g) ^ (lq & 14)) * 8)) = ow; }
#pragma unroll
      for (int i = 0; i < 2; ++i) { const int r = rr + 8 * i; const u32x4 v = *(const LAS u32x4*)(ost + r * 128 + ((kk ^ ((r >> 1) & 7)) * 16));
          *(u32x4*)(MIX + (size_t)(b * SEQ + 128 * qblk + 16 * w + r) * DM + AW + hd * 64 + kk * 8) = v; } }
}
__device__ __forceinline__ void dil_run(LAS unsigned char* lds, int n, int u0, const bf16_t* KR, const bf16_t* VS, bf16_t* QG, float* LSE, const unsigned* CSH, const float* qnorm, int tid0) {
    const int tid = tid0;
    u32x4 kvr[16]; bf16x8 qn[4], qc[4];
    LAS float* GQ = (LAS float*)(lds + XSCR_OFF);
    if (tid < 384) GQ[tid] = qnorm[tid];
    const int g = (tid & 63) >> 4;
    dil_issue_kv<0>(u0, KR, VS, tid, kvr); dil_issue_q(u0, QG, tid, qn);
#pragma unroll 1
    for (int j = 0; j < n; ++j) {
        dil_stage(lds, tid, kvr);
        if (j == 0) LDS_BARRIER();
        { const DilGeo qq = dil_geo(u0 + j); const int pos = (qq.m0 + 16 * (tid >> 6) + (tid & 15)) * qq.dil + qq.r;
          q_norm_rope(qn, CSH, pos, GQ + 128 * qq.grp, g, qc); }
        LDS_BARRIER();
        const int un = u0 + (j + 1 < n ? j + 1 : j);
        dil_issue_kv<0>(un, KR, VS, tid, kvr);
        dil_compute(lds, u0 + j, qc, QG, LSE, tid, un, qn);
        asm volatile("s_waitcnt lgkmcnt(0)" ::: "memory"); __builtin_amdgcn_s_barrier(); asm volatile("" ::: "memory");
    }
}
__device__ __forceinline__ void mem_run(LAS unsigned char* lds, int n, int u0, const bf16_t* MQ, const bf16_t* MKl, const bf16_t* MVl, bf16_t* MIX, int tid0) {
    const int tid = tid0;
    u32x4 kvr[16]; bf16x8 qn[4], qc[4];
    mem_issue_kv(u0, MKl, MVl, tid, kvr); mem_issue_q(u0, MQ, tid, qn);
#pragma unroll 1
    for (int j = 0; j < n; ++j) { const int u = u0 + j;
        const bool fresh = (j == 0) || ((u & 31) == 0);
        if (fresh) mem_stage(lds, tid, kvr);
#pragma unroll
        for (int s = 0; s < 2; ++s) qc[s] = qn[s];
        if (fresh) LDS_BARRIER();
        const bool has_next = j + 1 < n; const int un = has_next ? u + 1 : u; const bool nfresh = has_next && ((un & 31) == 0);
        mem_issue_q(un, MQ, tid, qn);
        if (nfresh) mem_issue_kv(un, MKl, MVl, tid, kvr);
        mem_compute(lds, u, qc, MIX, tid);
        if (nfresh || !has_next) { asm volatile("s_waitcnt lgkmcnt(0)" ::: "memory"); __builtin_amdgcn_s_barrier(); asm volatile("" ::: "memory"); }
    }
}

constexpr int HG_UNITS = BATCH * NH * (SEQ / 64);
__device__ __forceinline__ void hg_cumsum(LAS float* tot, const unsigned short (&lfh)[16], int tid, float (&lf)[16], float (&bc)[16], float& bend) {
    const int d = tid & 127, rg = tid >> 7;
    float c = 0.f;
#pragma unroll
    for (int i = 0; i < 16; ++i) { lf[i] = (float)__builtin_bit_cast(_Float16, lfh[i]); c += lf[i]; bc[i] = c; }
    tot[rg * 128 + d] = c;
    asm volatile("s_waitcnt lgkmcnt(0)" ::: "memory"); __builtin_amdgcn_s_barrier(); asm volatile("" ::: "memory");
    const float t0 = tot[d], t1 = tot[128 + d], t2 = tot[256 + d], t3 = tot[384 + d];
    const float pre = rg == 0 ? 0.f : (rg == 1 ? t0 : (rg == 2 ? t0 + t1 : t0 + t1 + t2));
    bend = (t0 + t1) + (t2 + t3);
#pragma unroll
    for (int i = 0; i < 16; ++i) bc[i] += pre;
}
__device__ __forceinline__ float ex(float v) { return __builtin_amdgcn_exp2f(v * LOG2E); }
#define WAVE_BARRIER_LDS() do { asm volatile("s_waitcnt lgkmcnt(0)" ::: "memory"); __builtin_amdgcn_s_barrier(); asm volatile("" ::: "memory"); } while (0)
struct HgALoads { unsigned short lfh[16]; u32x4 v[2]; };
__device__ __forceinline__ void hgA_issue(int u, const unsigned short* LF, const bf16_t* VV, int tid, HgALoads& R) {
    const int bh = u >> 6, c = u & 63, b = bh / NH, h = bh % NH; const size_t rowbase = (size_t)b * SEQ + 64 * c; const int d = tid & 127, rg = tid >> 7;
#pragma unroll
    for (int i = 0; i < 16; ++i) R.lfh[i] = LF[(rowbase + 16 * rg + i) * AW + h * 128 + d];
#pragma unroll
    for (int i = 0; i < 2; ++i) { const int idx = i * 512 + tid, row = idx >> 4, ch = idx & 15; R.v[i] = *(const u32x4*)(VV + (rowbase + row) * AW + h * 128 + ch * 8); }
}
__device__ __forceinline__ void hgA_run(LAS unsigned char* lds, int n, int u0, const unsigned short* LF, const bf16_t* VV, bf16_t* DS, float* DEC, int tid) {
    LAS unsigned char* KT = lds;
    LAS unsigned char* Vimg = lds + 16384;
    LAS float* tot = (LAS float*)(lds + 32768);
    const int lane = tid & 63, w = __builtin_amdgcn_readfirstlane(tid >> 6), g = lane >> 4, d = tid & 127, rg = tid >> 7;
    HgALoads R; hgA_issue(u0, LF, VV, tid, R);
#pragma unroll 1
    for (int j = 0; j < n; ++j) { const int u = u0 + j;
        float lf[16], bc[16], bend;
        hg_cumsum(tot, R.lfh, tid, lf, bc, bend);
        { u32x4 w0, w1; float ko[16];
#pragma unroll
          for (int i = 0; i < 16; ++i) ko[i] = (1.f - ex(lf[i])) * ex(bend - bc[i]);
          w0.x = cvt_pk_bf16(ko[0], ko[1]); w0.y = cvt_pk_bf16(ko[2], ko[3]); w0.z = cvt_pk_bf16(ko[4], ko[5]); w0.w = cvt_pk_bf16(ko[6], ko[7]);
          w1.x = cvt_pk_bf16(ko[8], ko[9]); w1.y = cvt_pk_bf16(ko[10], ko[11]); w1.z = cvt_pk_bf16(ko[12], ko[13]); w1.w = cvt_pk_bf16(ko[14], ko[15]);
          *(LAS u32x4*)(KT + off_h(d, 2 * rg)) = w0; *(LAS u32x4*)(KT + off_h(d, 2 * rg + 1)) = w1;
          if (rg == 0) DEC[(size_t)u * 128 + d] = ex(bend); }
#pragma unroll
        for (int i = 0; i < 2; ++i) { const int idx = i * 512 + tid, row = idx >> 4, ch = idx & 15; *(LAS u32x4*)(Vimg + off_b(row, ch)) = R.v[i]; }
        WAVE_BARRIER_LDS();
        hgA_issue(u0 + (j + 1 < n ? j + 1 : j), LF, VV, tid, R);
        bf16x8 af[2];
#pragma unroll
        for (int ks = 0; ks < 2; ++ks) af[ks] = *(const LAS bf16x8*)(KT + off_h(16 * w + (lane & 15), 4 * ks + g));
        bf16_t* dsu = DS + (size_t)u * 16384;
#pragma unroll
        for (int jt = 0; jt < 8; ++jt) { f32x4 acc = (f32x4){0.f, 0.f, 0.f, 0.f};
#pragma unroll
            for (int ks = 0; ks < 2; ++ks) { const s16x4 lo = tr_read(Vimg + trrd(lane, 32 * ks + 8 * g, jt)), hi = tr_read(Vimg + trrd(lane, 32 * ks + 8 * g + 4, jt));
                acc = MFMA16(af[ks], cat8(lo, hi), acc); }
            u32x2 ow; ow.x = cvt_pk_bf16(acc[0], acc[1]); ow.y = cvt_pk_bf16(acc[2], acc[3]);
            *(u32x2*)(dsu + (size_t)(16 * jt + (lane & 15)) * 128 + 16 * w + 4 * g) = ow; }
        WAVE_BARRIER_LDS();
    }
}
__device__ __forceinline__ void hgB_item(int it, bf16_t* DS, const float* DEC) {
    const int bh = it >> 11, e8 = it & 2047;
    const int dk0 = 8 * (e8 & 15);
    float S[8];
#pragma unroll
    for (int i = 0; i < 8; ++i) S[i] = 0.f;
#pragma unroll 4
    for (int c = 0; c < 64; ++c) { const size_t un = (size_t)(bh * 64 + c);
        u32x4* p = (u32x4*)(DS + un * 16384 + (size_t)e8 * 8);
        const u32x4 dsv = *p; const f32x4 d0 = *(const f32x4*)(DEC + un * 128 + dk0), d1 = *(const f32x4*)(DEC + un * 128 + dk0 + 4);
        u32x4 o; o.x = cvt_pk_bf16(S[0], S[1]); o.y = cvt_pk_bf16(S[2], S[3]); o.z = cvt_pk_bf16(S[4], S[5]); o.w = cvt_pk_bf16(S[6], S[7]);
        *p = o;
        const unsigned wv[4] = {dsv.x, dsv.y, dsv.z, dsv.w};
#pragma unroll
        for (int i = 0; i < 4; ++i) { const float dl = (i < 2 ? d0 : d1)[(2 * i) & 3], dh = (i < 2 ? d0 : d1)[(2 * i + 1) & 3];
            S[2 * i] = dl * S[2 * i] + __uint_as_float(wv[i] << 16); S[2 * i + 1] = dh * S[2 * i + 1] + __uint_as_float(wv[i] & 0xffff0000u); } }
}
struct HgCLoads { unsigned short lfh[16], qs[16], sg[16]; u32x4 v[2], st[4]; };
__device__ __forceinline__ void hgC_issue(int u, const unsigned short* LF, const bf16_t* QS, const bf16_t* VV, const bf16_t* SG, const bf16_t* SP, int tid, HgCLoads& R) {
    const int bh = u >> 6, c = u & 63, b = bh / NH, h = bh % NH; const size_t rowbase = (size_t)b * SEQ + 64 * c; const int d = tid & 127, rg = tid >> 7;
    const int lane = tid & 63, w = tid >> 6, g = lane >> 4, lq = lane & 15, ti = w & 3, jh = w >> 2;
#pragma unroll
    for (int i = 0; i < 16; ++i) { const size_t o = (rowbase + 16 * rg + i) * AW + h * 128 + d; R.lfh[i] = LF[o]; R.qs[i] = QS[o]; }
#pragma unroll
    for (int i = 0; i < 2; ++i) { const int idx = i * 512 + tid, row = idx >> 4, ch = idx & 15; R.v[i] = *(const u32x4*)(VV + (rowbase + row) * AW + h * 128 + ch * 8); }
#pragma unroll
    for (int i = 0; i < 4; ++i) { const int idx = i * 512 + tid, row = idx >> 4, ch = idx & 15; R.st[i] = *(const u32x4*)(SP + (size_t)u * 16384 + row * 128 + ch * 8); }
#pragma unroll
    for (int e = 0; e < 4; ++e)
#pragma unroll
        for (int jj = 0; jj < 4; ++jj) R.sg[e * 4 + jj] = SG[(rowbase + 16 * ti + 4 * g + e) * AW + h * 128 + 16 * (4 * jh + jj) + lq];
}
__device__ __forceinline__ void hgC_run(LAS unsigned char* lds, int n, int u0, const unsigned short* LF, const bf16_t* QS, const bf16_t* VV, const bf16_t* SG, const bf16_t* SP, const float* onorm, bf16_t* MIX, int tid) {
    LAS unsigned char* QI = lds;
    LAS unsigned char* KI = lds + 16384;
    LAS unsigned char* Vimg = lds + 32768;
    LAS unsigned char* STi = lds + 49152;
    LAS unsigned char* AT = lds + 81920;
    LAS float* tot = (LAS float*)(lds + 90112);
    LAS float* red = (LAS float*)(lds + 92160);
    const int lane = tid & 63, w = __builtin_amdgcn_readfirstlane(tid >> 6), g = lane >> 4, lq = lane & 15, d = tid & 127, rg = tid >> 7, ti = w & 3, jh = w >> 2;
    HgCLoads R; hgC_issue(u0, LF, QS, VV, SG, SP, tid, R);
#pragma unroll 1
    for (int j = 0; j < n; ++j) { const int u = u0 + j; const int bh = u >> 6, c = u & 63, b = bh / NH, h = bh % NH; const size_t rowbase = (size_t)b * SEQ + 64 * c;
        float lf[16], bc[16], bend;
        hg_cumsum(tot, R.lfh, tid, lf, bc, bend);
#pragma unroll
        for (int i = 0; i < 16; ++i) { const int t = 16 * rg + i; const float q = bf2f(R.qs[i]); const float eb = ex(bc[i]);
            const unsigned a = off_b(t, d >> 3) + (d & 7) * 2;
            *(LAS bf16_t*)(QI + a) = (bf16_t)(cvt_pk_bf16(q * eb, 0.f) & 0xffffu);
            *(LAS bf16_t*)(KI + a) = (bf16_t)(cvt_pk_bf16((1.f - ex(lf[i])) * __builtin_amdgcn_rcpf(eb), 0.f) & 0xffffu); }
#pragma unroll
        for (int i = 0; i < 2; ++i) { const int idx = i * 512 + tid, row = idx >> 4, ch = idx & 15; *(LAS u32x4*)(Vimg + off_b(row, ch)) = R.v[i]; }
#pragma unroll
        for (int i = 0; i < 4; ++i) { const int idx = i * 512 + tid, row = idx >> 4, ch = idx & 15; *(LAS u32x4*)(STi + off_b(row, ch)) = R.st[i]; }
        float sgc[16];
#pragma unroll
        for (int i = 0; i < 16; ++i) sgc[i] = bf2f(R.sg[i]);
        WAVE_BARRIER_LDS();
        hgC_issue(u0 + (j + 1 < n ? j + 1 : j), LF, QS, VV, SG, SP, tid, R);
#pragma unroll
        for (int k2 = 0; k2 < 2; ++k2) { const int si = 2 * jh + k2; f32x4 acc = (f32x4){0.f, 0.f, 0.f, 0.f};
            if (si <= ti) {
#pragma unroll
                for (int s = 0; s < 4; ++s) acc = MFMA16(*(const LAS bf16x8*)(KI + rowrd16(lane, si, s)), *(const LAS bf16x8*)(QI + rowrd16(lane, ti, s)), acc);
            }
            const int t = 16 * ti + lq, s0 = 16 * si + 4 * g;
            u32x2 ow; ow.x = cvt_pk_bf16(s0 <= t ? acc[0] : 0.f, s0 + 1 <= t ? acc[1] : 0.f); ow.y = cvt_pk_bf16(s0 + 2 <= t ? acc[2] : 0.f, s0 + 3 <= t ? acc[3] : 0.f);
            *(LAS u32x2*)(AT + off_h(t, s0 >> 3) + (s0 & 7) * 2) = ow; }
        WAVE_BARRIER_LDS();
        bf16x8 aq[4], aa[2];
#pragma unroll
        for (int s = 0; s < 4; ++s) aq[s] = *(const LAS bf16x8*)(QI + rowrd16(lane, ti, s));
#pragma unroll
        for (int s = 0; s < 2; ++s) aa[s] = *(const LAS bf16x8*)(AT + off_h(16 * ti + lq, 4 * s + g));
        f32x4 o[4]; float ssq[4] = {0.f, 0.f, 0.f, 0.f};
#pragma unroll
        for (int jj = 0; jj < 4; ++jj) { const int jt = 4 * jh + jj; f32x4 acc = (f32x4){0.f, 0.f, 0.f, 0.f};
#pragma unroll
            for (int s = 0; s < 4; ++s) acc = MFMA16(aq[s], *(const LAS bf16x8*)(STi + rowrd16(lane, jt, s)), acc);
#pragma unroll
            for (int ks = 0; ks < 2; ++ks) { const s16x4 lo = tr_read(Vimg + trrd(lane, 32 * ks + 8 * g, jt)), hi = tr_read(Vimg + trrd(lane, 32 * ks + 8 * g + 4, jt));
                acc = MFMA16(aa[ks], cat8(lo, hi), acc); }
            o[jj] = acc;
#pragma unroll
            for (int e = 0; e < 4; ++e) ssq[e] += acc[e] * acc[e]; }
#pragma unroll
        for (int e = 0; e < 4; ++e) { float sv = ssq[e]; sv += __shfl_xor(sv, 1); sv += __shfl_xor(sv, 2); sv += __shfl_xor(sv, 4); sv += __shfl_xor(sv, 8); ssq[e] = sv; }
        if (lq == 0) {
#pragma unroll
            for (int e = 0; e < 4; ++e) red[(16 * ti + 4 * g + e) * 2 + jh] = ssq[e]; }
        WAVE_BARRIER_LDS();
        f32x4 onv;
#pragma unroll
        for (int jj = 0; jj < 4; ++jj) onv[jj] = onorm[h * 128 + 16 * (4 * jh + jj) + lq];
#pragma unroll
        for (int e = 0; e < 4; ++e) { const int t = 16 * ti + 4 * g + e; const float r2 = __builtin_amdgcn_rsqf((red[t * 2] + red[t * 2 + 1]) * (1.f / 128.f) + EPS);
#pragma unroll
            for (int jj = 0; jj < 4; ++jj) { const int dv = 16 * (4 * jh + jj) + lq;
                MIX[(rowbase + t) * DM + h * 128 + dv] = (bf16_t)(cvt_pk_bf16(o[jj][e] * r2 * onv[jj] * sgc[e * 4 + jj], 0.f) & 0xffffu); } }
        WAVE_BARRIER_LDS();
    }
}

constexpr int HG2_UNITS = BATCH * NH * 4;
__device__ __forceinline__ void hg2A_run(LAS unsigned char* lds, int s, const unsigned short* LF, const bf16_t* VV, float* AGG, float* DTOT, int tid) {
    LAS unsigned char* KT = lds;
    LAS unsigned char* Vimg = lds + 16384;
    LAS float* tot = (LAS float*)(lds + 32768);
    LAS float* dec = (LAS float*)(lds + 34816);
    const int lane = tid & 63, w = __builtin_amdgcn_readfirstlane(tid >> 6), g = lane >> 4, lq = lane & 15, d = tid & 127, rg = tid >> 7;
    const int u0 = (s >> 2) * 64 + (s & 3) * 16;
    f32x4 S[8];
#pragma unroll
    for (int i = 0; i < 8; ++i) S[i] = (f32x4){0.f, 0.f, 0.f, 0.f};
    float dlog = 0.f;
    HgALoads R; hgA_issue(u0, LF, VV, tid, R);
#pragma unroll 1
    for (int j = 0; j < 16; ++j) {
        float lf[16], bc[16], bend;
        hg_cumsum(tot, R.lfh, tid, lf, bc, bend);
        { u32x4 w0, w1; float ko[16];
#pragma unroll
          for (int i = 0; i < 16; ++i) ko[i] = (1.f - ex(lf[i])) * ex(bend - bc[i]);
          w0.x = cvt_pk_bf16(ko[0], ko[1]); w0.y = cvt_pk_bf16(ko[2], ko[3]); w0.z = cvt_pk_bf16(ko[4], ko[5]); w0.w = cvt_pk_bf16(ko[6], ko[7]);
          w1.x = cvt_pk_bf16(ko[8], ko[9]); w1.y = cvt_pk_bf16(ko[10], ko[11]); w1.z = cvt_pk_bf16(ko[12], ko[13]); w1.w = cvt_pk_bf16(ko[14], ko[15]);
          *(LAS u32x4*)(KT + off_h(d, 2 * rg)) = w0; *(LAS u32x4*)(KT + off_h(d, 2 * rg + 1)) = w1;
          if (rg == 0) dec[d] = ex(bend);
          dlog += bend; }
#pragma unroll
        for (int i = 0; i < 2; ++i) { const int idx = i * 512 + tid, row = idx >> 4, ch = idx & 15; *(LAS u32x4*)(Vimg + off_b(row, ch)) = R.v[i]; }
        WAVE_BARRIER_LDS();
        hgA_issue(u0 + (j < 15 ? j + 1 : j), LF, VV, tid, R);
        bf16x8 bv[2];
#pragma unroll
        for (int ks = 0; ks < 2; ++ks) { const s16x4 lo = tr_read(Vimg + trrd(lane, 32 * ks + 8 * g, w)), hi = tr_read(Vimg + trrd(lane, 32 * ks + 8 * g + 4, w)); bv[ks] = cat8(lo, hi); }
        { bf16x8 kt[2][2]; f32x4 dcv[2];
#define HG2_KLOAD(buf, i_) do { dcv[buf] = *(const LAS f32x4*)(dec + 16 * (i_) + 4 * g); _Pragma("unroll") for (int ks = 0; ks < 2; ++ks) kt[buf][ks] = *(const LAS bf16x8*)(KT + off_h(16 * (i_) + lq, 4 * ks + g)); } while (0)
          HG2_KLOAD(0, 0);
#pragma unroll
          for (int i = 0; i < 8; ++i) { if (i + 1 < 8) HG2_KLOAD((i + 1) & 1, i + 1);
              f32x4 a = S[i] * dcv[i & 1];
#pragma unroll
              for (int ks = 0; ks < 2; ++ks) a = MFMA16(kt[i & 1][ks], bv[ks], a);
              S[i] = a; }
#undef HG2_KLOAD
        }
    }
#pragma unroll
    for (int i = 0; i < 8; ++i) *(f32x4*)(AGG + (size_t)s * 16384 + (16 * w + lq) * 128 + 16 * i + 4 * g) = S[i];
    if (rg == 0) DTOT[s * 128 + d] = ex(dlog);
}
struct Hg2CLoads { unsigned short lfh[16], qs[16]; u32x4 v[2], sg[2]; };
__device__ __forceinline__ void hg2C_issue(int u, const unsigned short* LF, const bf16_t* QS, const bf16_t* VV, const bf16_t* SG, int tid, Hg2CLoads& R) {
    const int bh = u >> 6, c = u & 63, b = bh / NH, h = bh % NH; const size_t rowbase = (size_t)b * SEQ + 64 * c; const int d = tid & 127, rg = tid >> 7;
    const int lane = tid & 63, w = tid >> 6, g = lane >> 4, lq = lane & 15;
#pragma unroll
    for (int i = 0; i < 16; ++i) { const size_t o = (rowbase + 16 * rg + i) * AW + h * 128 + d; R.lfh[i] = LF[o]; R.qs[i] = QS[o]; }
#pragma unroll
    for (int i = 0; i < 2; ++i) { const int idx = i * 512 + tid, row = idx >> 4, ch = idx & 15; const size_t o = (rowbase + row) * AW + h * 128 + ch * 8; R.v[i] = *(const u32x4*)(VV + o); R.sg[i] = *(const u32x4*)(SG + o); }
}
__device__ __forceinline__ void hg2C_run(LAS unsigned char* lds, int s, const unsigned short* LF, const bf16_t* QS, const bf16_t* VV, const bf16_t* SG, const float* AGG, const float* DTOT,
                                         const float* onorm, bf16_t* MIX, int tid) {
    LAS unsigned char* QI = lds;
    LAS unsigned char* KI = lds + 16384;
    LAS unsigned char* Vimg = lds + 32768;
    LAS unsigned char* KT = lds + 49152;
    LAS unsigned char* AT = lds + 65536;
    LAS float* tot = (LAS float*)(lds + 73728);
    LAS float* dec = (LAS float*)(lds + 75776);
    LAS float* red = (LAS float*)(lds + 76800);
    LAS unsigned char* OS = lds + 79872;
    const int lane = tid & 63, w = __builtin_amdgcn_readfirstlane(tid >> 6), g = lane >> 4, lq = lane & 15, d = tid & 127, rg = tid >> 7, jh = w >> 2;
    const int bh = s >> 2, sc = s & 3, b = bh / NH, h = bh % NH, u0 = bh * 64 + sc * 16;
    f32x4 S[8];
#pragma unroll
    for (int i = 0; i < 8; ++i) S[i] = (f32x4){0.f, 0.f, 0.f, 0.f};
#pragma unroll 1
    for (int sp = 0; sp < sc; ++sp) { const int s2 = bh * 4 + sp;
#pragma unroll
        for (int i = 0; i < 8; ++i) { const f32x4 dt = *(const f32x4*)(DTOT + s2 * 128 + 16 * i + 4 * g), ag = *(const f32x4*)(AGG + (size_t)s2 * 16384 + (16 * w + lq) * 128 + 16 * i + 4 * g); S[i] = S[i] * dt + ag; } }
    const f32x4 onv0 = *(const f32x4*)(onorm + h * 128 + 8 * (tid & 15)), onv1 = *(const f32x4*)(onorm + h * 128 + 8 * (tid & 15) + 4);
    Hg2CLoads R; hg2C_issue(u0, LF, QS, VV, SG, tid, R);
#pragma unroll 1
    for (int j = 0; j < 16; ++j) { const size_t rowbase = (size_t)b * SEQ + 64 * (sc * 16 + j);
        float lf[16], bc[16], bend;
        hg_cumsum(tot, R.lfh, tid, lf, bc, bend);
        { float ko[16];
#pragma unroll
          for (int i = 0; i < 16; ++i) { const int t = 16 * rg + i; const float q = bf2f(R.qs[i]); const float eb = ex(bc[i]), kk = 1.f - ex(lf[i]);
              const unsigned a = off_k(t, d >> 3) + (d & 7) * 2;
              *(LAS bf16_t*)(QI + a) = (bf16_t)(cvt_pk_bf16(q * eb, 0.f) & 0xffffu);
              *(LAS bf16_t*)(KI + a) = (bf16_t)(cvt_pk_bf16(kk * __builtin_amdgcn_rcpf(eb), 0.f) & 0xffffu);
              ko[i] = kk * ex(bend - bc[i]); }
          u32x4 w0, w1;
          w0.x = cvt_pk_bf16(ko[0], ko[1]); w0.y = cvt_pk_bf16(ko[2], ko[3]); w0.z = cvt_pk_bf16(ko[4], ko[5]); w0.w = cvt_pk_bf16(ko[6], ko[7]);
          w1.x = cvt_pk_bf16(ko[8], ko[9]); w1.y = cvt_pk_bf16(ko[10], ko[11]); w1.z = cvt_pk_bf16(ko[12], ko[13]); w1.w = cvt_pk_bf16(ko[14], ko[15]);
          *(LAS u32x4*)(KT + off_h(d, 2 * rg)) = w0; *(LAS u32x4*)(KT + off_h(d, 2 * rg + 1)) = w1;
          if (rg == 0) dec[d] = ex(bend); }
#pragma unroll
        for (int i = 0; i < 2; ++i) { const int idx = i * 512 + tid, row = idx >> 4, ch = idx & 15; *(LAS u32x4*)(Vimg + off_b(row, ch)) = R.v[i]; }
        const u32x4 sgk0 = R.sg[0], sgk1 = R.sg[1];
        WAVE_BARRIER_LDS();
        hg2C_issue(u0 + (j < 15 ? j + 1 : j), LF, QS, VV, SG, tid, R);
        { const int ti = w & 3;
#pragma unroll
          for (int k2 = 0; k2 < 2; ++k2) { const int si = 2 * jh + k2; f32x4 acc = (f32x4){0.f, 0.f, 0.f, 0.f};
            if (si <= ti) {
#pragma unroll
                for (int q4 = 0; q4 < 4; ++q4) acc = MFMA16(*(const LAS bf16x8*)(KI + rowrdk(lane, si, q4)), *(const LAS bf16x8*)(QI + rowrdk(lane, ti, q4)), acc);
            }
            const int t = 16 * ti + lq, s0 = 16 * si + 4 * g;
            u32x2 ow; ow.x = cvt_pk_bf16(s0 <= t ? acc[0] : 0.f, s0 + 1 <= t ? acc[1] : 0.f); ow.y = cvt_pk_bf16(s0 + 2 <= t ? acc[2] : 0.f, s0 + 3 <= t ? acc[3] : 0.f);
            *(LAS u32x2*)(AT + off_h(t, s0 >> 3) + (s0 & 7) * 2) = ow; } }
        WAVE_BARRIER_LDS();
        bf16x8 bv[2];
#pragma unroll
        for (int ks = 0; ks < 2; ++ks) { const s16x4 lo = tr_read(Vimg + trrd(lane, 32 * ks + 8 * g, w)), hi = tr_read(Vimg + trrd(lane, 32 * ks + 8 * g + 4, w)); bv[ks] = cat8(lo, hi); }
        f32x4 o[4];
        { bf16x8 af[4][2];
#pragma unroll
          for (int ti = 0; ti < 4; ++ti)
#pragma unroll
            for (int ks = 0; ks < 2; ++ks) af[ti][ks] = *(const LAS bf16x8*)(AT + off_h(16 * ti + lq, 4 * ks + g));
          s16x4 ql[2][4], qh[2][4];
#define HG2_QLOAD(buf, kp_) do { _Pragma("unroll") for (int ti = 0; ti < 4; ++ti) { ql[buf][ti] = *(const LAS s16x4*)(QI + off_k(16 * ti + lq, 4 * (kp_) + (g >> 1)) + 8 * (g & 1)); qh[buf][ti] = *(const LAS s16x4*)(QI + off_k(16 * ti + lq, 4 * (kp_) + 2 + (g >> 1)) + 8 * (g & 1)); } } while (0)
          HG2_QLOAD(0, 0);
#pragma unroll
          for (int ti = 0; ti < 4; ++ti) { f32x4 acc = MFMA16(af[ti][0], bv[0], ((f32x4){0.f, 0.f, 0.f, 0.f})); o[ti] = MFMA16(af[ti][1], bv[1], acc); }
#pragma unroll
          for (int kp = 0; kp < 4; ++kp) { if (kp + 1 < 4) HG2_QLOAD((kp + 1) & 1, kp + 1);
              u32x4 pw; pw.x = cvt_pk_bf16(S[2 * kp][0], S[2 * kp][1]); pw.y = cvt_pk_bf16(S[2 * kp][2], S[2 * kp][3]); pw.z = cvt_pk_bf16(S[2 * kp + 1][0], S[2 * kp + 1][1]); pw.w = cvt_pk_bf16(S[2 * kp + 1][2], S[2 * kp + 1][3]);
              const bf16x8 Sb = __builtin_bit_cast(bf16x8, pw);
#pragma unroll
              for (int ti = 0; ti < 4; ++ti) o[ti] = MFMA16(cat8(ql[kp & 1][ti], qh[kp & 1][ti]), Sb, o[ti]); }
#undef HG2_QLOAD
        }
        { bf16x8 kt[2][2]; f32x4 dcv[2];
#define HG2_KLOAD(buf, i_) do { dcv[buf] = *(const LAS f32x4*)(dec + 16 * (i_) + 4 * g); _Pragma("unroll") for (int ks = 0; ks < 2; ++ks) kt[buf][ks] = *(const LAS bf16x8*)(KT + off_h(16 * (i_) + lq, 4 * ks + g)); } while (0)
          HG2_KLOAD(0, 0);
#pragma unroll
          for (int i = 0; i < 8; ++i) { if (i + 1 < 8) HG2_KLOAD((i + 1) & 1, i + 1);
              f32x4 a = S[i] * dcv[i & 1];
#pragma unroll
              for (int ks = 0; ks < 2; ++ks) a = MFMA16(kt[i & 1][ks], bv[ks], a);
              S[i] = a; }
#undef HG2_KLOAD
        }
        { float sv[16];
#pragma unroll
          for (int ti = 0; ti < 4; ++ti)
#pragma unroll
            for (int e = 0; e < 4; ++e) sv[ti * 4 + e] = row16_sum(o[ti][e] * o[ti][e]);
          if (lq == 0) {
#pragma unroll
            for (int ti = 0; ti < 4; ++ti)
#pragma unroll
                for (int e = 0; e < 4; ++e) red[(16 * ti + 4 * g + e) * 8 + w] = sv[ti * 4 + e]; }
#pragma unroll
          for (int ti = 0; ti < 4; ++ti)
#pragma unroll
            for (int e = 0; e < 4; ++e) *(LAS float*)(OS + (16 * ti + 4 * g + e) * 512 + ((w ^ g) * 64) + lq * 4) = o[ti][e]; }
        WAVE_BARRIER_LDS();
#pragma unroll
        for (int i = 0; i < 2; ++i) { const int idx = i * 512 + tid, row = idx >> 4, ch = idx & 15;
            const LAS unsigned char* op = OS + row * 512 + ((((ch >> 1) ^ ((row >> 2) & 3))) * 64) + (ch & 1) * 32;
            const f32x4 v0 = *(const LAS f32x4*)op, v1 = *(const LAS f32x4*)(op + 16);
            const f32x4 p0 = *(const LAS f32x4*)(red + row * 8), p1 = *(const LAS f32x4*)(red + row * 8 + 4);
            const float r2 = __builtin_amdgcn_rsqf((((p0[0] + p0[1]) + (p0[2] + p0[3])) + ((p1[0] + p1[1]) + (p1[2] + p1[3]))) * (1.f / 128.f) + EPS);
            const u32x4 sgw = i == 0 ? sgk0 : sgk1;
            f32x4 g0, g1;
            g0[0] = __uint_as_float(sgw.x << 16); g0[1] = __uint_as_float(sgw.x & 0xffff0000u); g0[2] = __uint_as_float(sgw.y << 16); g0[3] = __uint_as_float(sgw.y & 0xffff0000u);
            g1[0] = __uint_as_float(sgw.z << 16); g1[1] = __uint_as_float(sgw.z & 0xffff0000u); g1[2] = __uint_as_float(sgw.w << 16); g1[3] = __uint_as_float(sgw.w & 0xffff0000u);
            *(u32x4*)(MIX + (rowbase + row) * DM + h * 128 + ch * 8) = pg8::pack8(v0 * r2 * onv0 * g0, v1 * r2 * onv1 * g1); }
    }
}


#define XB_TMO      128
#define XB_XCNT(j)  (256  + 64 * (j))
#define XB_XSUB(j)  (1280 + 64 * (j))
#define XB_XGEN(j)  (2304 + 64 * (j))
#define XB_TOP      3328
#define XB_TOPGEN   3392
#define XCD_BAR_WORDS 3456
#define XB_SPIN_CAP (1u << 18)
__device__ __forceinline__ unsigned xb_ld(unsigned* p)              { return __hip_atomic_load(p, __ATOMIC_RELAXED, __HIP_MEMORY_SCOPE_AGENT); }
__device__ __forceinline__ unsigned xb_add(unsigned* p, unsigned v) { return __hip_atomic_fetch_add(p, v, __ATOMIC_RELAXED, __HIP_MEMORY_SCOPE_AGENT); }
__device__ __forceinline__ unsigned xb_xcc_id() { return (unsigned)__builtin_amdgcn_s_getreg((3 << 11) | 20) & 0xFu; }
#define XB_SPIN(cond, bar) do { unsigned _sp = 0; while (cond) { __builtin_amdgcn_s_sleep(1); \
    if ((++_sp & 255u) == 0u) { if (xb_ld(&(bar)[XB_TMO])) break; if (_sp > XB_SPIN_CAP) { atomicAdd(&(bar)[XB_TMO], 1u); break; } } } } while (0)
struct XcdBarrier { unsigned* bar; unsigned x; volatile LAS unsigned* st; };
__device__ __forceinline__ XcdBarrier xcd_barrier_post(unsigned* bar, volatile LAS unsigned* st) {
    XcdBarrier b; b.bar = bar; b.x = xb_xcc_id(); b.st = st;
    if (threadIdx.x == 0) (void)xb_add(&bar[XB_XCNT(b.x)], 1u);
    return b;
}
__device__ __forceinline__ void xcd_barrier_complete(unsigned* bar, unsigned x, unsigned& nloc, unsigned& nx) {
    const unsigned G = gridDim.x * gridDim.y * gridDim.z;
    unsigned sum, cnt, mine, sp = 0u;
    for (;;) {
        sum = 0u; cnt = 0u; mine = 0u;
#pragma unroll
        for (unsigned j = 0; j < 16; ++j) { const unsigned c = xb_ld(&bar[XB_XCNT(j)]); sum += c; cnt += (c > 0u) ? 1u : 0u; mine = (j == x) ? c : mine; }
        if (sum == G) break;
        __builtin_amdgcn_s_sleep(1);
        if ((++sp & 255u) == 0u) { if (xb_ld(&bar[XB_TMO])) break; if (sp > XB_SPIN_CAP) { atomicAdd(&bar[XB_TMO], 1u); break; } }
    }
    nloc = mine > 0u ? mine : 1u; nx = cnt > 0u ? cnt : 1u;
}
__device__ __forceinline__ void xcd_barrier(const XcdBarrier& b) {
    asm volatile("s_waitcnt vmcnt(0)" ::: "memory");
    __syncthreads();
    if (threadIdx.x == 0) {
        unsigned* bar = b.bar;
        __builtin_amdgcn_s_waitcnt(0);
        unsigned nloc = b.st[0], nx = b.st[1];
        if (nloc == 0u) { xcd_barrier_complete(bar, b.x, nloc, nx); b.st[0] = nloc; b.st[1] = nx; }
        const unsigned old = xb_add(&bar[XB_XSUB(b.x)], 1u);
        const unsigned gen = old / nloc;
        if (old + 1u == (gen + 1u) * nloc) {
            __builtin_amdgcn_fence(__ATOMIC_RELEASE, "agent");
            asm volatile("s_waitcnt vmcnt(0)" ::: "memory");
            const unsigned og = xb_add(&bar[XB_TOP], 1u);
            const unsigned tg = og / nx;
            if (og + 1u == (tg + 1u) * nx) xb_add(&bar[XB_TOPGEN], 1u);
            else XB_SPIN(xb_ld(&bar[XB_TOPGEN]) == tg, bar);
            __builtin_amdgcn_fence(__ATOMIC_ACQUIRE, "agent");
            xb_add(&bar[XB_XGEN(b.x)], 1u);
            asm volatile("s_waitcnt vmcnt(0)" ::: "memory");
        } else {
            XB_SPIN(xb_ld(&bar[XB_XGEN(b.x)]) == gen, bar);
            __builtin_amdgcn_fence(__ATOMIC_ACQUIRE, "agent");
            asm volatile("s_waitcnt vmcnt(0)" ::: "memory");
        }
    }
    __syncthreads();
}

struct Args {
    const float* in[19]; float* out; unsigned char* ws; int ph_lo, ph_hi;
};
enum { PH_PRO = 0, PH_GEMM1 = 1, PH_WO0 = 5, PH_GU0 = 6, PH_DN0 = 7, PH_KVB = 8, PH_WO1 = 11, PH_GU1 = 12, PH_DN1 = 13, PH_END = 14 };

__device__ __forceinline__ void p0_transpose_item(const float* W, const float* gain, int K, int N, bf16_t* WT, int map, LAS float* scr, int item, int lane) {
    const int nblk = N / 64, kb = item / nblk, nb = item % nblk, k0 = 64 * kb, n0 = 64 * nb;
    f32x4 wv[16];
#pragma unroll
    for (int i = 0; i < 16; ++i) wv[i] = *(const f32x4*)(W + (size_t)(k0 + 4 * i + (lane >> 4)) * N + n0 + 4 * (lane & 15));
    const int c = lane & 7, nn = lane >> 3;
    f32x4 g0 = (f32x4){1.f, 1.f, 1.f, 1.f}, g1 = g0;
    if (gain) { g0 = *(const f32x4*)(gain + k0 + 8 * c); g1 = *(const f32x4*)(gain + k0 + 8 * c + 4); }
#pragma unroll
    for (int i = 0; i < 16; ++i) { const int k = 4 * i + (lane >> 4); *(LAS f32x4*)(scr + k * 64 + 4 * ((lane & 15) ^ ((k >> 3) & 7))) = wv[i]; }
    asm volatile("s_waitcnt lgkmcnt(0)" ::: "memory");
#pragma unroll
    for (int j = 0; j < 8; ++j) { const int n = nn + 8 * j; const LAS float* sp = scr + (8 * c) * 64 + 4 * ((n >> 2) ^ c) + (n & 3);
        u32x4 o; o.x = cvt_pk_bf16(sp[0 * 64] * g0[0], sp[1 * 64] * g0[1]); o.y = cvt_pk_bf16(sp[2 * 64] * g0[2], sp[3 * 64] * g0[3]); o.z = cvt_pk_bf16(sp[4 * 64] * g1[0], sp[5 * 64] * g1[1]); o.w = cvt_pk_bf16(sp[6 * 64] * g1[2], sp[7 * 64] * g1[3]);
        *(u32x4*)(WT + (size_t)dst_row(map, n0 + n) * K + k0 + 8 * c) = o; }
    asm volatile("s_waitcnt lgkmcnt(0)" ::: "memory");
}
__device__ __forceinline__ void p0_row(const float* xrow, bf16_t* orow, float* ss, int lane) {
    const f32x4* xr = (const f32x4*)xrow + lane; f32x4 v[4]; float s = 0.f;
#pragma unroll
    for (int j = 0; j < 4; ++j) { v[j] = xr[64 * j]; s += (v[j].x * v[j].x + v[j].y * v[j].y) + (v[j].z * v[j].z + v[j].w * v[j].w); }
    s = wave_sum(s);
#pragma unroll
    for (int j = 0; j < 4; ++j) { u32x2 o; o.x = cvt_pk_bf16(v[j].x, v[j].y); o.y = cvt_pk_bf16(v[j].z, v[j].w); *((u32x2*)orow + lane + 64 * j) = o; }
    if (lane == 0) *ss = s;
}

__device__ __forceinline__ void p0_row4(const float* xrow, bf16_t* orow, float* ss, int lane) {
    f32x4 v[4][4]; float s[4];
#pragma unroll
    for (int r = 0; r < 4; ++r)
#pragma unroll
        for (int j = 0; j < 4; ++j) v[r][j] = ((const f32x4*)(xrow + (size_t)r * DM))[lane + 64 * j];
#pragma unroll
    for (int r = 0; r < 4; ++r) { float a = 0.f;
#pragma unroll
        for (int j = 0; j < 4; ++j) { a += (v[r][j].x * v[r][j].x + v[r][j].y * v[r][j].y) + (v[r][j].z * v[r][j].z + v[r][j].w * v[r][j].w);
            u32x2 o; o.x = cvt_pk_bf16(v[r][j].x, v[r][j].y); o.y = cvt_pk_bf16(v[r][j].z, v[r][j].w); *((u32x2*)(orow + (size_t)r * DM) + lane + 64 * j) = o; }
        s[r] = wave_sum(a); }
    if (lane < 4) ss[lane] = lane == 0 ? s[0] : (lane == 1 ? s[1] : (lane == 2 ? s[2] : s[3]));
}

__global__ void __launch_bounds__(NTHREADS, 2) mk_fwd(Args args) {
    extern __shared__ __attribute__((aligned(16))) unsigned char lds_raw[];
    LAS unsigned char* lds = (LAS unsigned char*)lds_raw;
    const int G = gridDim.x, bx = blockIdx.x;
    const int wave_s = __builtin_amdgcn_readfirstlane(threadIdx.x >> 6);
    const int vcu = (G % 8 == 0) ? (bx % 8) * (G / 8) + bx / 8 : bx;
    const float* x = (const float*)(const GAS float*)args.in[0]; const float* mem = (const float*)(const GAS float*)args.in[1]; const float* norm_mix = (const float*)(const GAS float*)args.in[2]; const float* norm_ffn = (const float*)(const GAS float*)args.in[3];
    const float* a_w_in = (const float*)(const GAS float*)args.in[4]; const float* a_lb = (const float*)(const GAS float*)args.in[5]; const float* a_onorm = (const float*)(const GAS float*)args.in[6]; const float* b_w_in = (const float*)(const GAS float*)args.in[7]; const float* b_qnorm = (const float*)(const GAS float*)args.in[8];
    const float* kv_norm = (const float*)(const GAS float*)args.in[9]; const float* w_kv = (const float*)(const GAS float*)args.in[10]; const float* b_knorm = (const float*)(const GAS float*)args.in[11]; const float* mem_norm = (const float*)(const GAS float*)args.in[12]; const float* w_mem_kv = (const float*)(const GAS float*)args.in[13];
    const float* mem_qnorm = (const float*)(const GAS float*)args.in[14]; const float* mem_knorm = (const float*)(const GAS float*)args.in[15]; const float* w_out = (const float*)(const GAS float*)args.in[16]; const float* w_gate_up = (const float*)(const GAS float*)args.in[17]; const float* w_down = (const float*)(const GAS float*)args.in[18];
#define WSP(type, name, off) type* name = (type*)(GAS type*)(wsp + (off))
#define PHASE_PTRS GAS unsigned char* wsp = (GAS unsigned char*)args.ws; asm volatile("" : "+s"(wsp)); float* sm = (float*)(GAS float*)(wsp + WS_SMALL); (void)sm
    float* H = (float*)(GAS float*)args.out;
    volatile LAS unsigned* MISC = (volatile LAS unsigned*)(lds + MISC_OFF);
    if (threadIdx.x < 16) MISC[threadIdx.x] = 0u;
    __syncthreads();
    const XcdBarrier gbar = xcd_barrier_post((unsigned*)((GAS unsigned char*)args.ws + WS_CTL), MISC);
#ifndef PROBE_REPEAT
#define PROBE_REPEAT -1
#endif
#define REPS(k) ((PROBE_REPEAT == (k)) ? 2 : 1)
#define IN(k) true
#ifndef PROBE_PHASE
#define PROBE_PHASE -1
#endif
#ifndef PROBE_MULT
#define PROBE_MULT 4
#endif
    unsigned long long tprev = 0, tsel = 0;
    if (PROBE_PHASE >= 0) tprev = __builtin_amdgcn_s_memrealtime();
#define SEAM(k) do { xcd_barrier(gbar); if (PROBE_PHASE >= 0) { const unsigned long long now_ = __builtin_amdgcn_s_memrealtime(); if (PROBE_PHASE == (k)) tsel = now_ - tprev; tprev = now_; } } while (0)

    for (int rep_ = 0; rep_ < REPS(PH_PRO); ++rep_) if (IN(PH_PRO)) {
        if (rep_) xcd_barrier(gbar);
        PHASE_PTRS;
        WSP(bf16_t, WA, WS_WA); WSP(bf16_t, WKVB, WS_WKVB); WSP(bf16_t, WO, WS_WO); WSP(bf16_t, WGU, WS_WGU); WSP(bf16_t, WD, WS_WD); WSP(bf16_t, WMKV, WS_WMKV);
        WSP(bf16_t, XB, WS_XB); WSP(bf16_t, MEMB, WS_MEMB); WSP(unsigned, CSH, WS_CSH);
        float* LB = sm + SM_LB / 4; float* COS = sm + SM_COS / 4; float* SIN = sm + SM_SIN / 4; float* SS0 = sm + SM_SS0 / 4; float* SS1 = sm + SM_SS1 / 4; float* SS2 = sm + SM_SS2 / 4; float* SS3 = sm + SM_SS3 / 4; float* SSM = sm + SM_SSM / 4;
        const int tid = fresh_tid(wave_s); const int lane = tid & 63, wave = __builtin_amdgcn_readfirstlane(tid >> 6);
        LAS float* scr = (LAS float*)(lds + wave * 16384);
        const int gw = vcu * NWAVES + wave, NGW = G * NWAVES;
        int base = 0;
#define WJOB(W_, g_, K_, N_, o_, map_) do { const int ni_ = ((K_) / 64) * ((N_) / 64); int first_ = gw - (base % NGW); if (first_ < 0) first_ += NGW; \
            for (int it = first_; it < ni_; it += NGW) p0_transpose_item(W_, g_, K_, N_, o_, map_, scr, it, lane); base += ni_; } while (0)
        WJOB(a_w_in, norm_mix, DM, A_COLS, WA, MAP_WA);
        WJOB(w_kv, kv_norm, DM, 2 * AW, WKVB, MAP_KV);
        WJOB(b_w_in, norm_mix + DM, DM, B_COLS, WKVB, MAP_BIN);
        WJOB(w_out, (const float*)nullptr, DM, DM, WO, MAP_STD);
        WJOB(w_out + (size_t)DM * DM, (const float*)nullptr, DM, DM, WO + (size_t)DM * DM, MAP_STD);
        WJOB(w_gate_up, norm_ffn, DM, 2 * FFN, WGU, MAP_GU);
        WJOB(w_gate_up + (size_t)DM * 2 * FFN, norm_ffn + DM, DM, 2 * FFN, WGU + (size_t)2 * FFN * DM, MAP_GU);
        WJOB(w_down, (const float*)nullptr, FFN, DM, WD, MAP_STD);
        WJOB(w_down + (size_t)FFN * DM, (const float*)nullptr, FFN, DM, WD + (size_t)DM * FFN, MAP_STD);
        WJOB(w_mem_kv, mem_norm, DM, 512, WMKV, MAP_MKV0);
        WJOB(w_mem_kv + (size_t)DM * 512, mem_norm + DM, DM, 512, WMKV, MAP_MKV1);
#undef WJOB
        for (int m = gw * 4; m < T; m += NGW * 4) p0_row4(x + (size_t)m * DM, XB + (size_t)m * DM, SS0 + m, lane);
        for (int m = gw; m < MROWS; m += NGW) p0_row(mem + (size_t)m * DM, MEMB + (size_t)m * DM, SSM + m, lane);
        const int gt = vcu * NTHREADS + tid, NGT = G * NTHREADS;
        for (int i = gt; i < 4096 * 64; i += NGT) { const int pos = i >> 6, fi = i & 63; const float inv = __builtin_amdgcn_exp2f(-(float)fi * (13.287712379549449f / 64.f)); const float ang = (float)pos * inv;
            const float rev = ang * 0.15915494309189535f, fr_ = rev - floorf(rev);
            const float cv = __builtin_amdgcn_cosf(fr_), sv = __builtin_amdgcn_sinf(fr_); COS[i] = cv; SIN[i] = sv;
            { typedef _Float16 h2_t __attribute__((ext_vector_type(2))); const h2_t pk = {(_Float16)cv, (_Float16)sv}; CSH[i] = __builtin_bit_cast(unsigned, pk); } }
        for (int i = gt; i < T; i += NGT) { SS1[i] = 0.f; SS2[i] = 0.f; SS3[i] = 0.f; }
        for (int i = gt; i < AW; i += NGT) { const float a0 = a_lb[i], a1 = a_lb[AW + i]; const float mx = fmaxf(a0, a1); const float e0 = expf(a0 - mx), e1 = expf(a1 - mx); LB[i] = e0 / (e0 + e1); }
        asm volatile("s_waitcnt vmcnt(0) lgkmcnt(0)" ::: "memory"); __syncthreads();
    }
    SEAM(PH_PRO);
    for (int rep_ = 0; rep_ < REPS(PH_GEMM1); ++rep_) if (IN(PH_GEMM1)) {
        if (rep_) xcd_barrier(gbar);
        PHASE_PTRS;
        WSP(bf16_t, WA, WS_WA); WSP(bf16_t, WMKV, WS_WMKV); WSP(bf16_t, XB, WS_XB); WSP(bf16_t, MEMB, WS_MEMB); WSP(bf16_t, MK, WS_MK); WSP(bf16_t, MV, WS_MV);
        WSP(bf16_t, QS, WS_QS); WSP(bf16_t, VV, WS_VV); WSP(bf16_t, SG, WS_SG); WSP(bf16_t, MQ0, WS_MQ0); WSP(unsigned short, LF, WS_LF);
        float* LB = sm + SM_LB / 4; float* SS0 = sm + SM_SS0 / 4; float* SSM = sm + SM_SSM / 4;
        { pg8::StaticOrder S; S.init(MROWS, 1024, G, (bx + G / 2) % G);
          pg8::EpiMemKV E{SSM, mem_knorm, MK, MV};
          pg8::gemm_phase(lds, wave_s, MEMB, WMKV, MROWS, 1024, DM, S, E); }
        { pg8::StaticOrder S; S.init(T, A_COLS, G, bx);
          pg8::EpiInproj0 E{SS0, LB, mem_qnorm, QS, LF, VV, SG, MQ0};
          pg8::gemm_phase(lds, wave_s, XB, WA, T, A_COLS, DM, S, E); }
    }
    if (PROBE_REPEAT == 21 && IN(PH_GEMM1)) { xcd_barrier(gbar); PHASE_PTRS; WSP(bf16_t, WA, WS_WA); WSP(bf16_t, XB, WS_XB); pg8::StaticOrder S; S.init(T, A_COLS, G, bx); pg8::EpiNull E; pg8::gemm_phase(lds, wave_s, XB, WA, T, A_COLS, DM, S, E); }
    SEAM(PH_GEMM1);
    if (IN(2)) { PHASE_PTRS; WSP(unsigned short, LF, WS_LF); WSP(bf16_t, VV, WS_VV); WSP(bf16_t, MQ0, WS_MQ0); WSP(bf16_t, MK, WS_MK); WSP(bf16_t, MV, WS_MV); WSP(bf16_t, MIX, WS_MIX);
        float* AGG = H; float* DTOT = H + (size_t)4 * 1024 * 1024;
        const int tid = fresh_tid(wave_s);
        if (G == 256) {
            if (vcu < HG2_UNITS && (vcu & 3) != 3) hg2A_run(lds, vcu, LF, VV, AGG, DTOT, tid);
            else { const int k = vcu < HG2_UNITS ? (vcu >> 2) : 48 + (vcu - HG2_UNITS); mem_run(lds, 4, 4 * k, MQ0, MK, MV, MIX, tid); } }
    }
    SEAM(2);
    if (IN(4)) { PHASE_PTRS; WSP(unsigned short, LF, WS_LF); WSP(bf16_t, QS, WS_QS); WSP(bf16_t, VV, WS_VV); WSP(bf16_t, SG, WS_SG); WSP(bf16_t, MIX, WS_MIX); WSP(bf16_t, MQ0, WS_MQ0); WSP(bf16_t, MK, WS_MK); WSP(bf16_t, MV, WS_MV);
        const float* AGG = H; const float* DTOT = H + (size_t)4 * 1024 * 1024;
        const int tid = fresh_tid(wave_s);
        if (G == 256) {
            if (vcu < HG2_UNITS) hg2C_run(lds, vcu, LF, QS, VV, SG, AGG, DTOT, a_onorm, MIX, tid);
            else mem_run(lds, 9, 448 + 9 * (vcu - HG2_UNITS), MQ0, MK, MV, MIX, tid); }
    }
    SEAM(4);
    { constexpr int l = 0;

        const int pb = l == 0 ? PH_WO0 : PH_WO1;
        if (IN(pb)) { PHASE_PTRS; WSP(bf16_t, WO, WS_WO); WSP(bf16_t, XB, WS_XB); WSP(bf16_t, MIX, WS_MIX); float* SS1 = sm + SM_SS1 / 4; float* SS3 = sm + SM_SS3 / 4;
            pg8::StaticOrder S; S.init(T, DM, G, bx);
            pg8::EpiResid<true, false> E{x, H, XB, l == 0 ? SS1 : SS3};
            pg8::gemm_phase(lds, wave_s, MIX, WO + (size_t)l * DM * DM, T, DM, DM, S, E); }
        if (PROBE_REPEAT == 5 && IN(pb)) { xcd_barrier(gbar); PHASE_PTRS; WSP(bf16_t, WO, WS_WO); WSP(bf16_t, MIX, WS_MIX); pg8::StaticOrder S; S.init(T, DM, G, bx); pg8::EpiNull E; pg8::gemm_phase(lds, wave_s, MIX, WO + (size_t)l * DM * DM, T, DM, DM, S, E); }
        SEAM(pb);
        for (int rep_ = 0; rep_ < REPS(6); ++rep_) if (IN(pb + 1)) { if (rep_) xcd_barrier(gbar); PHASE_PTRS; WSP(bf16_t, WGU, WS_WGU); WSP(bf16_t, XB, WS_XB); WSP(bf16_t, ACT, WS_ACT); float* SS1 = sm + SM_SS1 / 4; float* SS3 = sm + SM_SS3 / 4;
            pg8::StaticOrder S; S.init(T, 2 * FFN, G, bx);
            pg8::EpiGateUp E{l == 0 ? SS1 : SS3, ACT};
            pg8::gemm_phase(lds, wave_s, XB, WGU + (size_t)l * 2 * FFN * DM, T, 2 * FFN, DM, S, E); }
        SEAM(pb + 1);
        if (IN(pb + 2)) { PHASE_PTRS; WSP(bf16_t, WD, WS_WD); WSP(bf16_t, XB, WS_XB); WSP(bf16_t, ACT, WS_ACT); float* SS2 = sm + SM_SS2 / 4;
            pg8::StaticOrder S; S.init(T, DM, G, bx);
            pg8::EpiResid<true, l != 0> E{x, H, XB, SS2};
            pg8::gemm_phase(lds, wave_s, ACT, WD + (size_t)l * DM * FFN, T, DM, FFN, S, E); }
        if (PROBE_REPEAT == 7 && IN(pb + 2)) { xcd_barrier(gbar); PHASE_PTRS; WSP(bf16_t, WD, WS_WD); WSP(bf16_t, ACT, WS_ACT); pg8::StaticOrder S; S.init(T, DM, G, bx); pg8::EpiNull E; pg8::gemm_phase(lds, wave_s, ACT, WD + (size_t)l * DM * FFN, T, DM, FFN, S, E); }
        if (l == 0) {
            SEAM(PH_DN0);
            for (int rep_ = 0; rep_ < REPS(PH_KVB); ++rep_) if (IN(PH_KVB)) { if (rep_) xcd_barrier(gbar); PHASE_PTRS; WSP(bf16_t, WKVB, WS_WKVB); WSP(bf16_t, XB, WS_XB); WSP(bf16_t, KR, WS_KR); WSP(bf16_t, VS, WS_VS); WSP(bf16_t, QG, WS_QG); WSP(bf16_t, MQ1, WS_MQ1);
                float* COS = sm + SM_COS / 4; float* SIN = sm + SM_SIN / 4; float* SS2 = sm + SM_SS2 / 4;
                pg8::StaticOrder S; S.init(T, KVB_COLS, G, bx);
                pg8::EpiKVB E{SS2, b_knorm, b_qnorm, mem_qnorm + 64, COS, SIN, KR, VS, QG, MQ1};
                pg8::gemm_phase(lds, wave_s, XB, WKVB, T, KVB_COLS, DM, S, E); }
            if (PROBE_REPEAT == 28 && IN(PH_KVB)) { xcd_barrier(gbar); PHASE_PTRS; WSP(bf16_t, WKVB, WS_WKVB); WSP(bf16_t, XB, WS_XB); pg8::StaticOrder S; S.init(T, KVB_COLS, G, bx); pg8::EpiNull E; pg8::gemm_phase(lds, wave_s, XB, WKVB, T, KVB_COLS, DM, S, E); }
            SEAM(PH_KVB);
            if (IN(9)) { PHASE_PTRS; WSP(bf16_t, KR, WS_KR); WSP(bf16_t, VS, WS_VS); WSP(bf16_t, QG, WS_QG); WSP(bf16_t, MQ1, WS_MQ1); WSP(bf16_t, MK, WS_MK); WSP(bf16_t, MV, WS_MV); WSP(bf16_t, MIX, WS_MIX); WSP(float, LSE, WS_LSE); WSP(unsigned, CSH, WS_CSH);
                const int tid = fresh_tid(wave_s);
                if (G == 256) { dil_run(lds, 18, vcu * 18, KR, VS, QG, LSE, CSH, b_qnorm, tid); const int tid2 = fresh_tid(wave_s); mem_run(lds, 4, vcu * 4, MQ1, MK + (size_t)MROWS * MW, MV + (size_t)MROWS * MW, MIX, tid2); }
            }
            SEAM(9);
            for (int rep_ = 0; rep_ < REPS(10); ++rep_) if (IN(10)) { if (rep_) xcd_barrier(gbar); PHASE_PTRS; WSP(bf16_t, QG, WS_QG); WSP(bf16_t, MIX, WS_MIX); WSP(float, LSE, WS_LSE);
                const int tid = fresh_tid(wave_s);
#pragma unroll 1
                for (int it = bx * NTHREADS + tid; it < T * 96; it += G * NTHREADS) { const int row = it / 96, c8 = it % 96, h = c8 >> 4;
                    const float l0 = LSE[(size_t)row * NH + h], l1 = LSE[((size_t)T + row) * NH + h], l2 = LSE[((size_t)2 * T + row) * NH + h];
                    const float mm = fmaxf(l0, fmaxf(l1, l2)); float w0 = __builtin_amdgcn_exp2f(l0 - mm), w1 = __builtin_amdgcn_exp2f(l1 - mm), w2 = __builtin_amdgcn_exp2f(l2 - mm);
                    const float wi = __builtin_amdgcn_rcpf(w0 + w1 + w2); w0 *= wi; w1 *= wi; w2 *= wi;
                    const u32x4 a = *(const u32x4*)(QG + (size_t)row * AW + c8 * 8), bq = *(const u32x4*)(QG + ((size_t)T + row) * AW + c8 * 8), cq = *(const u32x4*)(QG + ((size_t)2 * T + row) * AW + c8 * 8);
                    const unsigned av[4] = {a.x, a.y, a.z, a.w}, bv[4] = {bq.x, bq.y, bq.z, bq.w}, cv[4] = {cq.x, cq.y, cq.z, cq.w}; unsigned ov[4];
#pragma unroll
                    for (int i = 0; i < 4; ++i) { const float lo = w0 * __uint_as_float(av[i] << 16) + w1 * __uint_as_float(bv[i] << 16) + w2 * __uint_as_float(cv[i] << 16);
                        const float hi = w0 * __uint_as_float(av[i] & 0xffff0000u) + w1 * __uint_as_float(bv[i] & 0xffff0000u) + w2 * __uint_as_float(cv[i] & 0xffff0000u); ov[i] = cvt_pk_bf16(lo, hi); }
                    *(u32x4*)(MIX + (size_t)row * DM + c8 * 8) = (u32x4){ov[0], ov[1], ov[2], ov[3]}; }
            }
            SEAM(10);
        }
        }
    { constexpr int l = 1;

        const int pb = l == 0 ? PH_WO0 : PH_WO1;
        if (IN(pb)) { PHASE_PTRS; WSP(bf16_t, WO, WS_WO); WSP(bf16_t, XB, WS_XB); WSP(bf16_t, MIX, WS_MIX); float* SS1 = sm + SM_SS1 / 4; float* SS3 = sm + SM_SS3 / 4;
            pg8::StaticOrder S; S.init(T, DM, G, bx);
            pg8::EpiResid<true, false> E{x, H, XB, l == 0 ? SS1 : SS3};
            pg8::gemm_phase(lds, wave_s, MIX, WO + (size_t)l * DM * DM, T, DM, DM, S, E); }
        if (PROBE_REPEAT == 5 && IN(pb)) { xcd_barrier(gbar); PHASE_PTRS; WSP(bf16_t, WO, WS_WO); WSP(bf16_t, MIX, WS_MIX); pg8::StaticOrder S; S.init(T, DM, G, bx); pg8::EpiNull E; pg8::gemm_phase(lds, wave_s, MIX, WO + (size_t)l * DM * DM, T, DM, DM, S, E); }
        SEAM(pb);
        for (int rep_ = 0; rep_ < REPS(6); ++rep_) if (IN(pb + 1)) { if (rep_) xcd_barrier(gbar); PHASE_PTRS; WSP(bf16_t, WGU, WS_WGU); WSP(bf16_t, XB, WS_XB); WSP(bf16_t, ACT, WS_ACT); float* SS1 = sm + SM_SS1 / 4; float* SS3 = sm + SM_SS3 / 4;
            pg8::StaticOrder S; S.init(T, 2 * FFN, G, bx);
            pg8::EpiGateUp E{l == 0 ? SS1 : SS3, ACT};
            pg8::gemm_phase(lds, wave_s, XB, WGU + (size_t)l * 2 * FFN * DM, T, 2 * FFN, DM, S, E); }
        SEAM(pb + 1);
        if (IN(pb + 2)) { PHASE_PTRS; WSP(bf16_t, WD, WS_WD); WSP(bf16_t, XB, WS_XB); WSP(bf16_t, ACT, WS_ACT); float* SS2 = sm + SM_SS2 / 4;
            pg8::StaticOrder S; S.init(T, DM, G, bx);
            pg8::EpiResid<true, l != 0> E{x, H, XB, SS2};
            pg8::gemm_phase(lds, wave_s, ACT, WD + (size_t)l * DM * FFN, T, DM, FFN, S, E); }
        if (PROBE_REPEAT == 7 && IN(pb + 2)) { xcd_barrier(gbar); PHASE_PTRS; WSP(bf16_t, WD, WS_WD); WSP(bf16_t, ACT, WS_ACT); pg8::StaticOrder S; S.init(T, DM, G, bx); pg8::EpiNull E; pg8::gemm_phase(lds, wave_s, ACT, WD + (size_t)l * DM * FFN, T, DM, FFN, S, E); }
        if (l == 0) {
            SEAM(PH_DN0);
            for (int rep_ = 0; rep_ < REPS(PH_KVB); ++rep_) if (IN(PH_KVB)) { if (rep_) xcd_barrier(gbar); PHASE_PTRS; WSP(bf16_t, WKVB, WS_WKVB); WSP(bf16_t, XB, WS_XB); WSP(bf16_t, KR, WS_KR); WSP(bf16_t, VS, WS_VS); WSP(bf16_t, QG, WS_QG); WSP(bf16_t, MQ1, WS_MQ1);
                float* COS = sm + SM_COS / 4; float* SIN = sm + SM_SIN / 4; float* SS2 = sm + SM_SS2 / 4;
                pg8::StaticOrder S; S.init(T, KVB_COLS, G, bx);
                pg8::EpiKVB E{SS2, b_knorm, b_qnorm, mem_qnorm + 64, COS, SIN, KR, VS, QG, MQ1};
                pg8::gemm_phase(lds, wave_s, XB, WKVB, T, KVB_COLS, DM, S, E); }
            if (PROBE_REPEAT == 28 && IN(PH_KVB)) { xcd_barrier(gbar); PHASE_PTRS; WSP(bf16_t, WKVB, WS_WKVB); WSP(bf16_t, XB, WS_XB); pg8::StaticOrder S; S.init(T, KVB_COLS, G, bx); pg8::EpiNull E; pg8::gemm_phase(lds, wave_s, XB, WKVB, T, KVB_COLS, DM, S, E); }
            SEAM(PH_KVB);
            if (IN(9)) { PHASE_PTRS; WSP(bf16_t, KR, WS_KR); WSP(bf16_t, VS, WS_VS); WSP(bf16_t, QG, WS_QG); WSP(bf16_t, MQ1, WS_MQ1); WSP(bf16_t, MK, WS_MK); WSP(bf16_t, MV, WS_MV); WSP(bf16_t, MIX, WS_MIX); WSP(float, LSE, WS_LSE); WSP(unsigned, CSH, WS_CSH);
                const int tid = fresh_tid(wave_s);
                if (G == 256) { dil_run(lds, 18, vcu * 18, KR, VS, QG, LSE, CSH, b_qnorm, tid); const int tid2 = fresh_tid(wave_s); mem_run(lds, 4, vcu * 4, MQ1, MK + (size_t)MROWS * MW, MV + (size_t)MROWS * MW, MIX, tid2); }
            }
            SEAM(9);
            for (int rep_ = 0; rep_ < REPS(10); ++rep_) if (IN(10)) { if (rep_) xcd_barrier(gbar); PHASE_PTRS; WSP(bf16_t, QG, WS_QG); WSP(bf16_t, MIX, WS_MIX); WSP(float, LSE, WS_LSE);
                const int tid = fresh_tid(wave_s);
#pragma unroll 1
                for (int it = bx * NTHREADS + tid; it < T * 96; it += G * NTHREADS) { const int row = it / 96, c8 = it % 96, h = c8 >> 4;
                    const float l0 = LSE[(size_t)row * NH + h], l1 = LSE[((size_t)T + row) * NH + h], l2 = LSE[((size_t)2 * T + row) * NH + h];
                    const float mm = fmaxf(l0, fmaxf(l1, l2)); float w0 = __builtin_amdgcn_exp2f(l0 - mm), w1 = __builtin_amdgcn_exp2f(l1 - mm), w2 = __builtin_amdgcn_exp2f(l2 - mm);
                    const float wi = __builtin_amdgcn_rcpf(w0 + w1 + w2); w0 *= wi; w1 *= wi; w2 *= wi;
                    const u32x4 a = *(const u32x4*)(QG + (size_t)row * AW + c8 * 8), bq = *(const u32x4*)(QG + ((size_t)T + row) * AW + c8 * 8), cq = *(const u32x4*)(QG + ((size_t)2 * T + row) * AW + c8 * 8);
                    const unsigned av[4] = {a.x, a.y, a.z, a.w}, bv[4] = {bq.x, bq.y, bq.z, bq.w}, cv[4] = {cq.x, cq.y, cq.z, cq.w}; unsigned ov[4];
#pragma unroll
                    for (int i = 0; i < 4; ++i) { const float lo = w0 * __uint_as_float(av[i] << 16) + w1 * __uint_as_float(bv[i] << 16) + w2 * __uint_as_float(cv[i] << 16);
                        const float hi = w0 * __uint_as_float(av[i] & 0xffff0000u) + w1 * __uint_as_float(bv[i] & 0xffff0000u) + w2 * __uint_as_float(cv[i] & 0xffff0000u); ov[i] = cvt_pk_bf16(lo, hi); }
                    *(u32x4*)(MIX + (size_t)row * DM + c8 * 8) = (u32x4){ov[0], ov[1], ov[2], ov[3]}; }
            }
            SEAM(10);
        }
        }
    if (PROBE_PHASE >= 0) { SEAM(13);
        if (bx == 0) { const unsigned long long t0 = __builtin_amdgcn_s_memrealtime(); while (__builtin_amdgcn_s_memrealtime() - t0 < (unsigned long long)PROBE_MULT * tsel) __builtin_amdgcn_s_sleep(32); } }
#undef IN
#undef SEAM
}

static int g_grid = 0;
static void launch_mk(Args& a, int lo, int hi, hipStream_t stream) {
    a.ph_lo = lo; a.ph_hi = hi;
    void* kargs[] = {&a};
    (void)kargs; hipLaunchKernelGGL(mk_fwd, dim3(g_grid), dim3(NTHREADS), LDS_BYTES, stream, a);
}
extern "C" void kernel_launch(void* const* d_in, const int* in_sizes, int n_in, void* d_out, int out_size, void* d_ws, size_t ws_size, hipStream_t stream) {
    if (ws_size < WS_END || n_in != 19 || out_size != T * DM) return;
    if (g_grid == 0) {
        int dev = 0, cus = 0, per_cu = 0;
        hipGetDevice(&dev); hipDeviceGetAttribute(&cus, hipDeviceAttributeMultiprocessorCount, dev);
        hipFuncSetAttribute((const void*)mk_fwd, hipFuncAttributeMaxDynamicSharedMemorySize, LDS_BYTES);
        hipOccupancyMaxActiveBlocksPerMultiprocessor(&per_cu, (const void*)mk_fwd, NTHREADS, LDS_BYTES);
        (void)hipGetLastError();
        g_grid = (per_cu >= 1) ? cus : -1;
    }
    if (g_grid < 0) return;
    const float* x = (const float*)d_in[0];
    const float* a_onorm = (const float*)d_in[6];
    char* ws = (char*)d_ws;
    float* sm = (float*)(ws + WS_SMALL);
    bf16_t* MK = (bf16_t*)(ws + WS_MK); bf16_t* MV = (bf16_t*)(ws + WS_MV);
    bf16_t* QS = (bf16_t*)(ws + WS_QS); bf16_t* VV = (bf16_t*)(ws + WS_VV); bf16_t* SG = (bf16_t*)(ws + WS_SG); bf16_t* MQ0 = (bf16_t*)(ws + WS_MQ0);
    float* LF = (float*)(ws + WS_LF);
    bf16_t* KR = (bf16_t*)(ws + WS_KR); bf16_t* VS = (bf16_t*)(ws + WS_VS); bf16_t* QG = (bf16_t*)(ws + WS_QG); bf16_t* MQ1 = (bf16_t*)(ws + WS_MQ1);
    bf16_t* MIX = (bf16_t*)(ws + WS_MIX);
    Args a{};
    for (int i = 0; i < 19; ++i) a.in[i] = (const float*)d_in[i];
    a.out = (float*)d_out; a.ws = (unsigned char*)d_ws;

    hipMemsetAsync((char*)d_ws + WS_CTL, 0, 16384, stream);
    launch_mk(a, PH_PRO, PH_END, stream);
}
```

```cpp
#include <hip/hip_runtime.h>
#include <stdint.h>

typedef unsigned short bf16_t;
typedef short bf16x8 __attribute__((ext_vector_type(8)));
typedef float f32x4 __attribute__((ext_vector_type(4)));
typedef unsigned u32x4 __attribute__((ext_vector_type(4)));
typedef unsigned u32x2 __attribute__((ext_vector_type(2)));

constexpr int DM = 1024, BATCH = 8, SEQ = 4096, T = BATCH * SEQ;
constexpr int HD = 128, NH = 6, AW = 768;
constexpr int MEMT = 256, MH = 4, MHD = 64, MW = 256, MROWS = BATCH * MEMT;
constexpr int A_COLS = 4 * AW + MW;
constexpr int B_COLS = 3 * AW + MW;
constexpr int KVB_COLS = 2 * AW + B_COLS;
constexpr int FFN = 2816;
constexpr float EPS = 1e-6f;
constexpr float LOG2E = 1.4426950408889634f;

constexpr size_t MiB = 1u << 20;
constexpr size_t WS_WA    = 0;
constexpr size_t WS_WKVB  = WS_WA + 7 * MiB;
constexpr size_t WS_WO    = WS_WKVB + 8 * MiB;
constexpr size_t WS_WGU   = WS_WO + 4 * MiB;
constexpr size_t WS_WD    = WS_WGU + 22 * MiB;
constexpr size_t WS_WMKV  = WS_WD + 11 * MiB;
constexpr size_t WS_SMALL = WS_WMKV + 2 * MiB;
constexpr size_t SM_LB = 0, SM_COS = 4096, SM_SIN = SM_COS + 4096 * 64 * 4, SM_SS0 = SM_SIN + 4096 * 64 * 4,
                 SM_SS1 = SM_SS0 + T * 4, SM_SS2 = SM_SS1 + T * 4, SM_SS3 = SM_SS2 + T * 4, SM_SSM = SM_SS3 + T * 4, SM_END = SM_SSM + MROWS * 4;
static_assert(SM_END <= 3 * MiB, "small");
constexpr size_t WS_CTL = WS_WMKV + 2 * MiB + 3 * MiB + 512 * 1024;
constexpr size_t WS_XB    = WS_SMALL + 4 * MiB;
constexpr size_t WS_MEMB  = WS_XB + 64 * MiB;
constexpr size_t WS_MK    = WS_MEMB + 4 * MiB;
constexpr size_t WS_MV    = WS_MK + 2 * MiB;
constexpr size_t WS_R1    = WS_MV + 2 * MiB;
constexpr size_t WS_QS    = WS_R1;
constexpr size_t WS_VV    = WS_QS + 48 * MiB;
constexpr size_t WS_SG    = WS_VV + 48 * MiB;
constexpr size_t WS_MQ0   = WS_SG + 48 * MiB;
constexpr size_t WS_LF    = WS_MQ0 + 16 * MiB;
constexpr size_t WS_MIX   = WS_R1 + 256 * MiB;
constexpr size_t WS_TMP   = WS_MIX + 64 * MiB;
constexpr size_t WS_ACT   = WS_R1;
constexpr size_t WS_TMP2  = WS_ACT + 176 * MiB;
constexpr size_t WS_KR    = WS_R1;
constexpr size_t WS_VS    = WS_KR + 48 * MiB;
constexpr size_t WS_QG    = WS_VS + 48 * MiB;
constexpr size_t WS_MQ1   = WS_QG + 144 * MiB;
constexpr size_t WS_LSE   = WS_TMP;
constexpr size_t WS_CSH   = WS_TMP + 4 * MiB;
constexpr size_t WS_END   = 512 * MiB;

__device__ __forceinline__ float bf2f(bf16_t v) { return __uint_as_float((unsigned)v << 16); }
__device__ __forceinline__ bf16_t f2bf(float f) { unsigned u = __float_as_uint(f); return (bf16_t)((u + 0x7fffu + ((u >> 16) & 1u)) >> 16); }
__device__ __forceinline__ float silu_f(float v) { return v / (1.f + __expf(-v)); }
__device__ __forceinline__ float wave_sum(float v) {
#pragma unroll
    for (int o = 1; o < 64; o <<= 1) v += __shfl_xor(v, o);
    return v;
}
__device__ __forceinline__ float wave_max(float v) {
#pragma unroll
    for (int o = 1; o < 64; o <<= 1) v = fmaxf(v, __shfl_xor(v, o));
    return v;
}

namespace nv {
__global__ void wt_kernel(const float* __restrict__ W, const float* __restrict__ gain, bf16_t* __restrict__ out, int K, int N, int row_off) {
    __shared__ float tile[32][33];
    const int n0 = blockIdx.x * 32, k0 = blockIdx.y * 32;
    const int tx = threadIdx.x & 31, ty = threadIdx.x >> 5;
    for (int i = ty; i < 32; i += 8) tile[i][tx] = W[(size_t)(k0 + i) * N + n0 + tx] * (gain ? gain[k0 + i] : 1.f);
    __syncthreads();
    for (int i = ty; i < 32; i += 8) out[(size_t)(row_off + n0 + i) * K + k0 + tx] = f2bf(tile[tx][i]);
}
__global__ void rows_kernel(const float* __restrict__ x, bf16_t* __restrict__ xb, float* __restrict__ ss, int rows) {
    const int row = blockIdx.x * 4 + (threadIdx.x >> 6), lane = threadIdx.x & 63;
    if (row >= rows) return;
    const f32x4* xr = (const f32x4*)(x + (size_t)row * DM) + lane;
    float s = 0.f;
#pragma unroll
    for (int j = 0; j < 4; ++j) { f32x4 v = xr[64 * j]; s += v.x * v.x + v.y * v.y + v.z * v.z + v.w * v.w;
        u32x2 o; o.x = f2bf(v.x) | ((unsigned)f2bf(v.y) << 16); o.y = f2bf(v.z) | ((unsigned)f2bf(v.w) << 16);
        *((u32x2*)(xb + (size_t)row * DM) + lane + 64 * j) = o; }
    s = wave_sum(s);
    if (lane == 0) ss[row] = s;
}
__global__ void misc_kernel(const float* __restrict__ lb_logits, float* __restrict__ sm) {
    const int i = blockIdx.x * blockDim.x + threadIdx.x;
    if (i < AW) { const float a0 = lb_logits[i], a1 = lb_logits[AW + i]; const float m = fmaxf(a0, a1); const float e0 = expf(a0 - m), e1 = expf(a1 - m); sm[SM_LB / 4 + i] = e0 / (e0 + e1); }
    if (i < 4096 * 64) { const int pos = i >> 6, fi = i & 63; const float inv = powf(10000.f, -(float)fi / 64.f); const float ang = (float)pos * inv;
        sm[SM_COS / 4 + i] = cosf(ang); sm[SM_SIN / 4 + i] = sinf(ang); }
    if (i < T) { sm[SM_SS1 / 4 + i] = 0.f; sm[SM_SS2 / 4 + i] = 0.f; sm[SM_SS3 / 4 + i] = 0.f; }
}
__global__ __launch_bounds__(256) void gemm_kernel(const bf16_t* __restrict__ A, const bf16_t* __restrict__ Bt, float* __restrict__ C, int K, int ldc) {
    const int wave = threadIdx.x >> 6, lane = threadIdx.x & 63, r = lane & 15, g = lane >> 4;
    const int m0 = blockIdx.y * 128 + (wave >> 1) * 64, n0 = blockIdx.x * 128 + (wave & 1) * 64;
    f32x4 acc[4][4];
#pragma unroll
    for (int i = 0; i < 4; ++i)
#pragma unroll
        for (int j = 0; j < 4; ++j) acc[i][j] = (f32x4){0.f, 0.f, 0.f, 0.f};
    for (int k0 = 0; k0 < K; k0 += 32) {
        bf16x8 a[4], b[4];
#pragma unroll
        for (int i = 0; i < 4; ++i) a[i] = *(const bf16x8*)(A + (size_t)(m0 + 16 * i + r) * K + k0 + 8 * g);
#pragma unroll
        for (int j = 0; j < 4; ++j) b[j] = *(const bf16x8*)(Bt + (size_t)(n0 + 16 * j + r) * K + k0 + 8 * g);
#pragma unroll
        for (int i = 0; i < 4; ++i)
#pragma unroll
            for (int j = 0; j < 4; ++j) acc[i][j] = __builtin_amdgcn_mfma_f32_16x16x32_bf16(a[i], b[j], acc[i][j], 0, 0, 0);
    }
#pragma unroll
    for (int i = 0; i < 4; ++i)
#pragma unroll
        for (int j = 0; j < 4; ++j)
#pragma unroll
            for (int e = 0; e < 4; ++e) C[(size_t)(m0 + 16 * i + 4 * g + e) * ldc + n0 + 16 * j + r] = acc[i][j][e];
}
__device__ __forceinline__ float rs_of(const float* ss, int row) { return rsqrtf(ss[row] * (1.f / DM) + EPS); }

__global__ __launch_bounds__(256) void epi_inproj0(const float* __restrict__ C, int row0, const float* __restrict__ ss, const float* __restrict__ lb, const float* __restrict__ mqn,
                                                   bf16_t* QS, float* LF, bf16_t* VV, bf16_t* SG, bf16_t* MQ) {
    const int lr = blockIdx.x, row = row0 + lr, tid = threadIdx.x;
    const float rs = rs_of(ss, row);
    const float* c = C + (size_t)lr * A_COLS;
    for (int d = tid; d < AW; d += 256) {
        QS[(size_t)row * AW + d] = f2bf(silu_f(c[d] * rs));
        const float z = c[AW + d] * rs, l = lb[d]; const float f = l + (1.f - l) / (1.f + __expf(-z));
        LF[(size_t)row * AW + d] = __logf(f);
        VV[(size_t)row * AW + d] = f2bf(c[2 * AW + d] * rs);
        SG[(size_t)row * AW + d] = f2bf(silu_f(c[3 * AW + d] * rs));
    }
    const int w = tid >> 6, lane = tid & 63;
    const float v = c[4 * AW + w * 64 + lane] * rs;
    const float s2 = wave_sum(v * v);
    const float r2 = rsqrtf(s2 * (1.f / 64.f) + EPS);
    MQ[(size_t)row * MW + w * 64 + lane] = f2bf(v * r2 * mqn[lane] * (0.125f * LOG2E));
}
__global__ __launch_bounds__(256) void epi_memkv(const float* __restrict__ C, const float* __restrict__ ss, const float* __restrict__ mkn, bf16_t* MK, bf16_t* MV) {
    const int row = blockIdx.x, tid = threadIdx.x, w = tid >> 6, lane = tid & 63;
    const float rs = rs_of(ss, row);
    const float* c = C + (size_t)row * 1024;
    for (int l = 0; l < 2; ++l) {
        const float v = c[l * 512 + w * 64 + lane] * rs;
        const float s2 = wave_sum(v * v);
        const float r2 = rsqrtf(s2 * (1.f / 64.f) + EPS);
        MK[((size_t)l * MROWS + row) * MW + w * 64 + lane] = f2bf(v * r2 * mkn[l * 64 + lane]);
        MV[((size_t)l * MROWS + row) * MW + tid] = f2bf(c[l * 512 + 256 + tid] * rs);
    }
}
__global__ __launch_bounds__(256) void epi_resid(const float* __restrict__ C, int row0, const float* base, float* H, bf16_t* HB, float* ssn) {
    __shared__ float red[4];
    const int lr = blockIdx.x, row = row0 + lr, tid = threadIdx.x;
    float s = 0.f;
    for (int d = tid; d < DM; d += 256) { const float v = base[(size_t)row * DM + d] + C[(size_t)lr * DM + d]; H[(size_t)row * DM + d] = v; if (HB) HB[(size_t)row * DM + d] = f2bf(v); s += v * v; }
    s = wave_sum(s);
    if ((tid & 63) == 0) red[tid >> 6] = s;
    __syncthreads();
    if (tid == 0 && ssn) ssn[row] = red[0] + red[1] + red[2] + red[3];
}
__global__ __launch_bounds__(256) void epi_gateup(const float* __restrict__ C, int row0, const float* __restrict__ ss, bf16_t* ACT) {
    const int lr = blockIdx.x, row = row0 + lr, tid = threadIdx.x;
    const float rs = rs_of(ss, row);
    const float* c = C + (size_t)lr * (2 * FFN);
    for (int j = tid; j < FFN; j += 256) ACT[(size_t)row * FFN + j] = f2bf(silu_f(c[j] * rs) * (c[FFN + j] * rs));
}
__global__ __launch_bounds__(256) void epi_kvb(const float* __restrict__ C, int row0, const float* __restrict__ ss, const float* __restrict__ knorm, const float* __restrict__ qnorm  ,
                                               const float* __restrict__ mqn, const float* __restrict__ cs, const float* __restrict__ sn,
                                               bf16_t* KR, bf16_t* VS, bf16_t* QG, bf16_t* MQ) {
    const int lr = blockIdx.x, row = row0 + lr, tid = threadIdx.x, w = tid >> 6, lane = tid & 63;
    const int pos = row & (SEQ - 1);
    const float rs = rs_of(ss, row);
    const float* c = C + (size_t)lr * KVB_COLS;
    const float co = cs[pos * 64 + lane], si = sn[pos * 64 + lane];
    for (int hv = w; hv < 30; hv += 4) {
        const float x1 = c[hv * 128 + lane] * rs, x2 = c[hv * 128 + 64 + lane] * rs;
        if (hv >= 6 && hv < 12) { VS[(size_t)row * AW + (hv - 6) * 128 + lane] = f2bf(x1); VS[(size_t)row * AW + (hv - 6) * 128 + 64 + lane] = f2bf(x2); continue; }
        const float s2 = wave_sum(x1 * x1 + x2 * x2);
        const float r2 = rsqrtf(s2 * (1.f / 128.f) + EPS);
        const float* gn = hv < 6 ? knorm : qnorm + ((hv - 12) / 6) * 128;
        const float sc = hv < 6 ? 1.f : (0.08838834764831845f * LOG2E);
        const float y1 = x1 * r2 * gn[lane] * sc, y2 = x2 * r2 * gn[64 + lane] * sc;
        const float o1 = y1 * co - y2 * si, o2 = y2 * co + y1 * si;
        bf16_t* dst = hv < 6 ? KR + (size_t)row * AW + hv * 128 : QG + ((size_t)((hv - 12) / 6) * T + row) * AW + ((hv - 12) % 6) * 128;
        dst[lane] = f2bf(o1); dst[64 + lane] = f2bf(o2);
    }
    const float v = c[30 * 128 + w * 64 + lane] * rs;
    const float s2 = wave_sum(v * v);
    const float r2 = rsqrtf(s2 * (1.f / 64.f) + EPS);
    MQ[(size_t)row * MW + w * 64 + lane] = f2bf(v * r2 * mqn[lane] * (0.125f * LOG2E));
}
__global__ __launch_bounds__(256) void hgrn_kernel(const bf16_t* __restrict__ QS, const float* __restrict__ LF, const bf16_t* __restrict__ VV, const bf16_t* __restrict__ SG,
                                                   const float* __restrict__ onorm, bf16_t* MIX) {
    __shared__ float qs[128], kk[128], ff[128], vv[128], part[256], red[2];
    const int b = blockIdx.x / NH, h = blockIdx.x % NH, tid = threadIdx.x, dv = tid & 127, half = tid >> 7;
    float S[64];
#pragma unroll
    for (int i = 0; i < 64; ++i) S[i] = 0.f;
    for (int t = 0; t < SEQ; ++t) {
        const size_t off = (size_t)(b * SEQ + t) * AW + h * 128;
        if (tid < 128) { const float f = __expf(LF[off + tid]); ff[tid] = f; kk[tid] = 1.f - f; qs[tid] = bf2f(QS[off + tid]); vv[tid] = bf2f(VV[off + tid]); }
        __syncthreads();
        const float v = vv[dv]; float o = 0.f;
#pragma unroll
        for (int i = 0; i < 64; ++i) { const int dk = half * 64 + i; S[i] = ff[dk] * S[i] + kk[dk] * v; o += S[i] * qs[dk]; }
        part[tid] = o;
        __syncthreads();
        if (tid < 128) { o = part[tid] + part[tid + 128]; const float s2 = wave_sum(o * o); if ((tid & 63) == 0) red[tid >> 6] = s2; part[tid] = o; }
        __syncthreads();
        if (tid < 128) { const float r2 = rsqrtf((red[0] + red[1]) * (1.f / 128.f) + EPS);
            MIX[(size_t)(b * SEQ + t) * DM + h * 128 + tid] = f2bf(part[tid] * r2 * onorm[h * 128 + tid] * bf2f(SG[off + tid])); }
    }
}
__global__ __launch_bounds__(256) void memattn_kernel(const bf16_t* __restrict__ MQ, const bf16_t* __restrict__ MK, const bf16_t* __restrict__ MV, bf16_t* MIX) {
    __shared__ float qsh[4][64];
    const int w = threadIdx.x >> 6, lane = threadIdx.x & 63;
    const int item = blockIdx.x * 4 + w, row = item >> 2, hd = item & 3, b = row / SEQ;
    qsh[w][lane] = bf2f(MQ[(size_t)row * MW + hd * 64 + lane]);
    __syncthreads();
    float s[4], m = -1e30f;
#pragma unroll
    for (int j = 0; j < 4; ++j) { const bf16_t* kr = MK + ((size_t)(b * MEMT + lane + 64 * j)) * MW + hd * 64; float a = 0.f;
        for (int c8 = 0; c8 < 8; ++c8) { const bf16x8 kv = *(const bf16x8*)(kr + 8 * c8);
#pragma unroll
            for (int e = 0; e < 8; ++e) a += qsh[w][c8 * 8 + e] * bf2f((bf16_t)kv[e]); }
        s[j] = a; m = fmaxf(m, a); }
    m = wave_max(m);
    float l = 0.f;
#pragma unroll
    for (int j = 0; j < 4; ++j) { s[j] = exp2f(s[j] - m); l += s[j]; }
    l = wave_sum(l);
    float o = 0.f;
#pragma unroll
    for (int j = 0; j < 4; ++j)
        for (int kq = 0; kq < 64; ++kq) { const float p = __shfl(s[j], kq); o += p * bf2f(MV[((size_t)(b * MEMT + kq + 64 * j)) * MW + hd * 64 + lane]); }
    MIX[(size_t)row * DM + AW + hd * 64 + lane] = f2bf(o / l);
}
__global__ __launch_bounds__(256) void dilattn_kernel(const bf16_t* __restrict__ QG, const bf16_t* __restrict__ KR, const bf16_t* __restrict__ VS, bf16_t* MIX) {
    __shared__ float qsh[4][3][128];
    const int w = threadIdx.x >> 6, lane = threadIdx.x & 63;
    const int item = blockIdx.x * 4 + w, row = item / NH, h = item % NH, b = row / SEQ, t = row % SEQ;
#pragma unroll
    for (int g = 0; g < 3; ++g) { qsh[w][g][lane] = bf2f(QG[((size_t)g * T + row) * AW + h * 128 + lane]); qsh[w][g][64 + lane] = bf2f(QG[((size_t)g * T + row) * AW + h * 128 + 64 + lane]); }
    __syncthreads();
    float s[3][3]; float m = -1e30f;
#pragma unroll
    for (int g = 0; g < 3; ++g) { const int dil = g == 0 ? 1 : (g == 1 ? 4 : 16);
#pragma unroll
        for (int jj = 0; jj < 3; ++jj) { const int j = lane + 64 * jj; const int pk = t - j * dil; float a = -1e30f;
            if (j <= 128 && pk >= 0) { const bf16_t* kr = KR + ((size_t)(b * SEQ + pk)) * AW + h * 128; a = 0.f; for (int c8 = 0; c8 < 16; ++c8) { const bf16x8 kv = *(const bf16x8*)(kr + 8 * c8);
#pragma unroll
                for (int e = 0; e < 8; ++e) a += qsh[w][g][c8 * 8 + e] * bf2f((bf16_t)kv[e]); } }
            s[g][jj] = a; m = fmaxf(m, a); } }
    m = wave_max(m);
    float l = 0.f;
#pragma unroll
    for (int g = 0; g < 3; ++g)
#pragma unroll
        for (int jj = 0; jj < 3; ++jj) { const float p = s[g][jj] > -1e29f ? exp2f(s[g][jj] - m) : 0.f; s[g][jj] = p; l += p; }
    l = wave_sum(l);
    float o0 = 0.f, o1 = 0.f;
#pragma unroll
    for (int g = 0; g < 3; ++g) { const int dil = g == 0 ? 1 : (g == 1 ? 4 : 16);
#pragma unroll
        for (int jj = 0; jj < 3; ++jj) {
            const int nk = jj < 2 ? 64 : 1;
            for (int kq = 0; kq < nk; ++kq) { const int j = kq + 64 * jj; const int pk = t - j * dil; if (pk < 0) break;
                const float p = __shfl(s[g][jj], kq);
                const bf16_t* vr = VS + ((size_t)(b * SEQ + pk)) * AW + h * 128;
                o0 += p * bf2f(vr[lane]); o1 += p * bf2f(vr[64 + lane]); } } }
    MIX[(size_t)row * DM + h * 128 + lane] = f2bf(o0 / l); MIX[(size_t)row * DM + h * 128 + 64 + lane] = f2bf(o1 / l);
}
}

#define LAS __attribute__((address_space(3)))
#define GAS __attribute__((address_space(1)))

constexpr int NTHREADS = 512, NWAVES = 8;
constexpr int RING_BYTES = 131072;
constexpr int XSCR_OFF = RING_BYTES;
constexpr int LDS_BYTES = 151552;
constexpr int OST_OFF = 133120;
constexpr int MISC_OFF = LDS_BYTES - 256;

__host__ __device__ __forceinline__ int rho_of(int r) { return 16 * ((r >> 2) & 1) + 4 * (r >> 3) + (r & 3); }
__host__ __device__ __forceinline__ int slot_std(int c) { return (c & ~31) + rho_of(c & 31); }
__host__ __device__ __forceinline__ int slot_rope(int d) { return 32 * ((d & 63) >> 4) + 16 * (d >> 6) + (d & 15); }
__host__ __device__ __forceinline__ int slot_mq(int c) { return 128 * ((c >> 5) & 1) + 32 * (c >> 6) + rho_of(c & 31); }
enum { MAP_WA = 0, MAP_KV = 1, MAP_BIN = 2, MAP_STD = 3, MAP_GU = 4, MAP_MKV0 = 5, MAP_MKV1 = 6 };
__device__ __forceinline__ int dst_row(int map, int n) {
    switch (map) {
    case MAP_WA:  return n < 3072 ? (n & ~127) + slot_std(n & 127) : 3072 + slot_mq(n - 3072);
    case MAP_KV:  return n < 768 ? (n & ~127) + slot_rope(n & 127) : (n & ~127) + slot_std(n & 127);
    case MAP_BIN: return n < 2304 ? 1536 + (n & ~127) + slot_std(n & 127) : 3840 + slot_mq(n - 2304);
    case MAP_STD: return (n & ~127) + slot_std(n & 127);
    case MAP_GU:  return n < FFN ? 256 * (n >> 7) + slot_std(n & 127) : 256 * ((n - FFN) >> 7) + 128 + slot_std((n - FFN) & 127);
    case MAP_MKV0: return n < 256 ? slot_mq(n) : 256 + ((n - 256) & ~127) + slot_std((n - 256) & 127);
    default:       return 512 + (n < 256 ? slot_mq(n) : 256 + ((n - 256) & ~127) + slot_std((n - 256) & 127));
    }
}

typedef float f32x2_t __attribute__((ext_vector_type(2))); typedef __bf16 bf16x2_t __attribute__((ext_vector_type(2)));
__device__ __forceinline__ unsigned cvt_pk_bf16(float lo, float hi) { f32x2_t v = {lo, hi}; bf16x2_t b = __builtin_convertvector(v, bf16x2_t); return __builtin_bit_cast(unsigned, b); }
__device__ __forceinline__ float fast_sigmoid(float v) { return __builtin_amdgcn_rcpf(1.f + __builtin_amdgcn_exp2f(-LOG2E * v)); }
__device__ __forceinline__ float fast_silu(float v) { return v * fast_sigmoid(v); }

__device__ __forceinline__ float row16_sum(float v) {
    v += __builtin_bit_cast(float, __builtin_amdgcn_mov_dpp(__builtin_bit_cast(int, v), 0x128, 0xf, 0xf, true));
    v += __builtin_bit_cast(float, __builtin_amdgcn_mov_dpp(__builtin_bit_cast(int, v), 0x124, 0xf, 0xf, true));
    v += __builtin_bit_cast(float, __builtin_amdgcn_mov_dpp(__builtin_bit_cast(int, v), 0x122, 0xf, 0xf, true));
    v += __builtin_bit_cast(float, __builtin_amdgcn_mov_dpp(__builtin_bit_cast(int, v), 0x121, 0xf, 0xf, true));
    return v; }
__device__ __forceinline__ float xrow_sum(float v) {
    { auto r = __builtin_amdgcn_permlane16_swap(__float_as_uint(v), __float_as_uint(v), false, false); v = __uint_as_float(r[0]) + __uint_as_float(r[1]); }
    { auto r = __builtin_amdgcn_permlane32_swap(__float_as_uint(v), __float_as_uint(v), false, false); v = __uint_as_float(r[0]) + __uint_as_float(r[1]); }
    return v; }
__device__ __forceinline__ float xrow_max(float v) {
    { auto r = __builtin_amdgcn_permlane16_swap(__float_as_uint(v), __float_as_uint(v), false, false); v = fmaxf(__uint_as_float(r[0]), __uint_as_float(r[1])); }
    { auto r = __builtin_amdgcn_permlane32_swap(__float_as_uint(v), __float_as_uint(v), false, false); v = fmaxf(__uint_as_float(r[0]), __uint_as_float(r[1])); }
    return v; }
__device__ __forceinline__ int fresh_tid(int wave_s) { int t = wave_s * 64 + (int)__builtin_amdgcn_mbcnt_hi(~0u, __builtin_amdgcn_mbcnt_lo(~0u, 0u)); asm volatile("" : "+v"(t)); return t; }
namespace pg8 {
constexpr int BM = 256, BK = 64, HALF = 128, HTB = HALF * BK * 2, STAGE_BYTES = 8 * HTB, NXCD = 8, WGM = 8;
__host__ __device__ __forceinline__ int lds_byte(int r, int c) { const int st = (r >> 4) * 2 + (c >> 5), rr = r & 15, cc = c & 31, ob = rr * 64 + cc * 2; return st * 1024 + (ob ^ (((ob >> 9) & 1) << 5)); }
__host__ __device__ __forceinline__ void stage_rc(int b, int& R, int& C) { const int st = b / 1024, sb = b % 1024, swz = sb ^ (((sb >> 9) & 1) << 5); R = (st >> 1) * 16 + swz / 64; C = (st & 1) * 32 + (swz % 64) / 2; }
struct Unit { int pm, pn; };
struct StaticOrder {
    int nM, nN, nwg, G, c, direct;
    __device__ void init(int M, int N, int G_, int c_) { nM = M / BM; nN = N / BM; nwg = nM * nN; G = G_; c = c_; direct = 0; }
    __device__ bool next(int i, Unit& u) const {
        const long L = (long)i * G + c; if (L >= nwg) return false;
        if (direct) { u.pm = c % nM; u.pn = c / nM; return true; }
        int wgid = (int)L; { const int q = nwg / NXCD, r = nwg % NXCD, xcd = wgid % NXCD, off = wgid / NXCD; wgid = (xcd < r ? xcd * (q + 1) : r * (q + 1) + (xcd - r) * q) + off; }
        const int nig = WGM * nN, gid = wgid / nig, fm = gid * WGM, gsz = (nM - fm) < WGM ? (nM - fm) : WGM;
        u.pm = fm + ((wgid % nig) % gsz); u.pn = (wgid % nig) / gsz; return true;
    }
};
typedef f32x4 Acc[2][2][4][2];

template <bool ALIGN_EPI = true, class Epi>
__device__ __forceinline__ void gemm_phase(LAS unsigned char* lds, int wave_s, const bf16_t* A, const bf16_t* Bt, int M, int N, int K, const StaticOrder& S, const Epi& E) {
    const int tid = fresh_tid(wave_s);
    const int wid = __builtin_amdgcn_readfirstlane(tid >> 6), lane = tid & 63, wr = wid >> 2, wc = wid & 3, fr = lane & 15, fq = lane >> 4;
    const int nt = K / BK;
#ifdef STAGGER_TICKS
    { const unsigned long long t0 = __builtin_amdgcn_s_memrealtime(); const unsigned long long dl = (unsigned long long)((blockIdx.x >> 3) & 3) * STAGGER_TICKS;
      while (__builtin_amdgcn_s_memrealtime() - t0 < dl) __builtin_amdgcn_s_sleep(16); }
#endif
    unsigned voff[2];
#pragma unroll
    for (int i = 0; i < 2; ++i) { int R, C; stage_rc(tid * 16 + i * 8192, R, C); voff[i] = (unsigned)(R * K + C) * 2u; }
    const size_t kstep = (size_t)(BK * 2);
    const size_t hstep = (size_t)HALF * K * 2;
    const size_t tstep = 2 * hstep;
    const unsigned ldsw = (unsigned)wid * 1024u;
    const int aoff = lds_byte(wr * 64 + fr, fq * 8), boff = lds_byte(wc * 32 + fr, fq * 8);
#define PG8_SA(b, h) (((b) * 2 + (h)) * HTB)
#define PG8_SB(b, h) ((4 + (b) * 2 + (h)) * HTB)
#define PG8_STAGE(bufoff, gbase) do { _Pragma("unroll") for (int _i = 0; _i < 2; ++_i) \
        __builtin_amdgcn_global_load_lds((const unsigned*)((const char*)(gbase) + voff[_i]), (LAS unsigned*)(lds + (bufoff) + ldsw + _i * 8192), 16, 0, 0); } while (0)
#define PG8_LDA(dst, b, h) do { _Pragma("unroll") for (int m = 0; m < 4; ++m) _Pragma("unroll") for (int k = 0; k < 2; ++k) dst[m][k] = *(const LAS bf16x8*)(lds + PG8_SA(b, h) + aoff + m * 2048 + k * 1024); } while (0)
#define PG8_LDB(dst, b, h) do { _Pragma("unroll") for (int n = 0; n < 2; ++n) _Pragma("unroll") for (int k = 0; k < 2; ++k) dst[n][k] = *(const LAS bf16x8*)(lds + PG8_SB(b, h) + boff + n * 2048 + k * 1024); } while (0)
#define PG8_MMA(ai, bj, At, Bt_) do { __builtin_amdgcn_s_setprio(1); _Pragma("unroll") for (int m = 0; m < 4; ++m) _Pragma("unroll") for (int n = 0; n < 2; ++n) _Pragma("unroll") for (int k = 0; k < 2; ++k) \
        acc[ai][bj][m][n] = __builtin_amdgcn_mfma_f32_16x16x32_bf16(Bt_[n][k], At[m][k], acc[ai][bj][m][n], 0, 0, 0); __builtin_amdgcn_s_setprio(0); } while (0)
#define PG8_WAIT_V(n) asm volatile("s_waitcnt vmcnt(" #n ")" ::: "memory")
#define PG8_WAIT_L(n) asm volatile("s_waitcnt lgkmcnt(" #n ")" ::: "memory")
#define PG8_BAR __builtin_amdgcn_s_barrier()
#define PG8_SCHED __builtin_amdgcn_sched_barrier(0)
    Unit cur, nxt; int ui = 0;
    if (!S.next(0, cur)) return;
    Acc acc;
#pragma unroll
    for (int a = 0; a < 2; ++a)
#pragma unroll
        for (int b = 0; b < 2; ++b)
#pragma unroll
            for (int m = 0; m < 4; ++m)
#pragma unroll
                for (int n = 0; n < 2; ++n) acc[a][b][m][n] = (f32x4){0.f, 0.f, 0.f, 0.f};
    bf16x8 At[4][2], B0[2][2], B1[2][2];
    const char* cA = (const char*)A + (size_t)cur.pm * tstep; const char* cB = (const char*)Bt + (size_t)cur.pn * tstep;
    PG8_STAGE(PG8_SB(0, 0), cB); PG8_STAGE(PG8_SB(0, 1), cB + hstep); PG8_STAGE(PG8_SA(0, 0), cA); PG8_STAGE(PG8_SA(0, 1), cA + hstep);
    if (wr == 1) PG8_BAR;
    PG8_WAIT_V(2); PG8_BAR;
    PG8_STAGE(PG8_SB(1, 0), cB + kstep); PG8_STAGE(PG8_SA(1, 0), cA + kstep); PG8_STAGE(PG8_SB(1, 1), cB + hstep + kstep);
    PG8_WAIT_V(6); PG8_BAR;
    for (;;) {
        const bool has_next = S.next(ui + 1, nxt);
        const char* nA = has_next ? (const char*)A + (size_t)nxt.pm * tstep : cA; const char* nB = has_next ? (const char*)Bt + (size_t)nxt.pn * tstep : cB;
        for (int t = 0; t < nt; t += 2) {
            const bool last = (t == nt - 2);
            const char* a1 = cA + (size_t)(t + 1) * kstep;
            const char* a2 = last ? nA : cA + (size_t)(t + 2) * kstep; const char* b2 = last ? nB : cB + (size_t)(t + 2) * kstep;
            const char* a3 = a2 + kstep; const char* b3 = b2 + kstep;
            PG8_LDB(B0, 0, 0); PG8_LDB(B1, 0, 1); PG8_SCHED; PG8_LDA(At, 0, 0); PG8_STAGE(PG8_SA(1, 1), a1 + hstep);
            PG8_WAIT_V(8); PG8_WAIT_L(0); PG8_BAR; PG8_MMA(0, 0, At, B0); PG8_MMA(0, 1, At, B1); PG8_BAR; PG8_SCHED;
            PG8_LDA(At, 0, 1); PG8_STAGE(PG8_SB(0, 0), b2); PG8_STAGE(PG8_SB(0, 1), b2 + hstep); PG8_STAGE(PG8_SA(0, 0), a2);
            PG8_WAIT_V(8); PG8_WAIT_L(0); PG8_BAR; PG8_MMA(1, 0, At, B0); PG8_MMA(1, 1, At, B1); PG8_BAR; PG8_SCHED;
            PG8_LDB(B0, 1, 0); PG8_LDB(B1, 1, 1); PG8_SCHED; PG8_LDA(At, 1, 0); PG8_STAGE(PG8_SA(0, 1), a2 + hstep);
            PG8_WAIT_V(8); PG8_WAIT_L(0); PG8_BAR; PG8_MMA(0, 0, At, B0); PG8_MMA(0, 1, At, B1); PG8_BAR; PG8_SCHED;
            PG8_LDA(At, 1, 1); PG8_STAGE(PG8_SB(1, 0), b3); PG8_STAGE(PG8_SB(1, 1), b3 + hstep); PG8_STAGE(PG8_SA(1, 0), a3);
            PG8_WAIT_V(8); PG8_WAIT_L(0); PG8_BAR; PG8_MMA(1, 0, At, B0); PG8_MMA(1, 1, At, B1); PG8_BAR; PG8_SCHED;
        }
        if (ALIGN_EPI) { if (wr == 0) PG8_BAR; }
        { int fr_ = fr, fq_ = fq; asm volatile("" : "+v"(fr_), "+v"(fq_));
          E(acc, cur, wr, wc, fr_, fq_, lds); }
        if (!has_next) break;
#pragma unroll
        for (int a = 0; a < 2; ++a)
#pragma unroll
            for (int b = 0; b < 2; ++b)
#pragma unroll
                for (int m = 0; m < 4; ++m)
#pragma unroll
                    for (int n = 0; n < 2; ++n) acc[a][b][m][n] = (f32x4){0.f, 0.f, 0.f, 0.f};
        cur = nxt; cA = nA; cB = nB; ++ui;
        if (ALIGN_EPI) { if (wr == 1) PG8_BAR; }
    }
    PG8_WAIT_V(0);
    if (!ALIGN_EPI) { if (wr == 0) PG8_BAR; }
    PG8_BAR;
#undef PG8_SA
#undef PG8_SB
#undef PG8_STAGE
#undef PG8_LDA
#undef PG8_LDB
#undef PG8_MMA
#undef PG8_WAIT_V
#undef PG8_WAIT_L
#undef PG8_BAR
#undef PG8_SCHED
}

__device__ __forceinline__ float rs_of(const float* ss, int row) { return __builtin_amdgcn_rsqf(ss[row] * (1.f / DM) + EPS); }
__device__ __forceinline__ u32x4 pack8(const f32x4& a, const f32x4& b) { u32x4 w; w.x = cvt_pk_bf16(a[0], a[1]); w.y = cvt_pk_bf16(a[2], a[3]); w.z = cvt_pk_bf16(b[0], b[1]); w.w = cvt_pk_bf16(b[2], b[3]); return w; }
__device__ __forceinline__ void load_rs8(const float* ss, int row0, float (&rs)[2][4]) {
#pragma unroll
    for (int ai = 0; ai < 2; ++ai)
#pragma unroll
        for (int m = 0; m < 4; ++m) rs[ai][m] = ss[row0 + ai * HALF + m * 16];
#pragma unroll
    for (int ai = 0; ai < 2; ++ai)
#pragma unroll
        for (int m = 0; m < 4; ++m) rs[ai][m] = __builtin_amdgcn_rsqf(rs[ai][m] * (1.f / DM) + EPS);
}

__device__ __forceinline__ void head64_store(f32x4 a0, f32x4 a1, f32x4 b0, f32x4 b1, float rs, const f32x4 (&gn)[4], float scale, bf16_t* dst  , int fq) {
    a0 *= rs; a1 *= rs; b0 *= rs; b1 *= rs;
    float s = 0.f;
#pragma unroll
    for (int e = 0; e < 4; ++e) s += a0[e] * a0[e] + a1[e] * a1[e] + b0[e] * b0[e] + b1[e] * b1[e];
    s = xrow_sum(s);
    const float r2 = __builtin_amdgcn_rsqf(s * (1.f / 64.f) + EPS) * scale;
    *(u32x4*)(dst + 8 * fq) = pack8(a0 * gn[0] * r2, a1 * gn[1] * r2);
    *(u32x4*)(dst + 32 + 8 * fq) = pack8(b0 * gn[2] * r2, b1 * gn[3] * r2);
}
__device__ __forceinline__ void load_gain64(const float* gain, int fq, f32x4 (&gn)[4]) {
    gn[0] = *(const f32x4*)(gain + 8 * fq); gn[1] = *(const f32x4*)(gain + 8 * fq + 4); gn[2] = *(const f32x4*)(gain + 32 + 8 * fq); gn[3] = *(const f32x4*)(gain + 32 + 8 * fq + 4);
}

struct EpiInproj0 {
    const float* ss; const float* lb; const float* mqn; bf16_t* QS; unsigned short* LF; bf16_t* VV; bf16_t* SG; bf16_t* MQ;
    __device__ __forceinline__ void operator()(const Acc& acc, const Unit& u, int wr, int wc, int fr, int fq, LAS unsigned char*) const {
        const int row0 = u.pm * BM + wr * 64 + fr, pn = u.pn;
        float rs[2][4]; load_rs8(ss, row0, rs);
        if (pn == 12) {
            f32x4 gn[4]; load_gain64(mqn, fq, gn);
#pragma unroll
            for (int ai = 0; ai < 2; ++ai)
#pragma unroll
                for (int m = 0; m < 4; ++m) { const int row = row0 + ai * HALF + m * 16;
                    head64_store(acc[ai][0][m][0], acc[ai][0][m][1], acc[ai][1][m][0], acc[ai][1][m][1], rs[ai][m], gn, 0.125f * LOG2E, MQ + (size_t)row * MW + 64 * wc, fq); }
            return;
        }
        const int kind = pn / 3, colb = (pn % 3) * 256 + wc * 32 + 8 * fq;
        if (kind == 1) {
            f32x4 lbv[2][2];
#pragma unroll
            for (int bj = 0; bj < 2; ++bj) { lbv[bj][0] = *(const f32x4*)(lb + colb + bj * HALF); lbv[bj][1] = *(const f32x4*)(lb + colb + bj * HALF + 4); }
#pragma unroll
            for (int ai = 0; ai < 2; ++ai)
#pragma unroll
                for (int m = 0; m < 4; ++m) { const int row = row0 + ai * HALF + m * 16; const float r = rs[ai][m];
#pragma unroll
                    for (int bj = 0; bj < 2; ++bj) { f32x4 v0 = acc[ai][bj][m][0] * r, v1 = acc[ai][bj][m][1] * r; const size_t o = (size_t)row * AW + colb + bj * HALF;
#pragma unroll
                        for (int e = 0; e < 4; ++e) { const float l0 = lbv[bj][0][e], l1 = lbv[bj][1][e];
                            v0[e] = __builtin_amdgcn_logf(l0 + (1.f - l0) * fast_sigmoid(v0[e])); v1[e] = __builtin_amdgcn_logf(l1 + (1.f - l1) * fast_sigmoid(v1[e])); }
                        typedef _Float16 h2_t __attribute__((ext_vector_type(2)));
                        u32x4 w; { h2_t p0 = {(_Float16)v0[0], (_Float16)v0[1]}, p1 = {(_Float16)v0[2], (_Float16)v0[3]}, p2 = {(_Float16)v1[0], (_Float16)v1[1]}, p3 = {(_Float16)v1[2], (_Float16)v1[3]};
                            w.x = __builtin_bit_cast(unsigned, p0); w.y = __builtin_bit_cast(unsigned, p1); w.z = __builtin_bit_cast(unsigned, p2); w.w = __builtin_bit_cast(unsigned, p3); }
                        *(u32x4*)(LF + o) = w; } }
            return;
        }
        bf16_t* dst = QS + (size_t)(kind == 0 ? 0 : kind - 1) * ((size_t)T * AW);
#pragma unroll
        for (int ai = 0; ai < 2; ++ai)
#pragma unroll
            for (int m = 0; m < 4; ++m) { const int row = row0 + ai * HALF + m * 16; const float r = rs[ai][m];
#pragma unroll
                for (int bj = 0; bj < 2; ++bj) { f32x4 v0 = acc[ai][bj][m][0] * r, v1 = acc[ai][bj][m][1] * r; const size_t o = (size_t)row * AW + colb + bj * HALF;
                    if (kind != 2) {
#pragma unroll
                        for (int e = 0; e < 4; ++e) { v0[e] = fast_silu(v0[e]); v1[e] = fast_silu(v1[e]); } }
                    *(u32x4*)(dst + o) = pack8(v0, v1); } }
    }
};
struct EpiMemKV {
    const float* ss; const float* mkn; bf16_t* MK; bf16_t* MV;
    __device__ __forceinline__ void operator()(const Acc& acc, const Unit& u, int wr, int wc, int fr, int fq, LAS unsigned char*) const {
        const int row0 = u.pm * BM + wr * 64 + fr, l = u.pn >> 1;
        float rs[2][4]; load_rs8(ss, row0, rs);
        f32x4 gn[4]; load_gain64(mkn + l * 64, fq, gn);
#pragma unroll
        for (int ai = 0; ai < 2; ++ai)
#pragma unroll
            for (int m = 0; m < 4; ++m) { const int row = row0 + ai * HALF + m * 16; const float r = rs[ai][m];
                if ((u.pn & 1) == 0) head64_store(acc[ai][0][m][0], acc[ai][0][m][1], acc[ai][1][m][0], acc[ai][1][m][1], r, gn, 1.f, MK + ((size_t)l * MROWS + row) * MW + 64 * wc, fq);
                else {
#pragma unroll
                    for (int bj = 0; bj < 2; ++bj) *(u32x4*)(MV + ((size_t)l * MROWS + row) * MW + bj * HALF + wc * 32 + 8 * fq) = pack8(acc[ai][bj][m][0] * r, acc[ai][bj][m][1] * r); } }
    }
};
template <bool BF_IN, bool F32_OUT>
struct EpiResid {
    const float* base; float* H; bf16_t* HB; float* ssn;
    __device__ __forceinline__ void operator()(const Acc& acc, const Unit& u, int wr, int wc, int fr, int fq, LAS unsigned char*) const {
        const int row0 = u.pm * BM + wr * 64 + fr, col0 = u.pn * BM + wc * 32 + 8 * fq;
        const unsigned e00 = (unsigned)(row0 * DM + col0);
        const char* bp = (const char*)base; char* hp = (char*)H; char* hbp = (char*)HB;
        f32x4 bs[2][2][2][2];
        u32x4 bb[2][2][2];
#define RES_LOAD(buf, k) do { _Pragma("unroll") for (int m2 = 0; m2 < 2; ++m2) _Pragma("unroll") for (int bj = 0; bj < 2; ++bj) { \
            const unsigned e = e00 + (unsigned)((((k) >> 1) * HALF + (((k) & 1) * 2 + m2) * 16) * DM + bj * HALF); \
            if (BF_IN) bb[buf][m2][bj] = *(const u32x4*)(hbp + e * 2u); \
            else { bs[buf][m2][bj][0] = *(const f32x4*)(bp + e * 4u); bs[buf][m2][bj][1] = *(const f32x4*)(bp + e * 4u + 16); } } } while (0)
        RES_LOAD(0, 0);
#pragma unroll
        for (int k = 0; k < 4; ++k) {
            if (k < 3) RES_LOAD((k + 1) & 1, k + 1);
#pragma unroll
            for (int m2 = 0; m2 < 2; ++m2) { const int ai = k >> 1, m = (k & 1) * 2 + m2; const int row = row0 + ai * HALF + m * 16; float s = 0.f;
#pragma unroll
                for (int bj = 0; bj < 2; ++bj) { const unsigned e = e00 + (unsigned)((ai * HALF + m * 16) * DM + bj * HALF);
                    f32x4 b0, b1;
                    if (BF_IN) { const u32x4 w = bb[k & 1][m2][bj];
                        b0 = (f32x4){__uint_as_float(w.x << 16), __uint_as_float(w.x & 0xffff0000u), __uint_as_float(w.y << 16), __uint_as_float(w.y & 0xffff0000u)};
                        b1 = (f32x4){__uint_as_float(w.z << 16), __uint_as_float(w.z & 0xffff0000u), __uint_as_float(w.w << 16), __uint_as_float(w.w & 0xffff0000u)}; }
                    else { b0 = bs[k & 1][m2][bj][0]; b1 = bs[k & 1][m2][bj][1]; }
                    const f32x4 v0 = b0 + acc[ai][bj][m][0], v1 = b1 + acc[ai][bj][m][1];
                    if (F32_OUT) { __builtin_nontemporal_store(v0, (f32x4*)(hp + e * 4u)); __builtin_nontemporal_store(v1, (f32x4*)(hp + e * 4u + 16)); }
                    else { *(u32x4*)(hbp + e * 2u) = pack8(v0, v1);
#pragma unroll
                        for (int q = 0; q < 4; ++q) s += v0[q] * v0[q] + v1[q] * v1[q]; } }
                if (!F32_OUT) { s = xrow_sum(s); if (fq == 0) atomicAdd(ssn + row, s); } }
            asm volatile("" ::: "memory"); }
#undef RES_LOAD
    }
};
struct EpiNull {
    __device__ __forceinline__ void operator()(const Acc& acc, const Unit&, int, int, int, int, LAS unsigned char*) const {
#pragma unroll
        for (int a = 0; a < 2; ++a)
#pragma unroll
            for (int b = 0; b < 2; ++b)
#pragma unroll
                for (int m = 0; m < 4; ++m)
#pragma unroll
                    for (int n = 0; n < 2; ++n) asm volatile("" :: "v"(acc[a][b][m][n]));
    }
};
struct EpiGateUp {
    const float* ss; bf16_t* ACT;
    __device__ __forceinline__ void operator()(const Acc& acc, const Unit& u, int wr, int wc, int fr, int fq, LAS unsigned char*) const {
        const int row0 = u.pm * BM + wr * 64 + fr, col0 = u.pn * HALF + wc * 32 + 8 * fq;
        float rs[2][4]; load_rs8(ss, row0, rs);
#pragma unroll
        for (int ai = 0; ai < 2; ++ai)
#pragma unroll
            for (int m = 0; m < 4; ++m) { const int row = row0 + ai * HALF + m * 16; const float r = rs[ai][m];
                f32x4 o0, o1;
#pragma unroll
                for (int e = 0; e < 4; ++e) { o0[e] = fast_silu(acc[ai][0][m][0][e] * r) * (acc[ai][1][m][0][e] * r); o1[e] = fast_silu(acc[ai][0][m][1][e] * r) * (acc[ai][1][m][1][e] * r); }
                *(u32x4*)(ACT + (size_t)row * FFN + col0) = pack8(o0, o1); }
    }
};
struct EpiKVB {
    const float* ss; const float* knorm; const float* qnorm; const float* mqn; const float* cs; const float* sn; bf16_t* KR; bf16_t* VS; bf16_t* QG; bf16_t* MQ;
    __device__ __forceinline__ void operator()(const Acc& acc, const Unit& u, int wr, int wc, int fr, int fq, LAS unsigned char* lds) const {
        const int row0 = u.pm * BM + wr * 64 + fr, pn = u.pn;
        float rs[2][4]; load_rs8(ss, row0, rs);
        if (pn == 15) {
            f32x4 gn[4]; load_gain64(mqn, fq, gn);
#pragma unroll
            for (int ai = 0; ai < 2; ++ai)
#pragma unroll
                for (int m = 0; m < 4; ++m) { const int row = row0 + ai * HALF + m * 16;
                    head64_store(acc[ai][0][m][0], acc[ai][0][m][1], acc[ai][1][m][0], acc[ai][1][m][1], rs[ai][m], gn, 0.125f * LOG2E, MQ + (size_t)row * MW + 64 * wc, fq); }
            return;
        }
        if (pn >= 3) {
            char* dstb = (char*)(KR + (size_t)(pn / 3) * ((size_t)T * AW));
            const unsigned o0 = (unsigned)(row0 * AW + (pn % 3) * 256 + wc * 32 + 8 * fq) * 2u;
#pragma unroll
            for (int ai = 0; ai < 2; ++ai)
#pragma unroll
                for (int m = 0; m < 4; ++m) { const float r = rs[ai][m];
#pragma unroll
                    for (int bj = 0; bj < 2; ++bj) *(u32x4*)(dstb + o0 + (unsigned)((ai * HALF + m * 16) * AW + bj * HALF) * 2u) = pack8(acc[ai][bj][m][0] * r, acc[ai][bj][m][1] * r); }
            return;
        }
        LAS float* P = (LAS float*)(lds + XSCR_OFF);
        const int d = 16 * wc + 4 * fq;
        f32x4 co[4], si[4];
#define ROPE_LOAD(ai) do { _Pragma("unroll") for (int m = 0; m < 4; ++m) { const int pos = (row0 + (ai) * HALF + m * 16) & (SEQ - 1); co[m] = *(const f32x4*)(cs + pos * 64 + d); si[m] = *(const f32x4*)(sn + pos * 64 + d); } } while (0)
        ROPE_LOAD(0);
#pragma unroll
        for (int ai = 0; ai < 2; ++ai)
#pragma unroll
            for (int m = 0; m < 4; ++m) { const int rl = ai * HALF + wr * 64 + m * 16 + fr; const float r = rs[ai][m];
#pragma unroll
                for (int bj = 0; bj < 2; ++bj) { const f32x4 a = acc[ai][bj][m][0] * r, b = acc[ai][bj][m][1] * r; float s = 0.f;
#pragma unroll
                    for (int e = 0; e < 4; ++e) s += a[e] * a[e] + b[e] * b[e];
                    s = xrow_sum(s);
                    if (fq == 0) P[(rl * 2 + bj) * 4 + wc] = s; } }
        asm volatile("s_waitcnt lgkmcnt(0)" ::: "memory"); __builtin_amdgcn_s_barrier(); asm volatile("" ::: "memory");
        const int hp = pn; const float* gn = knorm; const float sc = 1.f; bf16_t* dstb = KR;
        const f32x4 g1 = *(const f32x4*)(gn + d), g2 = *(const f32x4*)(gn + 64 + d);
#pragma unroll
        for (int ai = 0; ai < 2; ++ai)
#pragma unroll
            for (int m = 0; m < 4; ++m) { const int rl = ai * HALF + wr * 64 + m * 16 + fr, row = u.pm * BM + rl; const float r = rs[ai][m];
                if (ai == 1 && m == 0) { asm volatile("" ::: "memory"); ROPE_LOAD(1); }
#pragma unroll
                for (int bj = 0; bj < 2; ++bj) { const f32x4 pp = *(const LAS f32x4*)(P + (rl * 2 + bj) * 4);
                    const float r2 = __builtin_amdgcn_rsqf(((pp[0] + pp[1]) + (pp[2] + pp[3])) * (1.f / 128.f) + EPS) * r * sc;
                    const f32x4 y1 = acc[ai][bj][m][0] * g1 * r2, y2 = acc[ai][bj][m][1] * g2 * r2;
                    const f32x4 o1 = y1 * co[m] - y2 * si[m], o2 = y2 * co[m] + y1 * si[m];
                    bf16_t* dst = dstb + (size_t)row * AW + (2 * hp + bj) * 128 + d;
                    u32x2 w1, w2; w1.x = cvt_pk_bf16(o1[0], o1[1]); w1.y = cvt_pk_bf16(o1[2], o1[3]); w2.x = cvt_pk_bf16(o2[0], o2[1]); w2.y = cvt_pk_bf16(o2[2], o2[3]);
                    *(u32x2*)dst = w1; *(u32x2*)(dst + 64) = w2; } }
#undef ROPE_LOAD
    }
};
}


typedef short s16x4 __attribute__((ext_vector_type(4)));
__device__ __forceinline__ unsigned off_b(unsigned row, unsigned ch) { return 256u * row + 16u * (ch ^ (((row & 3) << 2) | ((row >> 2) & 3))); }
__device__ __forceinline__ unsigned off_k(unsigned row, unsigned ch) { return 256u * row + 16u * (ch ^ (row & 15)); }
__device__ __forceinline__ unsigned rowrdk(unsigned lane, unsigned rb, unsigned s) { return off_k((lane & 15) + 16 * rb, 4 * s + (lane >> 4)); }
__device__ __forceinline__ unsigned rowrd16(unsigned lane, unsigned rb, unsigned s) { return off_b((lane & 15) + 16 * rb, 4 * s + (lane >> 4)); }
__device__ __forceinline__ unsigned trrd(unsigned lane, unsigned rowbase, unsigned c) { const unsigned q = (lane & 15) >> 2, p = lane & 3; return off_b(rowbase + q, 2 * c + (p >> 1)) + 8 * (p & 1); }
__device__ __forceinline__ unsigned off_v(unsigned row, unsigned ch) { return 256u * row + 16u * (ch ^ (2u * (row & 7u))); }
__device__ __forceinline__ unsigned trrd_v(unsigned lane, unsigned rowbase, unsigned c) { const unsigned q = (lane & 15) >> 2, p = lane & 3; return off_v(rowbase + q, 2 * c + (p >> 1)) + 8 * (p & 1); }
__device__ __forceinline__ unsigned off_h(unsigned row, unsigned ch) { return 128u * row + 16u * (ch ^ ((row >> 1) & 7)); }
__device__ __forceinline__ s16x4 tr_read(LAS unsigned char* p) { return __builtin_bit_cast(s16x4, __builtin_amdgcn_ds_read_tr16_b64_v4i16((LAS s16x4*)p)); }
__device__ __forceinline__ bf16x8 cat8(s16x4 lo, s16x4 hi) { return (bf16x8){lo[0], lo[1], lo[2], lo[3], hi[0], hi[1], hi[2], hi[3]}; }
#define MFMA16(a, b, c) __builtin_amdgcn_mfma_f32_16x16x32_bf16(a, b, c, 0, 0, 0)
#define LDS_BARRIER() do { asm volatile("s_waitcnt vmcnt(0) lgkmcnt(0)" ::: "memory"); __builtin_amdgcn_s_barrier(); asm volatile("" ::: "memory"); } while (0)
#define LDS_ONLY_BARRIER() do { asm volatile("s_waitcnt lgkmcnt(0)" ::: "memory"); __builtin_amdgcn_s_barrier(); asm volatile("" ::: "memory"); } while (0)

template <int NT, int NDT>
__device__ __forceinline__ float attn_softmax_pv(LAS unsigned char* Vimg, f32x4 (&st)[NT], int t0, int lane, f32x4 (&o)[NDT], float& mx_out) {
    const int g = lane >> 4;
    float mx = -1e30f;
#pragma unroll
    for (int i = 0; i < NT; ++i)
#pragma unroll
        for (int e = 0; e < 4; ++e) mx = fmaxf(mx, st[i][e]);
    mx = xrow_max(mx);
    float l = 0.f;
#pragma unroll
    for (int i = 0; i < NT; ++i)
#pragma unroll
        for (int e = 0; e < 4; ++e) { const float p = __builtin_amdgcn_exp2f(st[i][e] - mx); st[i][e] = p; l += p; }
    l = xrow_sum(l);
    u32x4 pwv[(NT + 1) / 2];
#pragma unroll
    for (int pr = 0; pr < (NT + 1) / 2; ++pr) { const bool has1 = (2 * pr + 1 < NT);
        pwv[pr].x = cvt_pk_bf16(st[2 * pr][0], st[2 * pr][1]); pwv[pr].y = cvt_pk_bf16(st[2 * pr][2], st[2 * pr][3]);
        if (has1) { pwv[pr].z = cvt_pk_bf16(st[has1 ? 2 * pr + 1 : 0][0], st[has1 ? 2 * pr + 1 : 0][1]); pwv[pr].w = cvt_pk_bf16(st[has1 ? 2 * pr + 1 : 0][2], st[has1 ? 2 * pr + 1 : 0][3]); } else { pwv[pr].z = 0u; pwv[pr].w = 0u; } }
#pragma unroll
    for (int dt = 0; dt < NDT; ++dt) o[dt] = (f32x4){0.f, 0.f, 0.f, 0.f};
    s16x4 vlo[2][NDT], vhi[2][NDT];
#define ATT_VLOAD(buf, pr_) do { const int T0_ = t0 + 2 * (pr_); int T1_ = T0_ + 1; if (T1_ > 15) T1_ = 15; \
        _Pragma("unroll") for (int dt = 0; dt < NDT; ++dt) { vlo[buf][dt] = tr_read(Vimg + trrd_v(lane, 16 * T0_ + 4 * g, dt)); vhi[buf][dt] = tr_read(Vimg + trrd_v(lane, 16 * T1_ + 4 * g, dt)); } } while (0)
    ATT_VLOAD(0, 0);
#pragma unroll
    for (int pr = 0; pr < (NT + 1) / 2; ++pr) {
        if (pr + 1 < (NT + 1) / 2) ATT_VLOAD((pr + 1) & 1, pr + 1);
        const bf16x8 pb = __builtin_bit_cast(bf16x8, pwv[pr]);
#pragma unroll
        for (int dt = 0; dt < NDT; ++dt) o[dt] = MFMA16(cat8(vlo[pr & 1][dt], vhi[pr & 1][dt]), pb, o[dt]);
    }
#undef ATT_VLOAD
    mx_out = mx;
    return l;
}

struct DilGeo { int b, h, grp, dil, r, m0; };
__device__ __forceinline__ DilGeo dil_geo(int u) { DilGeo q; const int bh = u / 96, v = u % 96, vv = v & 31; q.b = bh / NH; q.h = bh % NH; q.grp = v >> 5; q.dil = q.grp == 0 ? 1 : (q.grp == 1 ? 4 : 16);
    const int nbk = 32 >> (2 * q.grp); q.r = vv / nbk; q.m0 = 128 * (vv % nbk); return q; }
template <int I0>
__device__ __forceinline__ void dil_issue_kv(int u, const bf16_t* KR, const bf16_t* VS, int tid, u32x4 (&kvr)[16]) {
    const DilGeo q = dil_geo(u);
#pragma unroll
    for (int i = I0; i < 8; ++i) { const int idx = i * 512 + tid, row = idx >> 4, ch = idx & 15; int m = q.m0 - 128 + row; if (m < 0) m = 0;
        const size_t go = ((size_t)(q.b * SEQ + m * q.dil + q.r)) * AW + q.h * 128 + ch * 8;
        kvr[i] = *(const u32x4*)(KR + go); kvr[8 + i] = *(const u32x4*)(VS + go); }
}
__device__ __forceinline__ bool dil_cont(int u) { const int v = u % 96, grp = v >> 5, vv = v & 31, nbk = 32 >> (2 * grp); return (vv & (nbk - 1)) != 0; }
__device__ __forceinline__ void dil_issue_q(int u, const bf16_t* QG, int tid, bf16x8 (&qf)[4]) {
    const DilGeo q = dil_geo(u); const int lane = tid & 63, w = tid >> 6, g = lane >> 4, lq = lane & 15;
    const size_t qrow = (size_t)(q.b * SEQ + (q.m0 + 16 * w + lq) * q.dil + q.r);
    const bf16_t* qp = QG + ((size_t)q.grp * T + qrow) * AW + q.h * 128;
#pragma unroll
    for (int s = 0; s < 4; ++s) qf[s] = *(const bf16x8*)(qp + 32 * s + 8 * g);
}
__device__ __forceinline__ void q_norm_rope(const bf16x8 (&qn)[4], const unsigned* csh  , int pos, const LAS float* gq  , int g, bf16x8 (&qc)[4]) {
    float x[4][8]; float ss = 0.f;
#pragma unroll
    for (int s = 0; s < 4; ++s)
#pragma unroll
        for (int j = 0; j < 8; ++j) { x[s][j] = bf2f((bf16_t)qn[s][j]); ss += x[s][j] * x[s][j]; }
    ss = xrow_sum(ss);
    const float r = __builtin_amdgcn_rsqf(ss * (1.f / 128.f) + EPS) * (0.08838834764831845f * LOG2E);
#pragma unroll
    for (int s = 0; s < 4; ++s) { const f32x4 ga = *(const LAS f32x4*)(gq + 32 * s + 8 * g), gb = *(const LAS f32x4*)(gq + 32 * s + 8 * g + 4);
#pragma unroll
        for (int j = 0; j < 8; ++j) x[s][j] *= (j < 4 ? ga[j & 3] : gb[j & 3]) * r; }
    typedef _Float16 h2_t __attribute__((ext_vector_type(2)));
#pragma unroll
    for (int s = 0; s < 2; ++s) { unsigned w1[4], w2[4];
#pragma unroll
        for (int j2 = 0; j2 < 4; ++j2) { float o1[2], o2[2];
#pragma unroll
            for (int k = 0; k < 2; ++k) { const int j = 2 * j2 + k; const h2_t cs2 = __builtin_bit_cast(h2_t, csh[pos * 64 + 32 * s + 8 * g + j]); const float c = (float)cs2[0], sn = (float)cs2[1];
                o1[k] = x[s][j] * c - x[s + 2][j] * sn; o2[k] = x[s + 2][j] * c + x[s][j] * sn; }
            w1[j2] = cvt_pk_bf16(o1[0], o1[1]); w2[j2] = cvt_pk_bf16(o2[0], o2[1]); }
        qc[s] = __builtin_bit_cast(bf16x8, (u32x4){w1[0], w1[1], w1[2], w1[3]}); qc[s + 2] = __builtin_bit_cast(bf16x8, (u32x4){w2[0], w2[1], w2[2], w2[3]}); }
}
__device__ __forceinline__ void dil_stage(LAS unsigned char* lds, int tid, const u32x4 (&kvr)[16]) {
#pragma unroll
    for (int i = 0; i < 8; ++i) { const int idx = i * 512 + tid, row = idx >> 4, ch = idx & 15;
        *(LAS u32x4*)(lds + off_k(row, ch)) = kvr[i]; *(LAS u32x4*)(lds + 65536 + off_v(row, ch)) = kvr[8 + i]; }
}
__device__ __forceinline__ void dil_stage_half(LAS unsigned char* lds, int tid, const u32x4 (&kvr)[16]) {
    u32x4 tk[4], tv[4];
#pragma unroll
    for (int i = 4; i < 8; ++i) { const int idx = i * 512 + tid, row = idx >> 4, ch = idx & 15; tk[i - 4] = *(const LAS u32x4*)(lds + off_k(row, ch)); tv[i - 4] = *(const LAS u32x4*)(lds + 65536 + off_v(row, ch)); }
#pragma unroll
    for (int i = 4; i < 8; ++i) { const int idx = i * 512 + tid, row = idx >> 4, ch = idx & 15;
        *(LAS u32x4*)(lds + off_k(row, ch) - 32768) = tk[i - 4]; *(LAS u32x4*)(lds + 65536 + off_v(row, ch) - 32768) = tv[i - 4];
        *(LAS u32x4*)(lds + off_k(row, ch)) = kvr[i]; *(LAS u32x4*)(lds + 65536 + off_v(row, ch)) = kvr[8 + i]; }
}
__device__ __forceinline__ void dil_compute(LAS unsigned char* lds, int u, const bf16x8 (&qf)[4], bf16_t* QG, float* LSE, int tid, int unext, bf16x8 (&qn)[4]) {
    LAS unsigned char* Kimg = lds; LAS unsigned char* Vimg = lds + 65536;
    const DilGeo q = dil_geo(u); const int lane = tid & 63, w = __builtin_amdgcn_readfirstlane(tid >> 6), g = lane >> 4, lq = lane & 15;
    const size_t qrow = (size_t)(q.b * SEQ + (q.m0 + 16 * w + lq) * q.dil + q.r);
    bf16_t* qp = QG + ((size_t)q.grp * T + qrow) * AW + q.h * 128;
    f32x4 st[9];
    bf16x8 kf[2][4];
#pragma unroll
    for (int s = 0; s < 4; ++s) kf[0][s] = *(const LAS bf16x8*)(Kimg + rowrdk(lane, w, s));
#pragma unroll
    for (int i = 0; i < 9; ++i) { const int tile = w + i; f32x4 acc = (f32x4){0.f, 0.f, 0.f, 0.f};
        if (i + 1 < 9) {
#pragma unroll
            for (int s = 0; s < 4; ++s) kf[(i + 1) & 1][s] = *(const LAS bf16x8*)(Kimg + rowrdk(lane, tile + 1, s)); }
#pragma unroll
        for (int s = 0; s < 4; ++s) acc = MFMA16(kf[i & 1][s], qf[s], acc);
        if (i == 0 || i == 8 || q.m0 == 0) {
#pragma unroll
            for (int e = 0; e < 4; ++e) { const int kk = 16 * tile + 4 * g + e, dist = 128 + 16 * w + lq - kk; const bool ok = dist >= 0 && dist <= 128 && (q.m0 - 128 + kk) >= 0; st[i][e] = ok ? acc[e] : -1e30f; }
        } else st[i] = acc; }
    dil_issue_q(unext, QG, tid, qn);
    f32x4 o[8]; float mx;
    const float l = attn_softmax_pv<9, 8>(Vimg, st, w, lane, o, mx);
    const float inv = __builtin_amdgcn_rcpf(l);
    { LAS unsigned char* ost = lds + OST_OFF + w * 2048; const int rr = lane >> 3, kk = lane & 7;
#pragma unroll
      for (int hf = 0; hf < 2; ++hf) {
#pragma unroll
        for (int d4 = 0; d4 < 4; ++d4) { const int dt = hf * 4 + d4; u32x2 ow; ow.x = cvt_pk_bf16(o[dt][0] * inv, o[dt][1] * inv); ow.y = cvt_pk_bf16(o[dt][2] * inv, o[dt][3] * inv);
            *(LAS u32x2*)(ost + lq * 128 + (((d4 * 4 + g) ^ (lq & 14)) * 8)) = ow; }
#pragma unroll
        for (int i = 0; i < 2; ++i) { const int r = rr + 8 * i; const u32x4 v = *(const LAS u32x4*)(ost + r * 128 + ((kk ^ ((r >> 1) & 7)) * 16));
            const size_t row = (size_t)(q.b * SEQ + (q.m0 + 16 * w + r) * q.dil + q.r);
            *(u32x4*)(QG + ((size_t)q.grp * T + row) * AW + q.h * 128 + hf * 64 + kk * 8) = v; } } }
    if (g == 0) LSE[((size_t)q.grp * T + qrow) * NH + q.h] = mx + __builtin_amdgcn_logf(l);
}
__device__ __forceinline__ void mem_issue_kv(int u, const bf16_t* MKl, const bf16_t* MVl, int tid, u32x4 (&kvr)[16]) {
    const int b = u >> 7, hd = (u >> 5) & 3;
#pragma unroll
    for (int i = 0; i < 4; ++i) { const int idx = i * 512 + tid, row = idx >> 3, ch = idx & 7;
        const size_t go = ((size_t)(b * MEMT + row)) * MW + hd * 64 + ch * 8;
        kvr[i] = *(const u32x4*)(MKl + go); kvr[8 + i] = *(const u32x4*)(MVl + go); }
}
__device__ __forceinline__ void mem_issue_q(int u, const bf16_t* MQ, int tid, bf16x8 (&qf)[4]) {
    const int lane = tid & 63, w = tid >> 6, g = lane >> 4, lq = lane & 15; const int b = u >> 7, hd = (u >> 5) & 3, qblk = u & 31;
    const bf16_t* qp = MQ + (size_t)(b * SEQ + 128 * qblk + 16 * w + lq) * MW + hd * 64;
#pragma unroll
    for (int s = 0; s < 2; ++s) qf[s] = *(const bf16x8*)(qp + 32 * s + 8 * g);
}
__device__ __forceinline__ void mem_stage(LAS unsigned char* lds, int tid, const u32x4 (&kvr)[16]) {
#pragma unroll
    for (int i = 0; i < 4; ++i) { const int idx = i * 512 + tid, row = idx >> 3, ch = idx & 7;
        *(LAS u32x4*)(lds + off_k(row, ch)) = kvr[i]; *(LAS u32x4*)(lds + 65536 + off_v(row, ch)) = kvr[8 + i]; }
}
__device__ __forceinline__ void mem_compute(LAS unsigned char* lds, int u, const bf16x8 (&qf)[4], bf16_t* MIX, int tid) {
    LAS unsigned char* Kimg = lds; LAS unsigned char* Vimg = lds + 65536;
    const int lane = tid & 63, w = __builtin_amdgcn_readfirstlane(tid >> 6), g = lane >> 4, lq = lane & 15; const int b = u >> 7, hd = (u >> 5) & 3, qblk = u & 31;
    const size_t qrow = (size_t)(b * SEQ + 128 * qblk + 16 * w + lq);
    f32x4 st[16];
#pragma unroll
    for (int i = 0; i < 16; ++i) { f32x4 acc = (f32x4){0.f, 0.f, 0.f, 0.f};
#pragma unroll
        for (int s = 0; s < 2; ++s) acc = MFMA16(*(const LAS bf16x8*)(Kimg + rowrdk(lane, i, s)), qf[s], acc);
        st[i] = acc; }
    f32x4 o[4]; float mx;
    const float l = attn_softmax_pv<16, 4>(Vimg, st, 0, lane, o, mx);
    const float inv = __builtin_amdgcn_rcpf(l);
    { LAS unsigned char* ost = lds + OST_OFF + w * 2048; const int rr = lane >> 3, kk = lane & 7;
#pragma unroll
      for (int dt = 0; dt < 4; ++dt) { u32x2 ow; ow.x = cvt_pk_bf16(o[dt][0] * inv, o[dt][1] * inv); ow.y = cvt_pk_bf16(o[dt][2] * inv, o[dt][3] * inv);
          *(LAS u32x2*)(ost + lq * 128 + (((dt * 4 + g) ^ (lq & 14)) * 8)) = ow; }
#pragma unroll
      for (int i = 0; i < 2; ++i) { const int r = rr + 8 * i; const u32x4 v = *(const LAS u32x4*)(ost + r * 128 + ((kk ^ ((r >> 1) & 7)) * 16));
          *(u32x4*)(MIX + (size_t)(b * SEQ + 128 * qblk + 16 * w + r) * DM + AW + hd * 64 + kk * 8) = v; } }
}
struct HeadSync { unsigned* bar; volatile LAS unsigned* st; };
#define GB_HCNT(g) (3568 + 64 * (g))
__device__ __forceinline__ void dil_head_post(const HeadSync& hc) {
    if (threadIdx.x == 0) {
        if (hc.st[4] != 1u) { __builtin_amdgcn_fence(__ATOMIC_RELEASE, "agent"); asm volatile("s_waitcnt vmcnt(0)" ::: "memory"); }
        (void)__hip_atomic_fetch_add(&hc.bar[GB_HCNT(blockIdx.x & 7u)], 1u, __ATOMIC_RELAXED, __HIP_MEMORY_SCOPE_AGENT);
    }
}
__device__ __forceinline__ void dil_head_wait(const HeadSync& hc, unsigned heads) {
    if (threadIdx.x == 0) {
        unsigned* p = &hc.bar[GB_HCNT(blockIdx.x & 7u)]; const unsigned need = heads * ((gridDim.x + 7u - (blockIdx.x & 7u)) >> 3); unsigned sp = 0u;
        while ((int)(__hip_atomic_load(p, __ATOMIC_RELAXED, __HIP_MEMORY_SCOPE_AGENT) - need) < 0) { __builtin_amdgcn_s_sleep(1);
            if ((++sp & 255u) == 0u) { if (__hip_atomic_load(&hc.bar[128], __ATOMIC_RELAXED, __HIP_MEMORY_SCOPE_AGENT)) break; if (sp > (1u << 18)) { atomicAdd(&hc.bar[128], 1u); break; } } }
        __builtin_amdgcn_fence(__ATOMIC_ACQUIRE, "agent");
        asm volatile("s_waitcnt vmcnt(0)" ::: "memory");
    }
    __syncthreads();
}
__device__ __forceinline__ void dil_combine_head(int gb, int li, int h, const bf16_t* QG, const float* LSE, bf16_t* MIX, int tid) {
#pragma unroll 1
    for (int itl = li * NTHREADS + tid; itl < SEQ * 16; itl += 32 * NTHREADS) { const int row = gb * SEQ + (itl >> 4), c8 = h * 16 + (itl & 15);
        const float l0 = LSE[(size_t)row * NH + h], l1 = LSE[((size_t)T + row) * NH + h], l2 = LSE[((size_t)2 * T + row) * NH + h];
        const float mm = fmaxf(l0, fmaxf(l1, l2)); float w0 = __builtin_amdgcn_exp2f(l0 - mm), w1 = __builtin_amdgcn_exp2f(l1 - mm), w2 = __builtin_amdgcn_exp2f(l2 - mm);
        const float wi = __builtin_amdgcn_rcpf(w0 + w1 + w2); w0 *= wi; w1 *= wi; w2 *= wi;
        const u32x4 a = *(const u32x4*)(QG + (size_t)row * AW + c8 * 8), bq = *(const u32x4*)(QG + ((size_t)T + row) * AW + c8 * 8), cq = *(const u32x4*)(QG + ((size_t)2 * T + row) * AW + c8 * 8);
        const unsigned av[4] = {a.x, a.y, a.z, a.w}, bv[4] = {bq.x, bq.y, bq.z, bq.w}, cv[4] = {cq.x, cq.y, cq.z, cq.w}; unsigned ov[4];
#pragma unroll
        for (int i = 0; i < 4; ++i) { const float lo = w0 * __uint_as_float(av[i] << 16) + w1 * __uint_as_float(bv[i] << 16) + w2 * __uint_as_float(cv[i] << 16);
            const float hi = w0 * __uint_as_float(av[i] & 0xffff0000u) + w1 * __uint_as_float(bv[i] & 0xffff0000u) + w2 * __uint_as_float(cv[i] & 0xffff0000u); ov[i] = cvt_pk_bf16(lo, hi); }
        *(u32x4*)(MIX + (size_t)row * DM + c8 * 8) = (u32x4){ov[0], ov[1], ov[2], ov[3]}; }
}
__device__ __forceinline__ void dil_run(LAS unsigned char* lds, int n, int u0, const bf16_t* KR, const bf16_t* VS, bf16_t* QG, float* LSE, const unsigned* CSH, const float* qnorm, int tid0, const HeadSync& hc, bf16_t* MIX) {
    const int tid = tid0;
    u32x4 kvr[16]; bf16x8 qn[4], qc[4];
    LAS float* GQ = (LAS float*)(lds + XSCR_OFF);
    if (tid < 384) GQ[tid] = qnorm[tid];
    const int g = (tid & 63) >> 4;
#define DIL_U(j_) (u0 + 96 * ((j_) / 3) + 32 * ((j_) % 3))
    dil_issue_kv<0>(DIL_U(0), KR, VS, tid, kvr); dil_issue_q(DIL_U(0), QG, tid, qn);
#pragma unroll 1
    for (int j = 0; j < n; ++j) { const int uc = DIL_U(j);
        if (j % 3 == 1 && j >= 4) { dil_head_wait(hc, (unsigned)(j / 3)); dil_combine_head(u0 / 576, u0 % 576, j / 3 - 1, QG, LSE, MIX, tid); }
        dil_stage(lds, tid, kvr);
        if (j == 0) LDS_BARRIER();
        { const DilGeo qq = dil_geo(uc); const int pos = (qq.m0 + 16 * (tid >> 6) + (tid & 15)) * qq.dil + qq.r;
          q_norm_rope(qn, CSH, pos, GQ + 128 * qq.grp, g, qc); }
        const int un = DIL_U(j + 1 < n ? j + 1 : j);
        dil_issue_kv<0>(un, KR, VS, tid, kvr);
        LDS_ONLY_BARRIER();
        dil_compute(lds, uc, qc, QG, LSE, tid, un, qn);
        if (j % 3 == 2) asm volatile("s_waitcnt vmcnt(0)" ::: "memory");
        asm volatile("s_waitcnt lgkmcnt(0)" ::: "memory"); __builtin_amdgcn_s_barrier(); asm volatile("" ::: "memory");
        if (j % 3 == 2) dil_head_post(hc);
    }
#undef DIL_U
}
__device__ __forceinline__ void mem_run(LAS unsigned char* lds, int n, int u0, const bf16_t* MQ, const bf16_t* MKl, const bf16_t* MVl, bf16_t* MIX, int tid0) {
    const int tid = tid0;
    u32x4 kvr[16]; bf16x8 qn[4], qc[4];
    mem_issue_kv(u0, MKl, MVl, tid, kvr); mem_issue_q(u0, MQ, tid, qn);
#pragma unroll 1
    for (int j = 0; j < n; ++j) { const int u = u0 + j;
        const bool fresh = (j == 0) || ((u & 31) == 0);
        if (fresh) mem_stage(lds, tid, kvr);
#pragma unroll
        for (int s = 0; s < 2; ++s) qc[s] = qn[s];
        if (fresh) LDS_BARRIER();
        const bool has_next = j + 1 < n; const int un = has_next ? u + 1 : u; const bool nfresh = has_next && ((un & 31) == 0);
        mem_issue_q(un, MQ, tid, qn);
        if (nfresh) mem_issue_kv(un, MKl, MVl, tid, kvr);
        mem_compute(lds, u, qc, MIX, tid);
        if (nfresh || !has_next) { asm volatile("s_waitcnt lgkmcnt(0)" ::: "memory"); __builtin_amdgcn_s_barrier(); asm volatile("" ::: "memory"); }
    }
}

constexpr int HG_UNITS = BATCH * NH * (SEQ / 64);
__device__ __forceinline__ void hg_cumsum(LAS float* tot, const unsigned short (&lfh)[16], int tid, float (&lf)[16], float (&bc)[16], float& bend) {
    const int d = tid & 127, rg = tid >> 7;
    float c = 0.f;
#pragma unroll
    for (int i = 0; i < 16; ++i) { lf[i] = (float)__builtin_bit_cast(_Float16, lfh[i]); c += lf[i]; bc[i] = c; }
    tot[rg * 128 + d] = c;
    asm volatile("s_waitcnt lgkmcnt(0)" ::: "memory"); __builtin_amdgcn_s_barrier(); asm volatile("" ::: "memory");
    const float t0 = tot[d], t1 = tot[128 + d], t2 = tot[256 + d], t3 = tot[384 + d];
    const float pre = rg == 0 ? 0.f : (rg == 1 ? t0 : (rg == 2 ? t0 + t1 : t0 + t1 + t2));
    bend = (t0 + t1) + (t2 + t3);
#pragma unroll
    for (int i = 0; i < 16; ++i) bc[i] += pre;
}
__device__ __forceinline__ float ex(float v) { return __builtin_amdgcn_exp2f(v); }
#define WAVE_BARRIER_LDS() do { asm volatile("s_waitcnt lgkmcnt(0)" ::: "memory"); __builtin_amdgcn_s_barrier(); asm volatile("" ::: "memory"); } while (0)
struct HgALoads { unsigned short lfh[16]; u32x4 v[2]; };
__device__ __forceinline__ void hgA_issue(int u, const unsigned short* LF, const bf16_t* VV, int tid, HgALoads& R) {
    const int bh = u >> 6, c = u & 63, b = bh / NH, h = bh % NH; const size_t rowbase = (size_t)b * SEQ + 64 * c; const int d = tid & 127, rg = tid >> 7;
#pragma unroll
    for (int i = 0; i < 16; ++i) R.lfh[i] = LF[(rowbase + 16 * rg + i) * AW + h * 128 + d];
#pragma unroll
    for (int i = 0; i < 2; ++i) { const int idx = i * 512 + tid, row = idx >> 4, ch = idx & 15; R.v[i] = *(const u32x4*)(VV + (rowbase + row) * AW + h * 128 + ch * 8); }
}
__device__ __forceinline__ void hgA_run(LAS unsigned char* lds, int n, int u0, const unsigned short* LF, const bf16_t* VV, bf16_t* DS, float* DEC, int tid) {
    LAS unsigned char* KT = lds;
    LAS unsigned char* Vimg = lds + 16384;
    LAS float* tot = (LAS float*)(lds + 32768);
    const int lane = tid & 63, w = __builtin_amdgcn_readfirstlane(tid >> 6), g = lane >> 4, d = tid & 127, rg = tid >> 7;
    HgALoads R; hgA_issue(u0, LF, VV, tid, R);
#pragma unroll 1
    for (int j = 0; j < n; ++j) { const int u = u0 + j;
        float lf[16], bc[16], bend;
        hg_cumsum(tot, R.lfh, tid, lf, bc, bend);
        { u32x4 w0, w1; float ko[16];
#pragma unroll
          for (int i = 0; i < 16; ++i) ko[i] = (1.f - ex(lf[i])) * ex(bend - bc[i]);
          w0.x = cvt_pk_bf16(ko[0], ko[1]); w0.y = cvt_pk_bf16(ko[2], ko[3]); w0.z = cvt_pk_bf16(ko[4], ko[5]); w0.w = cvt_pk_bf16(ko[6], ko[7]);
          w1.x = cvt_pk_bf16(ko[8], ko[9]); w1.y = cvt_pk_bf16(ko[10], ko[11]); w1.z = cvt_pk_bf16(ko[12], ko[13]); w1.w = cvt_pk_bf16(ko[14], ko[15]);
          *(LAS u32x4*)(KT + off_h(d, 2 * rg)) = w0; *(LAS u32x4*)(KT + off_h(d, 2 * rg + 1)) = w1;
          if (rg == 0) DEC[(size_t)u * 128 + d] = ex(bend); }
#pragma unroll
        for (int i = 0; i < 2; ++i) { const int idx = i * 512 + tid, row = idx >> 4, ch = idx & 15; *(LAS u32x4*)(Vimg + off_b(row, ch)) = R.v[i]; }
        WAVE_BARRIER_LDS();
        hgA_issue(u0 + (j + 1 < n ? j + 1 : j), LF, VV, tid, R);
        bf16x8 af[2];
#pragma unroll
        for (int ks = 0; ks < 2; ++ks) af[ks] = *(const LAS bf16x8*)(KT + off_h(16 * w + (lane & 15), 4 * ks + g));
        bf16_t* dsu = DS + (size_t)u * 16384;
#pragma unroll
        for (int jt = 0; jt < 8; ++jt) { f32x4 acc = (f32x4){0.f, 0.f, 0.f, 0.f};
#pragma unroll
            for (int ks = 0; ks < 2; ++ks) { const s16x4 lo = tr_read(Vimg + trrd(lane, 32 * ks + 8 * g, jt)), hi = tr_read(Vimg + trrd(lane, 32 * ks + 8 * g + 4, jt));
                acc = MFMA16(af[ks], cat8(lo, hi), acc); }
            u32x2 ow; ow.x = cvt_pk_bf16(acc[0], acc[1]); ow.y = cvt_pk_bf16(acc[2], acc[3]);
            *(u32x2*)(dsu + (size_t)(16 * jt + (lane & 15)) * 128 + 16 * w + 4 * g) = ow; }
        WAVE_BARRIER_LDS();
    }
}
__device__ __forceinline__ void hgB_item(int it, bf16_t* DS, const float* DEC) {
    const int bh = it >> 11, e8 = it & 2047;
    const int dk0 = 8 * (e8 & 15);
    float S[8];
#pragma unroll
    for (int i = 0; i < 8; ++i) S[i] = 0.f;
#pragma unroll 4
    for (int c = 0; c < 64; ++c) { const size_t un = (size_t)(bh * 64 + c);
        u32x4* p = (u32x4*)(DS + un * 16384 + (size_t)e8 * 8);
        const u32x4 dsv = *p; const f32x4 d0 = *(const f32x4*)(DEC + un * 128 + dk0), d1 = *(const f32x4*)(DEC + un * 128 + dk0 + 4);
        u32x4 o; o.x = cvt_pk_bf16(S[0], S[1]); o.y = cvt_pk_bf16(S[2], S[3]); o.z = cvt_pk_bf16(S[4], S[5]); o.w = cvt_pk_bf16(S[6], S[7]);
        *p = o;
        const unsigned wv[4] = {dsv.x, dsv.y, dsv.z, dsv.w};
#pragma unroll
        for (int i = 0; i < 4; ++i) { const float dl = (i < 2 ? d0 : d1)[(2 * i) & 3], dh = (i < 2 ? d0 : d1)[(2 * i + 1) & 3];
            S[2 * i] = dl * S[2 * i] + __uint_as_float(wv[i] << 16); S[2 * i + 1] = dh * S[2 * i + 1] + __uint_as_float(wv[i] & 0xffff0000u); } }
}
struct HgCLoads { unsigned short lfh[16], qs[16], sg[16]; u32x4 v[2], st[4]; };
__device__ __forceinline__ void hgC_issue(int u, const unsigned short* LF, const bf16_t* QS, const bf16_t* VV, const bf16_t* SG, const bf16_t* SP, int tid, HgCLoads& R) {
    const int bh = u >> 6, c = u & 63, b = bh / NH, h = bh % NH; const size_t rowbase = (size_t)b * SEQ + 64 * c; const int d = tid & 127, rg = tid >> 7;
    const int lane = tid & 63, w = tid >> 6, g = lane >> 4, lq = lane & 15, ti = w & 3, jh = w >> 2;
#pragma unroll
    for (int i = 0; i < 16; ++i) { const size_t o = (rowbase + 16 * rg + i) * AW + h * 128 + d; R.lfh[i] = LF[o]; R.qs[i] = QS[o]; }
#pragma unroll
    for (int i = 0; i < 2; ++i) { const int idx = i * 512 + tid, row = idx >> 4, ch = idx & 15; R.v[i] = *(const u32x4*)(VV + (rowbase + row) * AW + h * 128 + ch * 8); }
#pragma unroll
    for (int i = 0; i < 4; ++i) { const int idx = i * 512 + tid, row = idx >> 4, ch = idx & 15; R.st[i] = *(const u32x4*)(SP + (size_t)u * 16384 + row * 128 + ch * 8); }
#pragma unroll
    for (int e = 0; e < 4; ++e)
#pragma unroll
        for (int jj = 0; jj < 4; ++jj) R.sg[e * 4 + jj] = SG[(rowbase + 16 * ti + 4 * g + e) * AW + h * 128 + 16 * (4 * jh + jj) + lq];
}
__device__ __forceinline__ void hgC_run(LAS unsigned char* lds, int n, int u0, const unsigned short* LF, const bf16_t* QS, const bf16_t* VV, const bf16_t* SG, const bf16_t* SP, const float* onorm, bf16_t* MIX, int tid) {
    LAS unsigned char* QI = lds;
    LAS unsigned char* KI = lds + 16384;
    LAS unsigned char* Vimg = lds + 32768;
    LAS unsigned char* STi = lds + 49152;
    LAS unsigned char* AT = lds + 81920;
    LAS float* tot = (LAS float*)(lds + 90112);
    LAS float* red = (LAS float*)(lds + 92160);
    const int lane = tid & 63, w = __builtin_amdgcn_readfirstlane(tid >> 6), g = lane >> 4, lq = lane & 15, d = tid & 127, rg = tid >> 7, ti = w & 3, jh = w >> 2;
    HgCLoads R; hgC_issue(u0, LF, QS, VV, SG, SP, tid, R);
#pragma unroll 1
    for (int j = 0; j < n; ++j) { const int u = u0 + j; const int bh = u >> 6, c = u & 63, b = bh / NH, h = bh % NH; const size_t rowbase = (size_t)b * SEQ + 64 * c;
        float lf[16], bc[16], bend;
        hg_cumsum(tot, R.lfh, tid, lf, bc, bend);
#pragma unroll
        for (int i = 0; i < 16; ++i) { const int t = 16 * rg + i; const float q = bf2f(R.qs[i]); const float eb = ex(bc[i]);
            const unsigned a = off_b(t, d >> 3) + (d & 7) * 2;
            *(LAS bf16_t*)(QI + a) = (bf16_t)(cvt_pk_bf16(q * eb, 0.f) & 0xffffu);
            *(LAS bf16_t*)(KI + a) = (bf16_t)(cvt_pk_bf16((1.f - ex(lf[i])) * __builtin_amdgcn_rcpf(eb), 0.f) & 0xffffu); }
#pragma unroll
        for (int i = 0; i < 2; ++i) { const int idx = i * 512 + tid, row = idx >> 4, ch = idx & 15; *(LAS u32x4*)(Vimg + off_b(row, ch)) = R.v[i]; }
#pragma unroll
        for (int i = 0; i < 4; ++i) { const int idx = i * 512 + tid, row = idx >> 4, ch = idx & 15; *(LAS u32x4*)(STi + off_b(row, ch)) = R.st[i]; }
        float sgc[16];
#pragma unroll
        for (int i = 0; i < 16; ++i) sgc[i] = bf2f(R.sg[i]);
        WAVE_BARRIER_LDS();
        hgC_issue(u0 + (j + 1 < n ? j + 1 : j), LF, QS, VV, SG, SP, tid, R);
#pragma unroll
        for (int k2 = 0; k2 < 2; ++k2) { const int si = 2 * jh + k2; f32x4 acc = (f32x4){0.f, 0.f, 0.f, 0.f};
            if (si <= ti) {
#pragma unroll
                for (int s = 0; s < 4; ++s) acc = MFMA16(*(const LAS bf16x8*)(KI + rowrd16(lane, si, s)), *(const LAS bf16x8*)(QI + rowrd16(lane, ti, s)), acc);
            }
            const int t = 16 * ti + lq, s0 = 16 * si + 4 * g;
            u32x2 ow; ow.x = cvt_pk_bf16(s0 <= t ? acc[0] : 0.f, s0 + 1 <= t ? acc[1] : 0.f); ow.y = cvt_pk_bf16(s0 + 2 <= t ? acc[2] : 0.f, s0 + 3 <= t ? acc[3] : 0.f);
            *(LAS u32x2*)(AT + off_h(t, s0 >> 3) + (s0 & 7) * 2) = ow; }
        WAVE_BARRIER_LDS();
        bf16x8 aq[4], aa[2];
#pragma unroll
        for (int s = 0; s < 4; ++s) aq[s] = *(const LAS bf16x8*)(QI + rowrd16(lane, ti, s));
#pragma unroll
        for (int s = 0; s < 2; ++s) aa[s] = *(const LAS bf16x8*)(AT + off_h(16 * ti + lq, 4 * s + g));
        f32x4 o[4]; float ssq[4] = {0.f, 0.f, 0.f, 0.f};
#pragma unroll
        for (int jj = 0; jj < 4; ++jj) { const int jt = 4 * jh + jj; f32x4 acc = (f32x4){0.f, 0.f, 0.f, 0.f};
#pragma unroll
            for (int s = 0; s < 4; ++s) acc = MFMA16(aq[s], *(const LAS bf16x8*)(STi + rowrd16(lane, jt, s)), acc);
#pragma unroll
            for (int ks = 0; ks < 2; ++ks) { const s16x4 lo = tr_read(Vimg + trrd(lane, 32 * ks + 8 * g, jt)), hi = tr_read(Vimg + trrd(lane, 32 * ks + 8 * g + 4, jt));
                acc = MFMA16(aa[ks], cat8(lo, hi), acc); }
            o[jj] = acc;
#pragma unroll
            for (int e = 0; e < 4; ++e) ssq[e] += acc[e] * acc[e]; }
#pragma unroll
        for (int e = 0; e < 4; ++e) { float sv = ssq[e]; sv += __shfl_xor(sv, 1); sv += __shfl_xor(sv, 2); sv += __shfl_xor(sv, 4); sv += __shfl_xor(sv, 8); ssq[e] = sv; }
        if (lq == 0) {
#pragma unroll
            for (int e = 0; e < 4; ++e) red[(16 * ti + 4 * g + e) * 2 + jh] = ssq[e]; }
        WAVE_BARRIER_LDS();
        f32x4 onv;
#pragma unroll
        for (int jj = 0; jj < 4; ++jj) onv[jj] = onorm[h * 128 + 16 * (4 * jh + jj) + lq];
#pragma unroll
        for (int e = 0; e < 4; ++e) { const int t = 16 * ti + 4 * g + e; const float r2 = __builtin_amdgcn_rsqf((red[t * 2] + red[t * 2 + 1]) * (1.f / 128.f) + EPS);
#pragma unroll
            for (int jj = 0; jj < 4; ++jj) { const int dv = 16 * (4 * jh + jj) + lq;
                MIX[(rowbase + t) * DM + h * 128 + dv] = (bf16_t)(cvt_pk_bf16(o[jj][e] * r2 * onv[jj] * sgc[e * 4 + jj], 0.f) & 0xffffu); } }
        WAVE_BARRIER_LDS();
    }
}

constexpr int HG2_UNITS = BATCH * NH * 4;
struct HgA2Loads { unsigned short lfh[32]; u32x4 v[4]; };
template <int PART>
__device__ __forceinline__ void hgA2_issue(int u, const unsigned short* LF, const bf16_t* VV, int tid, HgA2Loads& R) {
    const int bh = u >> 6, c = u & 63, b = bh / NH, h = bh % NH; const size_t rowbase = (size_t)b * SEQ + 64 * c; const int d = tid & 127, rg = tid >> 7;
    if (PART != 2) {
#pragma unroll
    for (int i = 0; i < 32; ++i) R.lfh[i] = LF[(rowbase + 32 * rg + i) * AW + h * 128 + d]; }
    if (PART != 1)
#pragma unroll
    for (int i = 0; i < 4; ++i) { const int idx = i * 512 + tid, row = idx >> 4, ch = idx & 15; R.v[i] = *(const u32x4*)(VV + (rowbase + row) * AW + h * 128 + ch * 8); }
}
__device__ __forceinline__ void hg2A_run(LAS unsigned char* lds, int s, const unsigned short* LF, const bf16_t* VV, float* AGG, float* DTOT, int tid) {
    LAS unsigned char* KT = lds;
    LAS unsigned char* Vimg = lds + 32768;
    LAS float* tot = (LAS float*)(lds + 65536);
    LAS float* dec = (LAS float*)(lds + 67584);
    const int lane = tid & 63, w = __builtin_amdgcn_readfirstlane(tid >> 6), g = lane >> 4, lq = lane & 15, d = tid & 127, rg = tid >> 7;
    const int u0 = (s >> 2) * 64 + (s & 3) * 16;
    f32x4 S[8];
#pragma unroll
    for (int i = 0; i < 8; ++i) S[i] = (f32x4){0.f, 0.f, 0.f, 0.f};
    float dlog = 0.f;
    HgA2Loads R; hgA2_issue<0>(u0, LF, VV, tid, R);
#pragma unroll 1
    for (int j = 0; j < 8; ++j) {
        float lf[32], bc[32], bend;
        { float c = 0.f;
#pragma unroll
          for (int i = 0; i < 32; ++i) { lf[i] = (float)__builtin_bit_cast(_Float16, R.lfh[i]); c += lf[i]; bc[i] = c; }
          hgA2_issue<1>(u0 + 2 * (j < 7 ? j + 1 : j), LF, VV, tid, R);
          tot[rg * 128 + d] = c;
          WAVE_BARRIER_LDS();
          const float t0 = tot[d], t1 = tot[128 + d], t2 = tot[256 + d], t3 = tot[384 + d];
          const float pre = rg == 0 ? 0.f : (rg == 1 ? t0 : (rg == 2 ? t0 + t1 : t0 + t1 + t2));
          bend = (t0 + t1) + (t2 + t3);
#pragma unroll
          for (int i = 0; i < 32; ++i) bc[i] += pre; }
#pragma unroll
        for (int c4 = 0; c4 < 4; ++c4) { float ko[8];
#pragma unroll
          for (int i = 0; i < 8; ++i) ko[i] = (1.f - ex(lf[8 * c4 + i])) * ex(bend - bc[8 * c4 + i]);
          u32x4 w0; w0.x = cvt_pk_bf16(ko[0], ko[1]); w0.y = cvt_pk_bf16(ko[2], ko[3]); w0.z = cvt_pk_bf16(ko[4], ko[5]); w0.w = cvt_pk_bf16(ko[6], ko[7]);
          *(LAS u32x4*)(KT + off_k(d, 4 * rg + c4)) = w0; }
        if (rg == 0) dec[d] = ex(bend);
        dlog += bend;
#pragma unroll
        for (int i = 0; i < 4; ++i) { const int idx = i * 512 + tid, row = idx >> 4, ch = idx & 15; *(LAS u32x4*)(Vimg + off_b(row, ch)) = R.v[i]; }
        hgA2_issue<2>(u0 + 2 * (j < 7 ? j + 1 : j), LF, VV, tid, R);
        WAVE_BARRIER_LDS();
        bf16x8 bv[4];
#pragma unroll
        for (int ks = 0; ks < 4; ++ks) { const s16x4 lo = tr_read(Vimg + trrd(lane, 32 * ks + 8 * g, w)), hi = tr_read(Vimg + trrd(lane, 32 * ks + 8 * g + 4, w)); bv[ks] = cat8(lo, hi); }
        { bf16x8 kt[2][4]; f32x4 dcv[2];
#define HG2_KLOAD(buf, i_) do { dcv[buf] = *(const LAS f32x4*)(dec + 16 * (i_) + 4 * g); _Pragma("unroll") for (int ks = 0; ks < 4; ++ks) kt[buf][ks] = *(const LAS bf16x8*)(KT + off_k(16 * (i_) + lq, 4 * ks + g)); } while (0)
          HG2_KLOAD(0, 0);
#pragma unroll
          for (int i = 0; i < 8; ++i) { if (i + 1 < 8) HG2_KLOAD((i + 1) & 1, i + 1);
              f32x4 a = S[i] * dcv[i & 1];
#pragma unroll
              for (int ks = 0; ks < 4; ++ks) a = MFMA16(kt[i & 1][ks], bv[ks], a);
              S[i] = a; }
#undef HG2_KLOAD
        }
    }
#pragma unroll
    for (int i = 0; i < 8; ++i) *(f32x4*)(AGG + (size_t)s * 16384 + (16 * w + lq) * 128 + 16 * i + 4 * g) = S[i];
    if (rg == 0) DTOT[s * 128 + d] = ex(dlog);
}
struct Hg2CLoads { unsigned short lfh[16], qs[16]; u32x4 v[2], sg[2]; };
__device__ __forceinline__ void hg2C_issue(int u, const unsigned short* LF, const bf16_t* QS, const bf16_t* VV, const bf16_t* SG, int tid, Hg2CLoads& R) {
    const int bh = u >> 6, c = u & 63, b = bh / NH, h = bh % NH; const size_t rowbase = (size_t)b * SEQ + 64 * c; const int d = tid & 127, rg = tid >> 7;
    const int lane = tid & 63, w = tid >> 6, g = lane >> 4, lq = lane & 15;
#pragma unroll
    for (int i = 0; i < 16; ++i) { const size_t o = (rowbase + 16 * rg + i) * AW + h * 128 + d; R.lfh[i] = LF[o]; R.qs[i] = QS[o]; }
#pragma unroll
    for (int i = 0; i < 2; ++i) { const int idx = i * 512 + tid, row = idx >> 4, ch = idx & 15; const size_t o = (rowbase + row) * AW + h * 128 + ch * 8; R.v[i] = *(const u32x4*)(VV + o); R.sg[i] = *(const u32x4*)(SG + o); }
}
__device__ __forceinline__ void hg2C_run(LAS unsigned char* lds, int s, const unsigned short* LF, const bf16_t* QS, const bf16_t* VV, const bf16_t* SG, const float* AGG, const float* DTOT,
                                         const float* onorm, bf16_t* MIX, int tid) {
    LAS unsigned char* QI = lds;
    LAS unsigned char* KI = lds + 16384;
    LAS unsigned char* Vimg = lds + 32768;
    LAS unsigned char* KT = lds + 49152;
    LAS unsigned char* AT = lds + 65536;
    LAS float* tot = (LAS float*)(lds + 73728);
    LAS float* dec = (LAS float*)(lds + 75776);
    LAS float* red = (LAS float*)(lds + 76800);
    LAS unsigned char* OS = lds + 79872;
    const int lane = tid & 63, w = __builtin_amdgcn_readfirstlane(tid >> 6), g = lane >> 4, lq = lane & 15, d = tid & 127, rg = tid >> 7, jh = w >> 2;
    const int bh = s >> 2, sc = s & 3, b = bh / NH, h = bh % NH, u0 = bh * 64 + sc * 16;
    Hg2CLoads R; hg2C_issue(u0, LF, QS, VV, SG, tid, R);
    f32x4 S[8];
#pragma unroll
    for (int i = 0; i < 8; ++i) S[i] = (f32x4){0.f, 0.f, 0.f, 0.f};
#pragma unroll 1
    for (int sp = 0; sp < sc; ++sp) { const int s2 = bh * 4 + sp;
#pragma unroll
        for (int i = 0; i < 8; ++i) { const f32x4 dt = *(const f32x4*)(DTOT + s2 * 128 + 16 * i + 4 * g), ag = *(const f32x4*)(AGG + (size_t)s2 * 16384 + (16 * w + lq) * 128 + 16 * i + 4 * g); S[i] = S[i] * dt + ag; } }
    const f32x4 onv0 = *(const f32x4*)(onorm + h * 128 + 8 * (tid & 15)), onv1 = *(const f32x4*)(onorm + h * 128 + 8 * (tid & 15) + 4);
#pragma unroll 1
    for (int j = 0; j < 16; ++j) { const size_t rowbase = (size_t)b * SEQ + 64 * (sc * 16 + j);
        float lf[16], bc[16], bend;
        hg_cumsum(tot, R.lfh, tid, lf, bc, bend);
        { float ko[16]; const float decv = ex(bend);
#pragma unroll
          for (int i = 0; i < 16; ++i) { const int t = 16 * rg + i; const float q = bf2f(R.qs[i]); const float eb = ex(bc[i]), kk = 1.f - ex(lf[i]);
              const unsigned a = off_k(t, d >> 3) + (d & 7) * 2; const float kin = kk * __builtin_amdgcn_rcpf(eb);
              *(LAS bf16_t*)(QI + a) = (bf16_t)(cvt_pk_bf16(q * eb, 0.f) & 0xffffu);
              *(LAS bf16_t*)(KI + a) = (bf16_t)(cvt_pk_bf16(kin, 0.f) & 0xffffu);
              ko[i] = kin * decv; }
          u32x4 w0, w1;
          w0.x = cvt_pk_bf16(ko[0], ko[1]); w0.y = cvt_pk_bf16(ko[2], ko[3]); w0.z = cvt_pk_bf16(ko[4], ko[5]); w0.w = cvt_pk_bf16(ko[6], ko[7]);
          w1.x = cvt_pk_bf16(ko[8], ko[9]); w1.y = cvt_pk_bf16(ko[10], ko[11]); w1.z = cvt_pk_bf16(ko[12], ko[13]); w1.w = cvt_pk_bf16(ko[14], ko[15]);
          *(LAS u32x4*)(KT + off_h(d, 2 * rg)) = w0; *(LAS u32x4*)(KT + off_h(d, 2 * rg + 1)) = w1;
          if (rg == 0) dec[d] = decv; }
#pragma unroll
        for (int i = 0; i < 2; ++i) { const int idx = i * 512 + tid, row = idx >> 4, ch = idx & 15; *(LAS u32x4*)(Vimg + off_b(row, ch)) = R.v[i]; }
        const u32x4 sgk0 = R.sg[0], sgk1 = R.sg[1];
        hg2C_issue(u0 + (j < 15 ? j + 1 : j), LF, QS, VV, SG, tid, R);
        WAVE_BARRIER_LDS();
        { const int ti = w & 3;
#pragma unroll
          for (int k2 = 0; k2 < 2; ++k2) { const int si = 2 * jh + k2; f32x4 acc = (f32x4){0.f, 0.f, 0.f, 0.f};
            if (si <= ti) {
#pragma unroll
                for (int q4 = 0; q4 < 4; ++q4) acc = MFMA16(*(const LAS bf16x8*)(KI + rowrdk(lane, si, q4)), *(const LAS bf16x8*)(QI + rowrdk(lane, ti, q4)), acc);
            }
            const int t = 16 * ti + lq, s0 = 16 * si + 4 * g;
            u32x2 ow; ow.x = cvt_pk_bf16(s0 <= t ? acc[0] : 0.f, s0 + 1 <= t ? acc[1] : 0.f); ow.y = cvt_pk_bf16(s0 + 2 <= t ? acc[2] : 0.f, s0 + 3 <= t ? acc[3] : 0.f);
            *(LAS u32x2*)(AT + off_h(t, s0 >> 3) + (s0 & 7) * 2) = ow; } }
        WAVE_BARRIER_LDS();
        bf16x8 bv[2];
#pragma unroll
        for (int ks = 0; ks < 2; ++ks) { const s16x4 lo = tr_read(Vimg + trrd(lane, 32 * ks + 8 * g, w)), hi = tr_read(Vimg + trrd(lane, 32 * ks + 8 * g + 4, w)); bv[ks] = cat8(lo, hi); }
        f32x4 o[4];
        { bf16x8 af[4][2];
#pragma unroll
          for (int ti = 0; ti < 4; ++ti)
#pragma unroll
            for (int ks = 0; ks < 2; ++ks) af[ti][ks] = *(const LAS bf16x8*)(AT + off_h(16 * ti + lq, 4 * ks + g));
          s16x4 ql[2][4], qh[2][4];
#define HG2_QLOAD(buf, kp_) do { _Pragma("unroll") for (int ti = 0; ti < 4; ++ti) { ql[buf][ti] = *(const LAS s16x4*)(QI + off_k(16 * ti + lq, 4 * (kp_) + (g >> 1)) + 8 * (g & 1)); qh[buf][ti] = *(const LAS s16x4*)(QI + off_k(16 * ti + lq, 4 * (kp_) + 2 + (g >> 1)) + 8 * (g & 1)); } } while (0)
          HG2_QLOAD(0, 0);
#pragma unroll
          for (int ti = 0; ti < 4; ++ti) { f32x4 acc = MFMA16(af[ti][0], bv[0], ((f32x4){0.f, 0.f, 0.f, 0.f})); o[ti] = MFMA16(af[ti][1], bv[1], acc); }
#pragma unroll
          for (int kp = 0; kp < 4; ++kp) { if (kp + 1 < 4) HG2_QLOAD((kp + 1) & 1, kp + 1);
              u32x4 pw; pw.x = cvt_pk_bf16(S[2 * kp][0], S[2 * kp][1]); pw.y = cvt_pk_bf16(S[2 * kp][2], S[2 * kp][3]); pw.z = cvt_pk_bf16(S[2 * kp + 1][0], S[2 * kp + 1][1]); pw.w = cvt_pk_bf16(S[2 * kp + 1][2], S[2 * kp + 1][3]);
              const bf16x8 Sb = __builtin_bit_cast(bf16x8, pw);
#pragma unroll
              for (int ti = 0; ti < 4; ++ti) o[ti] = MFMA16(cat8(ql[kp & 1][ti], qh[kp & 1][ti]), Sb, o[ti]); }
#undef HG2_QLOAD
        }
        { bf16x8 kt[2][2]; f32x4 dcv[2];
#define HG2_KLOAD(buf, i_) do { dcv[buf] = *(const LAS f32x4*)(dec + 16 * (i_) + 4 * g); _Pragma("unroll") for (int ks = 0; ks < 2; ++ks) kt[buf][ks] = *(const LAS bf16x8*)(KT + off_h(16 * (i_) + lq, 4 * ks + g)); } while (0)
          HG2_KLOAD(0, 0);
#pragma unroll
          for (int i = 0; i < 8; ++i) { if (i + 1 < 8) HG2_KLOAD((i + 1) & 1, i + 1);
              f32x4 a = S[i] * dcv[i & 1];
#pragma unroll
              for (int ks = 0; ks < 2; ++ks) a = MFMA16(kt[i & 1][ks], bv[ks], a);
              S[i] = a; }
#undef HG2_KLOAD
        }
        { float sv[16];
#pragma unroll
          for (int ti = 0; ti < 4; ++ti)
#pragma unroll
            for (int e = 0; e < 4; ++e) sv[ti * 4 + e] = row16_sum(o[ti][e] * o[ti][e]);
          if (lq == 0) {
#pragma unroll
            for (int ti = 0; ti < 4; ++ti)
#pragma unroll
                for (int e = 0; e < 4; ++e) red[(16 * ti + 4 * g + e) * 8 + w] = sv[ti * 4 + e]; }
#pragma unroll
          for (int ti = 0; ti < 4; ++ti)
#pragma unroll
            for (int e = 0; e < 4; ++e) *(LAS float*)(OS + (16 * ti + 4 * g + e) * 512 + ((w ^ g) * 64) + lq * 4) = o[ti][e]; }
        WAVE_BARRIER_LDS();
#pragma unroll
        for (int i = 0; i < 2; ++i) { const int idx = i * 512 + tid, row = idx >> 4, ch = idx & 15;
            const LAS unsigned char* op = OS + row * 512 + ((((ch >> 1) ^ ((row >> 2) & 3))) * 64) + (ch & 1) * 32;
            const f32x4 v0 = *(const LAS f32x4*)op, v1 = *(const LAS f32x4*)(op + 16);
            const f32x4 p0 = *(const LAS f32x4*)(red + row * 8), p1 = *(const LAS f32x4*)(red + row * 8 + 4);
            const float r2 = __builtin_amdgcn_rsqf((((p0[0] + p0[1]) + (p0[2] + p0[3])) + ((p1[0] + p1[1]) + (p1[2] + p1[3]))) * (1.f / 128.f) + EPS);
            const u32x4 sgw = i == 0 ? sgk0 : sgk1;
            f32x4 g0, g1;
            g0[0] = __uint_as_float(sgw.x << 16); g0[1] = __uint_as_float(sgw.x & 0xffff0000u); g0[2] = __uint_as_float(sgw.y << 16); g0[3] = __uint_as_float(sgw.y & 0xffff0000u);
            g1[0] = __uint_as_float(sgw.z << 16); g1[1] = __uint_as_float(sgw.z & 0xffff0000u); g1[2] = __uint_as_float(sgw.w << 16); g1[3] = __uint_as_float(sgw.w & 0xffff0000u);
            *(u32x4*)(MIX + (rowbase + row) * DM + h * 128 + ch * 8) = pg8::pack8(v0 * r2 * onv0 * g0, v1 * r2 * onv1 * g1); }
    }
}


#define XB_TMO      128
#define XB_XCNT(j)  (256  + 64 * (j))
#define XB_XSUB(j)  (1280 + 64 * (j))
#define XB_XGEN(j)  (2304 + 64 * (j))
#define XB_TOP      3328
#define XB_TOPGEN   3392
#define XCD_BAR_WORDS 3456
#define XB_SPIN_CAP (1u << 18)
#define GB_XMASK(g) (3536 + 64 * (g))
__device__ __forceinline__ unsigned xb_ld(unsigned* p)              { return __hip_atomic_load(p, __ATOMIC_RELAXED, __HIP_MEMORY_SCOPE_AGENT); }
__device__ __forceinline__ unsigned xb_add(unsigned* p, unsigned v) { return __hip_atomic_fetch_add(p, v, __ATOMIC_RELAXED, __HIP_MEMORY_SCOPE_AGENT); }
__device__ __forceinline__ unsigned xb_xcc_id() { return (unsigned)__builtin_amdgcn_s_getreg((3 << 11) | 20) & 0xFu; }
#define XB_SPIN(cond, bar) do { unsigned _sp = 0; while (cond) { __builtin_amdgcn_s_sleep(1); \
    if ((++_sp & 255u) == 0u) { if (xb_ld(&(bar)[XB_TMO])) break; if (_sp > XB_SPIN_CAP) { atomicAdd(&(bar)[XB_TMO], 1u); break; } } } } while (0)
struct XcdBarrier { unsigned* bar; unsigned x; volatile LAS unsigned* st; };
__device__ __forceinline__ XcdBarrier xcd_barrier_post(unsigned* bar, volatile LAS unsigned* st) {
    XcdBarrier b; b.bar = bar; b.x = xb_xcc_id(); b.st = st;
    if (threadIdx.x == 0) { (void)xb_add(&bar[XB_XCNT(b.x)], 1u); (void)__hip_atomic_fetch_or(&bar[GB_XMASK(blockIdx.x & 7u)], 1u << b.x, __ATOMIC_RELAXED, __HIP_MEMORY_SCOPE_AGENT); }
    return b;
}
__device__ __forceinline__ void xcd_barrier_complete(unsigned* bar, unsigned x, unsigned& nloc, unsigned& nx) {
    const unsigned G = gridDim.x * gridDim.y * gridDim.z;
    unsigned sum, cnt, mine, sp = 0u;
    for (;;) {
        sum = 0u; cnt = 0u; mine = 0u;
#pragma unroll
        for (unsigned j = 0; j < 16; ++j) { const unsigned c = xb_ld(&bar[XB_XCNT(j)]); sum += c; cnt += (c > 0u) ? 1u : 0u; mine = (j == x) ? c : mine; }
        if (sum == G) break;
        __builtin_amdgcn_s_sleep(1);
        if ((++sp & 255u) == 0u) { if (xb_ld(&bar[XB_TMO])) break; if (sp > XB_SPIN_CAP) { atomicAdd(&bar[XB_TMO], 1u); break; } }
    }
    nloc = mine > 0u ? mine : 1u; nx = cnt > 0u ? cnt : 1u;
}
__device__ __forceinline__ void xcd_barrier(const XcdBarrier& b) {
    asm volatile("s_waitcnt vmcnt(0)" ::: "memory");
    __syncthreads();
    if (threadIdx.x == 0) {
        unsigned* bar = b.bar;
        __builtin_amdgcn_s_waitcnt(0);
        unsigned nloc = b.st[0], nx = b.st[1];
        if (nloc == 0u) { xcd_barrier_complete(bar, b.x, nloc, nx); b.st[0] = nloc; b.st[1] = nx; }
        const unsigned old = xb_add(&bar[XB_XSUB(b.x)], 1u);
        const unsigned gen = old / nloc;
        if (old + 1u == (gen + 1u) * nloc) {
            __builtin_amdgcn_fence(__ATOMIC_RELEASE, "agent");
            asm volatile("s_waitcnt vmcnt(0)" ::: "memory");
            const unsigned og = xb_add(&bar[XB_TOP], 1u);
            const unsigned tg = og / nx;
            if (og + 1u == (tg + 1u) * nx) xb_add(&bar[XB_TOPGEN], 1u);
            else XB_SPIN(xb_ld(&bar[XB_TOPGEN]) == tg, bar);
            __builtin_amdgcn_fence(__ATOMIC_ACQUIRE, "agent");
            xb_add(&bar[XB_XGEN(b.x)], 1u);
            asm volatile("s_waitcnt vmcnt(0)" ::: "memory");
        } else {
            XB_SPIN(xb_ld(&bar[XB_XGEN(b.x)]) == gen, bar);
            __builtin_amdgcn_fence(__ATOMIC_ACQUIRE, "agent");
            asm volatile("s_waitcnt vmcnt(0)" ::: "memory");
        }
    }
    __syncthreads();
}

#define GB_CNT(g) (3520 + 64 * (g))
#define GB_GEN(g) (3552 + 64 * (g))
__device__ __forceinline__ void grp_barrier(const XcdBarrier& b) {
    asm volatile("s_waitcnt vmcnt(0)" ::: "memory");
    __syncthreads();
    if (threadIdx.x == 0) {
        unsigned* bar = b.bar; const unsigned g = blockIdx.x & 7u, n = (gridDim.x + 7u - g) >> 3;
        __builtin_amdgcn_s_waitcnt(0);
        const unsigned k = b.st[3] + 1u; b.st[3] = k;
        unsigned same = b.st[4];
        if (same == 0u) { const unsigned m = xb_ld(&bar[GB_XMASK(g)]); same = (m != 0u && (m & (m - 1u)) == 0u) ? 1u : 2u; b.st[4] = same; }
        if (same != 1u) { __builtin_amdgcn_fence(__ATOMIC_RELEASE, "agent"); asm volatile("s_waitcnt vmcnt(0)" ::: "memory"); }
        const unsigned old = xb_add(&bar[GB_CNT(g)], 1u);
        if (old + 1u == k * n) { (void)xb_add(&bar[GB_GEN(g)], 1u); }
        else XB_SPIN((int)(xb_ld(&bar[GB_GEN(g)]) - k) < 0, bar);
        __builtin_amdgcn_fence(__ATOMIC_ACQUIRE, "agent");
        asm volatile("s_waitcnt vmcnt(0)" ::: "memory");
    }
    __syncthreads();
}

struct Args {
    const float* in[19]; float* out; unsigned char* ws; int ph_lo, ph_hi;
};
enum { PH_PRO = 0, PH_GEMM1 = 1, PH_WO0 = 5, PH_GU0 = 6, PH_DN0 = 7, PH_KVB = 8, PH_WO1 = 11, PH_GU1 = 12, PH_DN1 = 13, PH_END = 14 };

__device__ __forceinline__ void p0_transpose_item(const float* W, const float* gain, int K, int N, bf16_t* WT, int map, LAS float* scr, int item, int lane) {
    const int nblk = N / 64, kb = item / nblk, nb = item % nblk, k0 = 64 * kb, n0 = 64 * nb;
    f32x4 wv[16];
#pragma unroll
    for (int i = 0; i < 16; ++i) wv[i] = __builtin_nontemporal_load((const f32x4*)(W + (size_t)(k0 + 4 * i + (lane >> 4)) * N + n0 + 4 * (lane & 15)));
    const int c = lane & 7, nn = lane >> 3;
    f32x4 g0 = (f32x4){1.f, 1.f, 1.f, 1.f}, g1 = g0;
    if (gain) { g0 = *(const f32x4*)(gain + k0 + 8 * c); g1 = *(const f32x4*)(gain + k0 + 8 * c + 4); }
#pragma unroll
    for (int i = 0; i < 16; ++i) { const int k = 4 * i + (lane >> 4); *(LAS f32x4*)(scr + k * 64 + 4 * ((lane & 15) ^ ((k >> 3) & 7))) = wv[i]; }
    asm volatile("s_waitcnt lgkmcnt(0)" ::: "memory");
#pragma unroll
    for (int j = 0; j < 8; ++j) { const int n = nn + 8 * j; const LAS float* sp = scr + (8 * c) * 64 + 4 * ((n >> 2) ^ c) + (n & 3);
        u32x4 o; o.x = cvt_pk_bf16(sp[0 * 64] * g0[0], sp[1 * 64] * g0[1]); o.y = cvt_pk_bf16(sp[2 * 64] * g0[2], sp[3 * 64] * g0[3]); o.z = cvt_pk_bf16(sp[4 * 64] * g1[0], sp[5 * 64] * g1[1]); o.w = cvt_pk_bf16(sp[6 * 64] * g1[2], sp[7 * 64] * g1[3]);
        *(u32x4*)(WT + (size_t)dst_row(map, n0 + n) * K + k0 + 8 * c) = o; }
    asm volatile("s_waitcnt lgkmcnt(0)" ::: "memory");
}
__device__ __forceinline__ void p0_row(const float* xrow, bf16_t* orow, float* ss, int lane) {
    const f32x4* xr = (const f32x4*)xrow + lane; f32x4 v[4]; float s = 0.f;
#pragma unroll
    for (int j = 0; j < 4; ++j) { v[j] = __builtin_nontemporal_load(xr + 64 * j); s += (v[j].x * v[j].x + v[j].y * v[j].y) + (v[j].z * v[j].z + v[j].w * v[j].w); }
    s = wave_sum(s);
#pragma unroll
    for (int j = 0; j < 4; ++j) { u32x2 o; o.x = cvt_pk_bf16(v[j].x, v[j].y); o.y = cvt_pk_bf16(v[j].z, v[j].w); *((u32x2*)orow + lane + 64 * j) = o; }
    if (lane == 0) *ss = s;
}

__device__ __forceinline__ void p0_row4_load(const float* xrow, int lane, f32x4 (&v)[4][4]) {
#pragma unroll
    for (int r = 0; r < 4; ++r)
#pragma unroll
        for (int j = 0; j < 4; ++j) v[r][j] = __builtin_nontemporal_load((const f32x4*)(xrow + (size_t)r * DM) + lane + 64 * j);
}
__device__ __forceinline__ void p0_row4_finish(const f32x4 (&v)[4][4], bf16_t* orow, float* ss, int lane) {
    float s[4];
#pragma unroll
    for (int r = 0; r < 4; ++r) { float a = 0.f;
#pragma unroll
        for (int j = 0; j < 4; ++j) { a += (v[r][j].x * v[r][j].x + v[r][j].y * v[r][j].y) + (v[r][j].z * v[r][j].z + v[r][j].w * v[r][j].w);
            u32x2 o; o.x = cvt_pk_bf16(v[r][j].x, v[r][j].y); o.y = cvt_pk_bf16(v[r][j].z, v[r][j].w); *((u32x2*)(orow + (size_t)r * DM) + lane + 64 * j) = o; }
        s[r] = wave_sum(a); }
    if (lane < 4) ss[lane] = lane == 0 ? s[0] : (lane == 1 ? s[1] : (lane == 2 ? s[2] : s[3]));
}
__device__ __forceinline__ void p0_row4(const float* xrow, bf16_t* orow, float* ss, int lane) {
    f32x4 v[4][4]; float s[4];
#pragma unroll
    for (int r = 0; r < 4; ++r)
#pragma unroll
        for (int j = 0; j < 4; ++j) v[r][j] = ((const f32x4*)(xrow + (size_t)r * DM))[lane + 64 * j];
#pragma unroll
    for (int r = 0; r < 4; ++r) { float a = 0.f;
#pragma unroll
        for (int j = 0; j < 4; ++j) { a += (v[r][j].x * v[r][j].x + v[r][j].y * v[r][j].y) + (v[r][j].z * v[r][j].z + v[r][j].w * v[r][j].w);
            u32x2 o; o.x = cvt_pk_bf16(v[r][j].x, v[r][j].y); o.y = cvt_pk_bf16(v[r][j].z, v[r][j].w); *((u32x2*)(orow + (size_t)r * DM) + lane + 64 * j) = o; }
        s[r] = wave_sum(a); }
    if (lane < 4) ss[lane] = lane == 0 ? s[0] : (lane == 1 ? s[1] : (lane == 2 ? s[2] : s[3]));
}

__global__ void __launch_bounds__(NTHREADS, 2) mk_fwd(Args args) {
    extern __shared__ __attribute__((aligned(16))) unsigned char lds_raw[];
    LAS unsigned char* lds = (LAS unsigned char*)lds_raw;
    const int G = gridDim.x, bx = blockIdx.x;
    const int wave_s = __builtin_amdgcn_readfirstlane(threadIdx.x >> 6);
    const int vcu = (G % 8 == 0) ? (bx % 8) * (G / 8) + bx / 8 : bx;
    const float* x = (const float*)(const GAS float*)args.in[0]; const float* mem = (const float*)(const GAS float*)args.in[1]; const float* norm_mix = (const float*)(const GAS float*)args.in[2]; const float* norm_ffn = (const float*)(const GAS float*)args.in[3];
    const float* a_w_in = (const float*)(const GAS float*)args.in[4]; const float* a_lb = (const float*)(const GAS float*)args.in[5]; const float* a_onorm = (const float*)(const GAS float*)args.in[6]; const float* b_w_in = (const float*)(const GAS float*)args.in[7]; const float* b_qnorm = (const float*)(const GAS float*)args.in[8];
    const float* kv_norm = (const float*)(const GAS float*)args.in[9]; const float* w_kv = (const float*)(const GAS float*)args.in[10]; const float* b_knorm = (const float*)(const GAS float*)args.in[11]; const float* mem_norm = (const float*)(const GAS float*)args.in[12]; const float* w_mem_kv = (const float*)(const GAS float*)args.in[13];
    const float* mem_qnorm = (const float*)(const GAS float*)args.in[14]; const float* mem_knorm = (const float*)(const GAS float*)args.in[15]; const float* w_out = (const float*)(const GAS float*)args.in[16]; const float* w_gate_up = (const float*)(const GAS float*)args.in[17]; const float* w_down = (const float*)(const GAS float*)args.in[18];
#define WSP(type, name, off) type* name = (type*)(GAS type*)(wsp + (off))
#define PHASE_PTRS GAS unsigned char* wsp = (GAS unsigned char*)args.ws; asm volatile("" : "+s"(wsp)); float* sm = (float*)(GAS float*)(wsp + WS_SMALL); (void)sm
    float* H = (float*)(GAS float*)args.out;
    volatile LAS unsigned* MISC = (volatile LAS unsigned*)(lds + MISC_OFF);
    if (threadIdx.x < 16) MISC[threadIdx.x] = 0u;
    __syncthreads();
    const XcdBarrier gbar = xcd_barrier_post((unsigned*)((GAS unsigned char*)args.ws + WS_CTL), MISC);
#ifndef PROBE_REPEAT
#define PROBE_REPEAT -1
#endif
#define REPS(k) ((PROBE_REPEAT == (k)) ? 2 : 1)
#define IN(k) true
#ifndef PROBE_PHASE
#define PROBE_PHASE -1
#endif
#ifndef PROBE_MULT
#define PROBE_MULT 4
#endif
    unsigned long long tprev = 0, tsel = 0;
    if (PROBE_PHASE >= 0) tprev = __builtin_amdgcn_s_memrealtime();
#define SEAM(k) do { if ((k) == PH_PRO || (k) == 4 || (k) == PH_DN0 || (k) == 10 || G != 256) xcd_barrier(gbar); else grp_barrier(gbar); if (PROBE_PHASE >= 0) { const unsigned long long now_ = __builtin_amdgcn_s_memrealtime(); if (PROBE_PHASE == (k)) tsel = now_ - tprev; tprev = now_; } } while (0)

    for (int rep_ = 0; rep_ < REPS(PH_PRO); ++rep_) if (IN(PH_PRO)) {
        if (rep_) xcd_barrier(gbar);
        PHASE_PTRS;
        WSP(bf16_t, WA, WS_WA); WSP(bf16_t, WKVB, WS_WKVB); WSP(bf16_t, WO, WS_WO); WSP(bf16_t, WGU, WS_WGU); WSP(bf16_t, WD, WS_WD); WSP(bf16_t, WMKV, WS_WMKV);
        WSP(bf16_t, XB, WS_XB); WSP(bf16_t, MEMB, WS_MEMB); WSP(unsigned, CSH, WS_CSH);
        float* LB = sm + SM_LB / 4; float* COS = sm + SM_COS / 4; float* SIN = sm + SM_SIN / 4; float* SS0 = sm + SM_SS0 / 4; float* SS1 = sm + SM_SS1 / 4; float* SS2 = sm + SM_SS2 / 4; float* SS3 = sm + SM_SS3 / 4; float* SSM = sm + SM_SSM / 4;
        const int tid = fresh_tid(wave_s); const int lane = tid & 63, wave = __builtin_amdgcn_readfirstlane(tid >> 6);
        LAS float* scr = (LAS float*)(lds + wave * 16384);
        const int gw = vcu * NWAVES + wave, NGW = G * NWAVES;
        int base = 0;
#define WJOB(W_, g_, K_, N_, o_, map_) do { const int ni_ = ((K_) / 64) * ((N_) / 64); int first_ = gw - (base % NGW); if (first_ < 0) first_ += NGW; \
            for (int it = first_; it < ni_; it += NGW) p0_transpose_item(W_, g_, K_, N_, o_, map_, scr, it, lane); base += ni_; } while (0)
#define WJOBS_LATE do { \
        WJOB(w_out, (const float*)nullptr, DM, DM, WO, MAP_STD); \
        WJOB(w_kv, kv_norm, DM, 2 * AW, WKVB, MAP_KV); \
        WJOB(b_w_in, norm_mix + DM, DM, B_COLS, WKVB, MAP_BIN); \
        WJOB(w_out + (size_t)DM * DM, (const float*)nullptr, DM, DM, WO + (size_t)DM * DM, MAP_STD); \
        WJOB(w_gate_up, norm_ffn, DM, 2 * FFN, WGU, MAP_GU); \
        WJOB(w_gate_up + (size_t)DM * 2 * FFN, norm_ffn + DM, DM, 2 * FFN, WGU + (size_t)2 * FFN * DM, MAP_GU); \
        WJOB(w_down, (const float*)nullptr, FFN, DM, WD, MAP_STD); \
        WJOB(w_down + (size_t)FFN * DM, (const float*)nullptr, FFN, DM, WD + (size_t)DM * FFN, MAP_STD); } while (0)
        WJOB(a_w_in, norm_mix, DM, A_COLS, WA, MAP_WA);
        WJOB(w_mem_kv, mem_norm, DM, 512, WMKV, MAP_MKV0);
        WJOB(w_mem_kv + (size_t)DM * 512, mem_norm + DM, DM, 512, WMKV, MAP_MKV1);
        if (G != 256) WJOBS_LATE;
        if (T == 4 * NGW * 4) {
            const int m0 = gw * 4, st_ = NGW * 4; f32x4 va[4][4], vb[4][4];
            p0_row4_load(x + (size_t)m0 * DM, lane, va); p0_row4_load(x + (size_t)(m0 + st_) * DM, lane, vb);
            p0_row4_finish(va, XB + (size_t)m0 * DM, SS0 + m0, lane); p0_row4_load(x + (size_t)(m0 + 2 * st_) * DM, lane, va);
            p0_row4_finish(vb, XB + (size_t)(m0 + st_) * DM, SS0 + m0 + st_, lane); p0_row4_load(x + (size_t)(m0 + 3 * st_) * DM, lane, vb);
            p0_row4_finish(va, XB + (size_t)(m0 + 2 * st_) * DM, SS0 + m0 + 2 * st_, lane);
            p0_row4_finish(vb, XB + (size_t)(m0 + 3 * st_) * DM, SS0 + m0 + 3 * st_, lane);
        } else
        for (int m = gw * 4; m < T; m += NGW * 4) p0_row4(x + (size_t)m * DM, XB + (size_t)m * DM, SS0 + m, lane);
        for (int m = gw; m < MROWS; m += NGW) p0_row(mem + (size_t)m * DM, MEMB + (size_t)m * DM, SSM + m, lane);
#define LATE_TABLES(gt, NGT) do { \
        for (int i = gt; i < 4096 * 64; i += NGT) { const int pos = i >> 6, fi = i & 63; const float inv = __builtin_amdgcn_exp2f(-(float)fi * (13.287712379549449f / 64.f)); const float ang = (float)pos * inv;\
            const float rev = ang * 0.15915494309189535f, fr_ = rev - floorf(rev);\
            const float cv = __builtin_amdgcn_cosf(fr_), sv = __builtin_amdgcn_sinf(fr_); COS[i] = cv; SIN[i] = sv; \
            { typedef _Float16 h2_t __attribute__((ext_vector_type(2))); const h2_t pk = {(_Float16)cv, (_Float16)sv}; CSH[i] = __builtin_bit_cast(unsigned, pk); } } \
        for (int i = gt; i < T; i += NGT) { SS1[i] = 0.f; SS2[i] = 0.f; SS3[i] = 0.f; } } while (0)
        const int gt = vcu * NTHREADS + tid, NGT = G * NTHREADS;
        if (G != 256) LATE_TABLES(gt, NGT);
        for (int i = gt; i < AW; i += NGT) { const float a0 = a_lb[i], a1 = a_lb[AW + i]; const float mx = fmaxf(a0, a1); const float e0 = expf(a0 - mx), e1 = expf(a1 - mx); LB[i] = e0 / (e0 + e1); }
        asm volatile("s_waitcnt vmcnt(0) lgkmcnt(0)" ::: "memory"); __syncthreads();
    }
    SEAM(PH_PRO);
    for (int rep_ = 0; rep_ < REPS(PH_GEMM1); ++rep_) if (IN(PH_GEMM1)) {
        if (rep_) xcd_barrier(gbar);
        PHASE_PTRS;
        WSP(bf16_t, WA, WS_WA); WSP(bf16_t, WMKV, WS_WMKV); WSP(bf16_t, XB, WS_XB); WSP(bf16_t, MEMB, WS_MEMB); WSP(bf16_t, MK, WS_MK); WSP(bf16_t, MV, WS_MV);
        WSP(bf16_t, QS, WS_QS); WSP(bf16_t, VV, WS_VV); WSP(bf16_t, SG, WS_SG); WSP(bf16_t, MQ0, WS_MQ0); WSP(unsigned short, LF, WS_LF);
        float* LB = sm + SM_LB / 4; float* SS0 = sm + SM_SS0 / 4; float* SSM = sm + SM_SSM / 4;
        { pg8::StaticOrder S; S.init(MROWS, 1024, G, (bx + G / 2) % G); S.direct = 1;
          pg8::EpiMemKV E{SSM, mem_knorm, MK, MV};
          pg8::gemm_phase(lds, wave_s, MEMB, WMKV, MROWS, 1024, DM, S, E); }
        { pg8::StaticOrder S; S.init(T, A_COLS, G, bx);
          pg8::EpiInproj0 E{SS0, LB, mem_qnorm, QS, LF, VV, SG, MQ0};
          pg8::gemm_phase(lds, wave_s, XB, WA, T, A_COLS, DM, S, E); }
    }
    if (PROBE_REPEAT == 21 && IN(PH_GEMM1)) { xcd_barrier(gbar); PHASE_PTRS; WSP(bf16_t, WA, WS_WA); WSP(bf16_t, XB, WS_XB); pg8::StaticOrder S; S.init(T, A_COLS, G, bx); pg8::EpiNull E; pg8::gemm_phase(lds, wave_s, XB, WA, T, A_COLS, DM, S, E); }
    SEAM(PH_GEMM1);
    if (IN(2)) { PHASE_PTRS; WSP(unsigned short, LF, WS_LF); WSP(bf16_t, VV, WS_VV); WSP(bf16_t, MQ0, WS_MQ0); WSP(bf16_t, MK, WS_MK); WSP(bf16_t, MV, WS_MV); WSP(bf16_t, MIX, WS_MIX);
        float* AGG = H; float* DTOT = H + (size_t)4 * 1024 * 1024;
        const int tid = fresh_tid(wave_s);
        if (G == 256) {
            const int gb = vcu >> 5, li = vcu & 31;
            if (li < 24 && (li & 3) != 3) hg2A_run(lds, 24 * gb + li, LF, VV, AGG, DTOT, tid);
            else { const int ms = li < 24 ? (li >> 2) : 6 + (li - 24); mem_run(lds, ms < 2 ? 10 : 9, 128 * gb + (ms < 2 ? 10 * ms : 20 + 9 * (ms - 2)), MQ0, MK, MV, MIX, tid); } }
    }
    SEAM(2);
    if (IN(4)) { PHASE_PTRS; WSP(unsigned short, LF, WS_LF); WSP(bf16_t, QS, WS_QS); WSP(bf16_t, VV, WS_VV); WSP(bf16_t, SG, WS_SG); WSP(bf16_t, MIX, WS_MIX); WSP(bf16_t, MQ0, WS_MQ0); WSP(bf16_t, MK, WS_MK); WSP(bf16_t, MV, WS_MV);
        const float* AGG = H; const float* DTOT = H + (size_t)4 * 1024 * 1024;
        const int tid = fresh_tid(wave_s);
        if (G == 256) {
            const int gb = vcu >> 5, li = vcu & 31;
            if (li < 24) hg2C_run(lds, 24 * gb + li, LF, QS, VV, SG, AGG, DTOT, a_onorm, MIX, tid);
            else {
                WSP(bf16_t, WKVB, WS_WKVB); WSP(bf16_t, WO, WS_WO); WSP(bf16_t, WGU, WS_WGU); WSP(bf16_t, WD, WS_WD); WSP(unsigned, CSH, WS_CSH);
                float* COS = sm + SM_COS / 4; float* SIN = sm + SM_SIN / 4; float* SS1 = sm + SM_SS1 / 4; float* SS2 = sm + SM_SS2 / 4; float* SS3 = sm + SM_SS3 / 4;
                const int tid3 = fresh_tid(wave_s); const int lane = tid3 & 63, wave = __builtin_amdgcn_readfirstlane(tid3 >> 6);
                LAS float* scr = (LAS float*)(lds + wave * 16384);
                const int gw = (gb * 8 + (li - 24)) * NWAVES + wave, NGW = 64 * NWAVES; int base = 0;
                WJOBS_LATE;
                LATE_TABLES((gb * 8 + (li - 24)) * NTHREADS + tid3, 64 * NTHREADS); } }
#undef WJOB
#undef WJOBS_LATE
#undef LATE_TABLES
    }
    SEAM(4);
    { constexpr int l = 0;

        const int pb = l == 0 ? PH_WO0 : PH_WO1;
        if (IN(pb)) { PHASE_PTRS; WSP(bf16_t, WO, WS_WO); WSP(bf16_t, XB, WS_XB); WSP(bf16_t, MIX, WS_MIX); float* SS1 = sm + SM_SS1 / 4; float* SS3 = sm + SM_SS3 / 4;
            pg8::StaticOrder S; S.init(T, DM, G, bx);
            pg8::EpiResid<true, false> E{x, H, XB, l == 0 ? SS1 : SS3};
            pg8::gemm_phase(lds, wave_s, MIX, WO + (size_t)l * DM * DM, T, DM, DM, S, E); }
        if (PROBE_REPEAT == 5 && IN(pb)) { xcd_barrier(gbar); PHASE_PTRS; WSP(bf16_t, WO, WS_WO); WSP(bf16_t, MIX, WS_MIX); pg8::StaticOrder S; S.init(T, DM, G, bx); pg8::EpiNull E; pg8::gemm_phase(lds, wave_s, MIX, WO + (size_t)l * DM * DM, T, DM, DM, S, E); }
        SEAM(pb);
        for (int rep_ = 0; rep_ < REPS(6); ++rep_) if (IN(pb + 1)) { if (rep_) xcd_barrier(gbar); PHASE_PTRS; WSP(bf16_t, WGU, WS_WGU); WSP(bf16_t, XB, WS_XB); WSP(bf16_t, ACT, WS_ACT); float* SS1 = sm + SM_SS1 / 4; float* SS3 = sm + SM_SS3 / 4;
            pg8::StaticOrder S; S.init(T, 2 * FFN, G, bx);
            pg8::EpiGateUp E{l == 0 ? SS1 : SS3, ACT};
            pg8::gemm_phase(lds, wave_s, XB, WGU + (size_t)l * 2 * FFN * DM, T, 2 * FFN, DM, S, E); }
        SEAM(pb + 1);
        if (IN(pb + 2)) { PHASE_PTRS; WSP(bf16_t, WD, WS_WD); WSP(bf16_t, XB, WS_XB); WSP(bf16_t, ACT, WS_ACT); float* SS2 = sm + SM_SS2 / 4;
            pg8::StaticOrder S; S.init(T, DM, G, bx);
            pg8::EpiResid<true, l != 0> E{x, H, XB, SS2};
            pg8::gemm_phase(lds, wave_s, ACT, WD + (size_t)l * DM * FFN, T, DM, FFN, S, E); }
        if (PROBE_REPEAT == 7 && IN(pb + 2)) { xcd_barrier(gbar); PHASE_PTRS; WSP(bf16_t, WD, WS_WD); WSP(bf16_t, ACT, WS_ACT); pg8::StaticOrder S; S.init(T, DM, G, bx); pg8::EpiNull E; pg8::gemm_phase(lds, wave_s, ACT, WD + (size_t)l * DM * FFN, T, DM, FFN, S, E); }
        if (l == 0) {
            SEAM(PH_DN0);
            for (int rep_ = 0; rep_ < REPS(PH_KVB); ++rep_) if (IN(PH_KVB)) { if (rep_) xcd_barrier(gbar); PHASE_PTRS; WSP(bf16_t, WKVB, WS_WKVB); WSP(bf16_t, XB, WS_XB); WSP(bf16_t, KR, WS_KR); WSP(bf16_t, VS, WS_VS); WSP(bf16_t, QG, WS_QG); WSP(bf16_t, MQ1, WS_MQ1);
                float* COS = sm + SM_COS / 4; float* SIN = sm + SM_SIN / 4; float* SS2 = sm + SM_SS2 / 4;
                pg8::StaticOrder S; S.init(T, KVB_COLS, G, bx);
                pg8::EpiKVB E{SS2, b_knorm, b_qnorm, mem_qnorm + 64, COS, SIN, KR, VS, QG, MQ1};
                pg8::gemm_phase(lds, wave_s, XB, WKVB, T, KVB_COLS, DM, S, E); }
            if (PROBE_REPEAT == 28 && IN(PH_KVB)) { xcd_barrier(gbar); PHASE_PTRS; WSP(bf16_t, WKVB, WS_WKVB); WSP(bf16_t, XB, WS_XB); pg8::StaticOrder S; S.init(T, KVB_COLS, G, bx); pg8::EpiNull E; pg8::gemm_phase(lds, wave_s, XB, WKVB, T, KVB_COLS, DM, S, E); }
            SEAM(PH_KVB);
            if (IN(9)) { PHASE_PTRS; WSP(bf16_t, KR, WS_KR); WSP(bf16_t, VS, WS_VS); WSP(bf16_t, QG, WS_QG); WSP(bf16_t, MQ1, WS_MQ1); WSP(bf16_t, MK, WS_MK); WSP(bf16_t, MV, WS_MV); WSP(bf16_t, MIX, WS_MIX); WSP(float, LSE, WS_LSE); WSP(unsigned, CSH, WS_CSH);
                const int tid = fresh_tid(wave_s);
                if (G == 256) { const HeadSync hc{gbar.bar, MISC}; dil_run(lds, 18, (vcu >> 5) * 576 + (vcu & 31), KR, VS, QG, LSE, CSH, b_qnorm, tid, hc, MIX); const int tid2 = fresh_tid(wave_s); mem_run(lds, 4, vcu * 4, MQ1, MK + (size_t)MROWS * MW, MV + (size_t)MROWS * MW, MIX, tid2);
                    const int tid5 = fresh_tid(wave_s); dil_head_wait(hc, 6u); dil_combine_head(vcu >> 5, vcu & 31, 5, QG, LSE, MIX, tid5); }
            }
            SEAM(10);
        }
        }
    { constexpr int l = 1;

        const int pb = l == 0 ? PH_WO0 : PH_WO1;
        if (IN(pb)) { PHASE_PTRS; WSP(bf16_t, WO, WS_WO); WSP(bf16_t, XB, WS_XB); WSP(bf16_t, MIX, WS_MIX); float* SS1 = sm + SM_SS1 / 4; float* SS3 = sm + SM_SS3 / 4;
            pg8::StaticOrder S; S.init(T, DM, G, bx);
            pg8::EpiResid<true, false> E{x, H, XB, l == 0 ? SS1 : SS3};
            pg8::gemm_phase(lds, wave_s, MIX, WO + (size_t)l * DM * DM, T, DM, DM, S, E); }
        if (PROBE_REPEAT == 5 && IN(pb)) { xcd_barrier(gbar); PHASE_PTRS; WSP(bf16_t, WO, WS_WO); WSP(bf16_t, MIX, WS_MIX); pg8::StaticOrder S; S.init(T, DM, G, bx); pg8::EpiNull E; pg8::gemm_phase(lds, wave_s, MIX, WO + (size_t)l * DM * DM, T, DM, DM, S, E); }
        SEAM(pb);
        for (int rep_ = 0; rep_ < REPS(6); ++rep_) if (IN(pb + 1)) { if (rep_) xcd_barrier(gbar); PHASE_PTRS; WSP(bf16_t, WGU, WS_WGU); WSP(bf16_t, XB, WS_XB); WSP(bf16_t, ACT, WS_ACT); float* SS1 = sm + SM_SS1 / 4; float* SS3 = sm + SM_SS3 / 4;
            pg8::StaticOrder S; S.init(T, 2 * FFN, G, bx);
            pg8::EpiGateUp E{l == 0 ? SS1 : SS3, ACT};
            pg8::gemm_phase(lds, wave_s, XB, WGU + (size_t)l * 2 * FFN * DM, T, 2 * FFN, DM, S, E); }
        SEAM(pb + 1);
        if (IN(pb + 2)) { PHASE_PTRS; WSP(bf16_t, WD, WS_WD); WSP(bf16_t, XB, WS_XB); WSP(bf16_t, ACT, WS_ACT); float* SS2 = sm + SM_SS2 / 4;
            pg8::StaticOrder S; S.init(T, DM, G, bx);
            pg8::EpiResid<true, l != 0> E{x, H, XB, SS2};
            pg8::gemm_phase(lds, wave_s, ACT, WD + (size_t)l * DM * FFN, T, DM, FFN, S, E); }
        if (PROBE_REPEAT == 7 && IN(pb + 2)) { xcd_barrier(gbar); PHASE_PTRS; WSP(bf16_t, WD, WS_WD); WSP(bf16_t, ACT, WS_ACT); pg8::StaticOrder S; S.init(T, DM, G, bx); pg8::EpiNull E; pg8::gemm_phase(lds, wave_s, ACT, WD + (size_t)l * DM * FFN, T, DM, FFN, S, E); }
        if (l == 0) {
            SEAM(PH_DN0);
            for (int rep_ = 0; rep_ < REPS(PH_KVB); ++rep_) if (IN(PH_KVB)) { if (rep_) xcd_barrier(gbar); PHASE_PTRS; WSP(bf16_t, WKVB, WS_WKVB); WSP(bf16_t, XB, WS_XB); WSP(bf16_t, KR, WS_KR); WSP(bf16_t, VS, WS_VS); WSP(bf16_t, QG, WS_QG); WSP(bf16_t, MQ1, WS_MQ1);
                float* COS = sm + SM_COS / 4; float* SIN = sm + SM_SIN / 4; float* SS2 = sm + SM_SS2 / 4;
                pg8::StaticOrder S; S.init(T, KVB_COLS, G, bx);
                pg8::EpiKVB E{SS2, b_knorm, b_qnorm, mem_qnorm + 64, COS, SIN, KR, VS, QG, MQ1};
                pg8::gemm_phase(lds, wave_s, XB, WKVB, T, KVB_COLS, DM, S, E); }
            if (PROBE_REPEAT == 28 && IN(PH_KVB)) { xcd_barrier(gbar); PHASE_PTRS; WSP(bf16_t, WKVB, WS_WKVB); WSP(bf16_t, XB, WS_XB); pg8::StaticOrder S; S.init(T, KVB_COLS, G, bx); pg8::EpiNull E; pg8::gemm_phase(lds, wave_s, XB, WKVB, T, KVB_COLS, DM, S, E); }
            SEAM(PH_KVB);
            if (IN(9)) { PHASE_PTRS; WSP(bf16_t, KR, WS_KR); WSP(bf16_t, VS, WS_VS); WSP(bf16_t, QG, WS_QG); WSP(bf16_t, MQ1, WS_MQ1); WSP(bf16_t, MK, WS_MK); WSP(bf16_t, MV, WS_MV); WSP(bf16_t, MIX, WS_MIX); WSP(float, LSE, WS_LSE); WSP(unsigned, CSH, WS_CSH);
                const int tid = fresh_tid(wave_s);
                if (G == 256) { const HeadSync hc{gbar.bar, MISC}; dil_run(lds, 18, (vcu >> 5) * 576 + (vcu & 31), KR, VS, QG, LSE, CSH, b_qnorm, tid, hc, MIX); const int tid2 = fresh_tid(wave_s); mem_run(lds, 4, vcu * 4, MQ1, MK + (size_t)MROWS * MW, MV + (size_t)MROWS * MW, MIX, tid2);
                    const int tid5 = fresh_tid(wave_s); dil_head_wait(hc, 6u); dil_combine_head(vcu >> 5, vcu & 31, 5, QG, LSE, MIX, tid5); }
            }
            SEAM(10);
        }
        }
    if (PROBE_PHASE >= 0) { SEAM(13);
        if (bx == 0) { const unsigned long long t0 = __builtin_amdgcn_s_memrealtime(); while (__builtin_amdgcn_s_memrealtime() - t0 < (unsigned long long)PROBE_MULT * tsel) __builtin_amdgcn_s_sleep(32); } }
#undef IN
#undef SEAM
}

static int g_grid = 0;
static void launch_mk(Args& a, int lo, int hi, hipStream_t stream) {
    a.ph_lo = lo; a.ph_hi = hi;
    void* kargs[] = {&a};
    (void)kargs; hipLaunchKernelGGL(mk_fwd, dim3(g_grid), dim3(NTHREADS), LDS_BYTES, stream, a);
}
extern "C" void kernel_launch(void* const* d_in, const int* in_sizes, int n_in, void* d_out, int out_size, void* d_ws, size_t ws_size, hipStream_t stream) {
    if (ws_size < WS_END || n_in != 19 || out_size != T * DM) return;
    if (g_grid == 0) {
        int dev = 0, cus = 0, per_cu = 0;
        hipGetDevice(&dev); hipDeviceGetAttribute(&cus, hipDeviceAttributeMultiprocessorCount, dev);
        hipFuncSetAttribute((const void*)mk_fwd, hipFuncAttributeMaxDynamicSharedMemorySize, LDS_BYTES);
        hipOccupancyMaxActiveBlocksPerMultiprocessor(&per_cu, (const void*)mk_fwd, NTHREADS, LDS_BYTES);
        (void)hipGetLastError();
        g_grid = (per_cu >= 1) ? cus : -1;
    }
    if (g_grid < 0) return;
    const float* x = (const float*)d_in[0];
    const float* a_onorm = (const float*)d_in[6];
    char* ws = (char*)d_ws;
    float* sm = (float*)(ws + WS_SMALL);
    bf16_t* MK = (bf16_t*)(ws + WS_MK); bf16_t* MV = (bf16_t*)(ws + WS_MV);
    bf16_t* QS = (bf16_t*)(ws + WS_QS); bf16_t* VV = (bf16_t*)(ws + WS_VV); bf16_t* SG = (bf16_t*)(ws + WS_SG); bf16_t* MQ0 = (bf16_t*)(ws + WS_MQ0);
    float* LF = (float*)(ws + WS_LF);
    bf16_t* KR = (bf16_t*)(ws + WS_KR); bf16_t* VS = (bf16_t*)(ws + WS_VS); bf16_t* QG = (bf16_t*)(ws + WS_QG); bf16_t* MQ1 = (bf16_t*)(ws + WS_MQ1);
    bf16_t* MIX = (bf16_t*)(ws + WS_MIX);
    Args a{};
    for (int i = 0; i < 19; ++i) a.in[i] = (const float*)d_in[i];
    a.out = (float*)d_out; a.ws = (unsigned char*)d_ws;

    hipMemsetAsync((char*)d_ws + WS_CTL, 0, 16384, stream);
    launch_mk(a, PH_PRO, PH_END, stream);
}
```
